# Optimizing an MI355X kernel written in HIP

```python
import jax, jax.numpy as jnp
from jax import lax
import numpy as np

D_MODEL = 1024
BATCH = 8
SEQ = 4096
DEPTH = 1

D_MIX = D_MODEL
HEAD_DIM = 128
GM_HEADS = 4
GM_WIDTH = GM_HEADS * HEAD_DIM
GM_CHUNK = 128
DN_HEADS = 4
DN_DK = 128
DN_DV = 128
DN_KEY = DN_HEADS * DN_DK
DN_VAL = DN_HEADS * DN_DV
DN_CHUNK = 64
CONV_W = 4
D_IN = 2 * GM_WIDTH + 2 * DN_KEY + 2 * DN_VAL + 2 * DN_HEADS
N_EXPERTS = 32
TOP_K = 4
D_FF = D_MODEL
SWIGLU_LIMIT = 7.0
SWIGLU_ALPHA = 1.702
MOE_BLOCK = 128
EPS = 1e-6

kernel_name = "hymba_gmlp_gdn_moe_layer"


def rmsnorm(x, g):
    xf = x.astype(jnp.float32)
    y = xf * lax.rsqrt(jnp.mean(xf * xf, axis=-1, keepdims=True) + EPS)
    return (y * g.astype(jnp.float32)).astype(x.dtype)


def l2norm(x):
    xf = x.astype(jnp.float32)
    return xf * lax.rsqrt(jnp.sum(xf * xf, axis=-1, keepdims=True) + EPS)


def gmlp_chunk_mixer(u, v, norm_g, ws, bs):
    b_, s_, _ = u.shape
    n = s_ // GM_CHUNK
    u = jax.nn.gelu(u, approximate=False).reshape(b_, n, GM_CHUNK, GM_HEADS, HEAD_DIM)
    v = jax.nn.gelu(v, approximate=False).reshape(b_, n, GM_CHUNK, GM_HEADS, HEAD_DIM)
    v = rmsnorm(v, norm_g)
    causal = jnp.tril(jnp.ones((GM_CHUNK, GM_CHUNK), dtype=bool))
    w = jnp.where(causal, ws, jnp.zeros_like(ws)).astype(v.dtype)
    gate = jnp.einsum('hts,bnshc->bnthc', w, v) + bs.T.astype(v.dtype)[None, None, :, :, None]
    return (u * gate).reshape(b_, s_, GM_WIDTH)


def causal_dwconv(x, w):
    c = x.shape[-1]
    return lax.conv_general_dilated(
        x, w[:, None, :].astype(x.dtype), window_strides=(1,),
        padding=[(CONV_W - 1, 0)], dimension_numbers=('NWC', 'WIO', 'NWC'),
        feature_group_count=c)


def gated_delta_rule(q, k, v, g, beta):
    b_, h_, s_, dk = q.shape
    dv = v.shape[-1]
    c = DN_CHUNK
    n = s_ // c
    q = q * (dk ** -0.5)
    qc = q.reshape(b_, h_, n, c, dk)
    kc = k.reshape(b_, h_, n, c, dk)
    vc = v.reshape(b_, h_, n, c, dv)
    bc = beta.reshape(b_, h_, n, c)
    gc = jnp.cumsum(g.reshape(b_, h_, n, c), axis=-1)
    tril_incl = jnp.tril(jnp.ones((c, c), dtype=bool))
    tril_strict = jnp.tril(jnp.ones((c, c), dtype=bool), -1)
    diff = gc[..., :, None] - gc[..., None, :]
    decay = jnp.where(tril_incl, jnp.exp(jnp.where(tril_incl, diff, 0.0)), 0.0)
    kb = kc * bc[..., None]
    lower = jnp.where(tril_strict, jnp.einsum('bhnid,bhnjd->bhnij', kb, kc) * decay, 0.0)
    a_mat = lower + jnp.eye(c, dtype=lower.dtype)
    rhs = jnp.concatenate([vc * bc[..., None], kb * jnp.exp(gc)[..., None]], axis=-1)
    sol = lax.linalg.triangular_solve(a_mat, rhs, left_side=True, lower=True, unit_diagonal=True)
    u_c = sol[..., :dv]
    w_c = sol[..., dv:]
    attn_intra = jnp.where(tril_incl, jnp.einsum('bhnid,bhnjd->bhnij', qc, kc) * decay, 0.0)
    g_last = gc[..., -1]
    k_to_end = kc * jnp.exp(g_last[..., None] - gc)[..., None]
    q_dec = qc * jnp.exp(gc)[..., None]

    def step(state, inp):
        q_i, u_i, w_i, a_i, k_e, gl = inp
        v_new = u_i - jnp.einsum('bhcd,bhde->bhce', w_i, state)
        o = jnp.einsum('bhcd,bhde->bhce', q_i, state) + jnp.einsum('bhij,bhje->bhie', a_i, v_new)
        state = state * jnp.exp(gl)[..., None, None] + jnp.einsum('bhcd,bhce->bhde', k_e, v_new)
        return state, o

    xs = tuple(jnp.moveaxis(t, 2, 0) for t in (q_dec, u_c, w_c, attn_intra, k_to_end, g_last))
    s0 = jnp.zeros((b_, h_, dk, dv), jnp.float32)
    _, o = lax.scan(step, s0, xs)
    return jnp.moveaxis(o, 0, 2).reshape(b_, h_, s_, dv)


def gated_deltanet_mixer(qkv, z, a, bb, conv_w, a_log, dt_bias, norm_g):
    b_, s_, _ = qkv.shape
    qkv = jax.nn.silu(causal_dwconv(qkv, conv_w))
    q, k, v = jnp.split(qkv, 3, axis=-1)
    q = l2norm(q.reshape(b_, s_, DN_HEADS, DN_DK)).transpose(0, 2, 1, 3)
    k = l2norm(k.reshape(b_, s_, DN_HEADS, DN_DK)).transpose(0, 2, 1, 3)
    v = v.reshape(b_, s_, DN_HEADS, DN_DV).astype(jnp.float32).transpose(0, 2, 1, 3)
    g = -jnp.exp(a_log.astype(jnp.float32)) * jax.nn.softplus(a.astype(jnp.float32) + dt_bias.astype(jnp.float32))
    beta = jax.nn.sigmoid(bb.astype(jnp.float32))
    o = gated_delta_rule(q, k, v, g.transpose(0, 2, 1), beta.transpose(0, 2, 1))
    o = o.transpose(0, 2, 1, 3)
    o = rmsnorm(o, norm_g) * jax.nn.silu(z.reshape(b_, s_, DN_HEADS, DN_DV).astype(jnp.float32))
    return o.reshape(b_, s_, DN_VAL).astype(z.dtype)


def moe_ffn(h, router_w, router_b, w_gu, b_gu, w_down, b_down):
    b_, s_, d = h.shape
    t = b_ * s_
    xf = h.reshape(t, d)
    logits = (xf @ router_w + router_b).astype(jnp.float32)
    top_val, top_idx = lax.top_k(logits, TOP_K)
    gates = jax.nn.softmax(top_val, axis=-1)
    n_assign = t * TOP_K
    flat_e = top_idx.reshape(n_assign)
    order = jnp.argsort(flat_e)
    sorted_e = flat_e[order]
    counts = jnp.zeros((N_EXPERTS,), jnp.int32).at[flat_e].add(1)
    padded = (counts + MOE_BLOCK - 1) // MOE_BLOCK * MOE_BLOCK
    pad_end = jnp.cumsum(padded)
    pad_start = pad_end - padded
    start = jnp.cumsum(counts) - counts
    dest = pad_start[sorted_e] + jnp.arange(n_assign, dtype=jnp.int32) - start[sorted_e]
    n_blocks = -(-(n_assign + N_EXPERTS * MOE_BLOCK) // MOE_BLOCK)
    p = n_blocks * MOE_BLOCK
    buf_tok = jnp.full((p,), t, jnp.int32).at[dest].set((order // TOP_K).astype(jnp.int32))
    buf_gate = jnp.zeros((p,), jnp.float32).at[dest].set(gates.reshape(n_assign)[order])
    block_e = jnp.minimum(jnp.searchsorted(pad_end, jnp.arange(n_blocks, dtype=jnp.int32) * MOE_BLOCK, side='right'), N_EXPERTS - 1)
    x_pad = jnp.concatenate([xf, jnp.zeros((1, d), xf.dtype)], axis=0)
    xin = x_pad[buf_tok].reshape(n_blocks, MOE_BLOCK, d)

    def expert_block(args):
        xb, e = args
        gu = xb @ w_gu[e] + b_gu[e]
        gate, up = jnp.split(gu, 2, axis=-1)
        gate = jnp.minimum(gate, SWIGLU_LIMIT)
        up = jnp.clip(up, -SWIGLU_LIMIT, SWIGLU_LIMIT)
        return ((up + 1.0) * (gate * jax.nn.sigmoid(SWIGLU_ALPHA * gate))) @ w_down[e] + b_down[e]

    y = lax.map(expert_block, (xin, block_e)).reshape(p, d)
    out = jnp.zeros((t + 1, d), y.dtype).at[buf_tok].add(y * buf_gate[:, None].astype(y.dtype))
    return out[:t].reshape(b_, s_, d)


def setup_inputs(seed: int = 0) -> dict:
    key = jax.random.key(seed)
    ks = jax.random.split(key, 20)
    f32 = jnp.float32
    nrm = lambda k, shape, scale: jax.random.normal(k, shape, f32) * scale
    gain = lambda k, shape: 1.0 + 0.02 * jax.random.normal(k, shape, f32)
    dt = jnp.exp(jax.random.uniform(ks[8], (DEPTH, DN_HEADS), f32, np.log(1e-3), np.log(1e-1)))
    return {
        "x": nrm(ks[0], (BATCH, SEQ, D_MODEL), 1.0),
        "norm_mix_g": gain(ks[1], (DEPTH, D_MODEL)),
        "w_in": nrm(ks[2], (DEPTH, D_MODEL, D_IN), D_MODEL ** -0.5),
        "gm_norm_g": gain(ks[3], (DEPTH, GM_HEADS, HEAD_DIM)),
        "gm_ws": nrm(ks[4], (DEPTH, GM_HEADS, GM_CHUNK, GM_CHUNK), GM_CHUNK ** -0.5),
        "gm_bs": gain(ks[5], (DEPTH, GM_HEADS, GM_CHUNK)),
        "dn_conv_w": nrm(ks[6], (DEPTH, CONV_W, 3 * DN_KEY), CONV_W ** -0.5),
        "dn_a_log": jnp.log(jax.random.uniform(ks[7], (DEPTH, DN_HEADS), f32, 1.0, 16.0)),
        "dn_dt_bias": dt + jnp.log(-jnp.expm1(-dt)),
        "dn_norm_g": gain(ks[9], (DEPTH, DN_DV)),
        "w_out": nrm(ks[10], (DEPTH, D_MIX, D_MODEL), D_MIX ** -0.5),
        "norm_ffn_g": gain(ks[11], (DEPTH, D_MODEL)),
        "router_w": nrm(ks[12], (DEPTH, D_MODEL, N_EXPERTS), D_MODEL ** -0.5),
        "router_b": nrm(ks[13], (DEPTH, N_EXPERTS), 0.01),
        "exp_w_gu": nrm(ks[14], (DEPTH, N_EXPERTS, D_MODEL, 2 * D_FF), D_MODEL ** -0.5),
        "exp_b_gu": nrm(ks[15], (DEPTH, N_EXPERTS, 2 * D_FF), 0.01),
        "exp_w_down": nrm(ks[16], (DEPTH, N_EXPERTS, D_FF, D_MODEL), D_FF ** -0.5),
        "exp_b_down": nrm(ks[17], (DEPTH, N_EXPERTS, D_MODEL), 0.01),
        "final_norm_g": gain(ks[18], (D_MODEL,)),
    }


def reference(x, norm_mix_g, w_in, gm_norm_g, gm_ws, gm_bs, dn_conv_w, dn_a_log, dn_dt_bias,
              dn_norm_g, w_out, norm_ffn_g, router_w, router_b, exp_w_gu, exp_b_gu,
              exp_w_down, exp_b_down, final_norm_g):
    split_points = [GM_WIDTH, 2 * GM_WIDTH, 2 * GM_WIDTH + 2 * DN_KEY + DN_VAL,
                    2 * GM_WIDTH + 2 * DN_KEY + 2 * DN_VAL,
                    2 * GM_WIDTH + 2 * DN_KEY + 2 * DN_VAL + DN_HEADS]
    h = x
    for l in range(DEPTH):
        y = rmsnorm(h, norm_mix_g[l])
        proj = y @ w_in[l]
        u, v_gm, qkv, z, a, bb = jnp.split(proj, split_points, axis=-1)
        out_a = gmlp_chunk_mixer(u, v_gm, gm_norm_g[l], gm_ws[l], gm_bs[l])
        out_b = gated_deltanet_mixer(qkv, z, a, bb, dn_conv_w[l], dn_a_log[l], dn_dt_bias[l], dn_norm_g[l])
        mix = jnp.concatenate([out_a, out_b], axis=-1)
        h = h + mix @ w_out[l]
        h = h + moe_ffn(rmsnorm(h, norm_ffn_g[l]), router_w[l], router_b[l], exp_w_gu[l],
                        exp_b_gu[l], exp_w_down[l], exp_b_down[l])
    return rmsnorm(h, final_norm_g)
```

```cpp
#include <hip/hip_runtime.h>
#include <cstdio>
#include <cstdint>

#ifndef PROBE_DOUBLE
#define PROBE_DOUBLE (-1)
#endif
#ifndef MK_PER_PHASE
#define MK_PER_PHASE 0
#endif

#define LAS __attribute__((address_space(3)))
#define GAS __attribute__((address_space(1)))
typedef unsigned short bf16_t;
typedef short bf16x8 __attribute__((ext_vector_type(8)));
typedef float f32x4 __attribute__((ext_vector_type(4)));
typedef float f32x2 __attribute__((ext_vector_type(2)));
typedef unsigned u32x4 __attribute__((ext_vector_type(4)));
typedef unsigned u32x2 __attribute__((ext_vector_type(2)));
typedef int i32x4 __attribute__((ext_vector_type(4)));
typedef int i32x8 __attribute__((ext_vector_type(8)));

constexpr int NB = 8, SEQ = 4096, D = 1024, T = NB * SEQ;
constexpr int DIN = 3080, NPROJ = 3072;
constexpr int NE = 32, TOPK = 4, DFF = 1024;
constexpr int NH = 4, HD = 128, GMC = 128, DNC = 64;
constexpr int NCH = SEQ / DNC;
constexpr int NCHUNKS = NB * NH * NCH;
constexpr int RMAX = T * TOPK + NE * 256;
constexpr float EPS = 1e-6f;
constexpr int NWAVES = 8, NTHREADS = 512;

constexpr size_t MiB = 1u << 20;
constexpr size_t WS_CTL = 0, CTL_ZERO_BYTES = 32768;
constexpr size_t WS_AB = 1 * MiB;
constexpr size_t WS_EIDX = 2 * MiB;
constexpr size_t WS_GATEW = 2 * MiB + 512 * 1024;
constexpr size_t WS_ROWOF = 3 * MiB;
constexpr size_t WS_EPOS = 3 * MiB + 512 * 1024;
constexpr size_t WS_GSORT = 4 * MiB;
constexpr size_t WS_LIST = 5 * MiB;
constexpr size_t WS_RWT = 9 * MiB;
constexpr size_t WS_GLAST = 10 * MiB;
constexpr size_t WS_WIN = 16 * MiB;
constexpr size_t WS_WOUT = 22 * MiB;
constexpr size_t WS_WGU = 24 * MiB;
constexpr size_t WS_WDN = 152 * MiB;
constexpr size_t WS_HN8 = 88 * MiB;
constexpr size_t WS_H = 216 * MiB;
constexpr size_t WS_R3 = 344 * MiB;
constexpr size_t WS_R4 = 616 * MiB;
constexpr size_t WS_Y = WS_R4;
constexpr size_t WS_WC = WS_R4;
constexpr size_t WS_UC = WS_R4 + 32 * MiB;
constexpr size_t WS_QD = WS_R4 + 64 * MiB;
constexpr size_t WS_KET = WS_R4 + 96 * MiB;
constexpr size_t WS_AT = WS_R4 + 128 * MiB;
constexpr size_t WS_MIX = WS_R4 + 144 * MiB;
constexpr size_t WS_O = WS_R4 + 208 * MiB;
constexpr size_t WS_HN = 888 * MiB;
constexpr size_t WS_YS = WS_R3;
constexpr size_t WS_END = 952 * MiB;
constexpr int CW_BAR = 0;
constexpr int CW_CNT = 4096;

constexpr int RING_BYTES = 147456;
constexpr int LDSCTL_OFF = RING_BYTES;
constexpr int LDS_BYTES = RING_BYTES + 1024;

#define LDS_WAIT() asm volatile("s_waitcnt lgkmcnt(0)" ::: "memory")
#define VM_WAIT() asm volatile("s_waitcnt vmcnt(0)" ::: "memory")
typedef __bf16 bf16x2_t __attribute__((ext_vector_type(2)));
__device__ __forceinline__ unsigned cvt_pk_bf16(float lo, float hi) { const bf16x2_t r = __builtin_convertvector((f32x2){lo, hi}, bf16x2_t); return __builtin_bit_cast(unsigned, r); }
__device__ __forceinline__ float bf2f(unsigned short b) { return __uint_as_float(((unsigned)b) << 16); }
__device__ __forceinline__ float bflo(unsigned w) { return __uint_as_float(w << 16); }
__device__ __forceinline__ float bfhi(unsigned w) { return __uint_as_float(w & 0xffff0000u); }
__device__ __forceinline__ bf16_t f2bf(float f) { return (bf16_t)(cvt_pk_bf16(f, 0.f) & 0xffffu); }
__device__ __forceinline__ unsigned cvt4_fp8(float a, float b, float c, float d) { int r = __builtin_amdgcn_cvt_pk_fp8_f32(a, b, 0, false); r = __builtin_amdgcn_cvt_pk_fp8_f32(c, d, r, true); return (unsigned)r; }
constexpr float W8_SCALE = 32.0f, W8_INV = 1.0f / 32.0f;
__device__ __forceinline__ float wave_sum(float v) {
#pragma unroll
    for (int o = 1; o < 64; o <<= 1) v += __shfl_xor(v, o);
    return v;
}
__device__ __forceinline__ float silu_f(float v) { return v / (1.0f + __expf(-v)); }
__device__ __forceinline__ float sigmoid_f(float v) { return 1.0f / (1.0f + __expf(-v)); }
__device__ __forceinline__ f32x2 gelu_pk(f32x2 v) {
    const f32x2 av = __builtin_elementwise_abs(v), d = av * 0.2316418882f + 1.0f;
    f32x2 t; t.x = __builtin_amdgcn_rcpf(d.x); t.y = __builtin_amdgcn_rcpf(d.y);
    f32x2 q = t * 0.5307027145f + (-0.7265760135f); q = q * t + 0.7107068705f; q = q * t + (-0.142248368f); q = q * t + 0.127414796f; q = q * t;
    const f32x2 s = (v * v) * (-0.72134752044f);
    f32x2 e; e.x = __builtin_amdgcn_exp2f(s.x); e.y = __builtin_amdgcn_exp2f(s.y);
    const f32x2 m = v * (q * e), r = v - m;
    f32x2 o; o.x = v.x < 0.f ? m.x : r.x; o.y = v.y < 0.f ? m.y : r.y; return o;
}

#define XB_TMO      128
#define XB_XCNT(j)  (256  + 64 * (j))
#define XB_XSUB(j)  (1280 + 64 * (j))
#define XB_XGEN(j)  (2304 + 64 * (j))
#define XB_TOP      3328
#define XB_TOPGEN   3392
#define XCD_BAR_WORDS 3456
#define XB_SPIN_CAP (1u << 18)
__device__ __forceinline__ unsigned xb_ld(unsigned* p)              { return __hip_atomic_load(p, __ATOMIC_RELAXED, __HIP_MEMORY_SCOPE_AGENT); }
__device__ __forceinline__ unsigned xb_add(unsigned* p, unsigned v) { return __hip_atomic_fetch_add(p, v, __ATOMIC_RELAXED, __HIP_MEMORY_SCOPE_AGENT); }
__device__ __forceinline__ unsigned xb_xcc_id() { return (unsigned)__builtin_amdgcn_s_getreg((3 << 11) | 20) & 0xFu; }
#define XB_SPIN(cond, bar) do { unsigned _sp = 0; while (cond) { __builtin_amdgcn_s_sleep(1); \
    if ((++_sp & 255u) == 0u) { if (xb_ld(&(bar)[XB_TMO])) break; if (_sp > XB_SPIN_CAP) { atomicAdd(&(bar)[XB_TMO], 1u); break; } } } } while (0)
struct XcdBarrier { unsigned* bar; unsigned x; volatile LAS unsigned* st; };
__device__ __forceinline__ XcdBarrier xcd_barrier_post(unsigned* bar, volatile LAS unsigned* st) {
    XcdBarrier b; b.bar = bar; b.x = xb_xcc_id(); b.st = st;
    if (threadIdx.x == 0) (void)xb_add(&bar[XB_XCNT(b.x)], 1u);
    return b;
}
__device__ __forceinline__ void xcd_barrier_complete(unsigned* bar, unsigned x, unsigned& nloc, unsigned& nx) {
    const unsigned G = gridDim.x * gridDim.y * gridDim.z;
    unsigned sum, cnt, mine, sp = 0u;
    for (;;) {
        sum = 0u; cnt = 0u; mine = 0u;
#pragma unroll
        for (unsigned j = 0; j < 16; ++j) { const unsigned c = xb_ld(&bar[XB_XCNT(j)]); sum += c; cnt += (c > 0u) ? 1u : 0u; mine = (j == x) ? c : mine; }
        if (sum == G) break;
        __builtin_amdgcn_s_sleep(1);
        if ((++sp & 255u) == 0u) { if (xb_ld(&bar[XB_TMO])) break; if (sp > XB_SPIN_CAP) { atomicAdd(&bar[XB_TMO], 1u); break; } }
    }
    nloc = mine > 0u ? mine : 1u; nx = cnt > 0u ? cnt : 1u;
}
__device__ __forceinline__ void xcd_barrier(const XcdBarrier& b) {
    asm volatile("s_waitcnt vmcnt(0)" ::: "memory");
    __syncthreads();
    if (threadIdx.x == 0) {
        unsigned* bar = b.bar;
        __builtin_amdgcn_s_waitcnt(0);
        unsigned nloc = b.st[0], nx = b.st[1];
        if (nloc == 0u) { xcd_barrier_complete(bar, b.x, nloc, nx); b.st[0] = nloc; b.st[1] = nx; }
        const unsigned old = xb_add(&bar[XB_XSUB(b.x)], 1u);
        const unsigned gen = old / nloc;
        if (old + 1u == (gen + 1u) * nloc) {
            __builtin_amdgcn_fence(__ATOMIC_RELEASE, "agent");
            asm volatile("s_waitcnt vmcnt(0)" ::: "memory");
            const unsigned og = xb_add(&bar[XB_TOP], 1u);
            const unsigned tg = og / nx;
            if (og + 1u == (tg + 1u) * nx) xb_add(&bar[XB_TOPGEN], 1u);
            else XB_SPIN(xb_ld(&bar[XB_TOPGEN]) == tg, bar);
            __builtin_amdgcn_fence(__ATOMIC_ACQUIRE, "agent");
            xb_add(&bar[XB_XGEN(b.x)], 1u);
            asm volatile("s_waitcnt vmcnt(0)" ::: "memory");
        } else {
            XB_SPIN(xb_ld(&bar[XB_XGEN(b.x)]) == gen, bar);
            __builtin_amdgcn_fence(__ATOMIC_ACQUIRE, "agent");
            asm volatile("s_waitcnt vmcnt(0)" ::: "memory");
        }
    }
    __syncthreads();
}

namespace pg8 {
constexpr int BM = 256, BK = 64, HALF = 128, HTB = HALF * BK * 2, STAGE_BYTES = 8 * HTB, NXCD = 8, WGM = 8;
__host__ __device__ __forceinline__ int lds_byte(int r, int c) { const int st = (r >> 4) * 2 + (c >> 5), rr = r & 15, cc = c & 31, ob = rr * 64 + cc * 2; return st * 1024 + (ob ^ (((ob >> 9) & 1) << 5)); }
__host__ __device__ __forceinline__ void stage_rc(int b, int& R, int& C) { const int st = b / 1024, sb = b % 1024, swz = sb ^ (((sb >> 9) & 1) << 5); R = (st >> 1) * 16 + swz / 64; C = (st & 1) * 32 + (swz % 64) / 2; }
__host__ __device__ __forceinline__ int perm32(int rho) { const int n = rho >> 4, i = rho & 15; return 8 * (i >> 2) + 4 * n + (i & 3); }

struct Unit { int pm, pn, pb; };
struct Gemm { const bf16_t* A; const bf16_t* Bt; int M, N, K; };

struct StaticOrder {
    int nM, nN, nwg, G, c;
    __device__ void init(int M, int N, int G_, int c_) { nM = M / BM; nN = N / BM; nwg = nM * nN; G = G_; c = c_; }
    __device__ bool next(int i, Unit& u) const {
        const long L = (long)i * G + c; if (L >= nwg) return false;
        int wgid = (int)L; { const int q = nwg / NXCD, r = nwg % NXCD, xcd = wgid % NXCD, off = wgid / NXCD; wgid = (xcd < r ? xcd * (q + 1) : r * (q + 1) + (xcd - r) * q) + off; }
        const int nig = WGM * nN, gid = wgid / nig, fm = gid * WGM, gsz = (nM - fm) < WGM ? (nM - fm) : WGM;
        u.pm = fm + ((wgid % nig) % gsz); u.pn = (wgid % nig) / gsz; u.pb = u.pn; return true;
    }
};
struct MoeOrder : StaticOrder {
    const LAS int* tile_e;
    __device__ bool next(int i, Unit& u) const { if (!StaticOrder::next(i, u)) return false; u.pb = __builtin_amdgcn_readfirstlane(tile_e[u.pm]) * nN + u.pn; return true; }
};

template <class Epi, class Sched, bool FP8 = false>
__device__ __forceinline__ void gemm_phase(LAS unsigned char* lds, const Gemm g, const Sched& S, const Epi& E) {
    const int tid = threadIdx.x, wid = __builtin_amdgcn_readfirstlane(tid >> 6), lane = tid & 63, wr = wid >> 2, wc = wid & 3, fr = lane & 15, fq = lane >> 4;
    const int K = g.K, nt = K / BK;
    unsigned voffA[2], voffB[2];
#pragma unroll
    for (int i = 0; i < 2; ++i) { int R, C; stage_rc(tid * 16 + i * 8192, R, C); const int Rb = Epi::PERM ? ((R & ~31) + perm32(R & 31)) : R;
        voffA[i] = (unsigned)(R * K + C) * 2u; voffB[i] = (unsigned)(Rb * K + C) * 2u; }
    const size_t kstep = (size_t)(BK * 2);
    const size_t hstep = (size_t)HALF * K * 2;
    const size_t tstep = 2 * hstep;
    const unsigned ldsw = (unsigned)wid * 1024u;
    const int aoff = lds_byte(wr * 64 + fr, fq * 8), boff = lds_byte(wc * 32 + fr, fq * 8);
    LAS unsigned char* ldsA = lds + aoff; LAS unsigned char* ldsB = lds + 4 * HTB + boff;
    asm volatile("" : "+v"(ldsA)); asm volatile("" : "+v"(ldsB));
#define PG8_SA(b, h) (((b) * 2 + (h)) * HTB)
#define PG8_SB(b, h) ((4 + (b) * 2 + (h)) * HTB)
#define PG8_STAGE(bufoff, gbase, voff) do { _Pragma("unroll") for (int _i = 0; _i < 2; ++_i) \
        __builtin_amdgcn_global_load_lds((const unsigned*)((const char*)(gbase) + (voff)[_i]), (LAS unsigned*)(lds + (bufoff) + ldsw + _i * 8192), 16, 0, 0); } while (0)
#define PG8_LD2(dst, addr) do { if constexpr (FP8) { const i32x4 lo_ = *(const LAS i32x4*)(addr), hi_ = *(const LAS i32x4*)((addr) + 1024); (dst).w = __builtin_shufflevector(lo_, hi_, 0, 1, 2, 3, 4, 5, 6, 7); } \
        else { (dst).h[0] = *(const LAS bf16x8*)(addr); (dst).h[1] = *(const LAS bf16x8*)((addr) + 1024); } } while (0)
#define PG8_LDA(dst, b, h) do { _Pragma("unroll") for (int m = 0; m < 4; ++m) PG8_LD2(dst[m], ldsA + PG8_SA(b, h) + m * 2048); } while (0)
#define PG8_LDB(dst, b, h) do { _Pragma("unroll") for (int n = 0; n < 2; ++n) PG8_LD2(dst[n], ldsB + PG8_SA(b, h) + n * 2048); } while (0)
#define PG8_MMA(ai, bj, At, Bt) do { __builtin_amdgcn_s_setprio(1); \
        if constexpr (FP8) { _Pragma("unroll") for (int m = 0; m < 4; ++m) _Pragma("unroll") for (int n = 0; n < 2; ++n) \
            asm volatile("v_mfma_f32_16x16x128_f8f6f4 %0, %1, %2, %0" : "+v"(acc[ai][bj][m][n]) : "v"(Bt[n].w), "v"(At[m].w)); } \
        else { _Pragma("unroll") for (int m = 0; m < 4; ++m) _Pragma("unroll") for (int n = 0; n < 2; ++n) _Pragma("unroll") for (int k = 0; k < 2; ++k) \
            acc[ai][bj][m][n] = __builtin_amdgcn_mfma_f32_16x16x32_bf16(Bt[n].h[k], At[m].h[k], acc[ai][bj][m][n], 0, 0, 0); } \
        __builtin_amdgcn_s_setprio(0); } while (0)
#define PG8_WAIT_V(n) asm volatile("s_waitcnt vmcnt(" #n ")" ::: "memory")
#define PG8_WAIT_L(n) asm volatile("s_waitcnt lgkmcnt(" #n ")" ::: "memory")
#define PG8_BAR __builtin_amdgcn_s_barrier()
#define PG8_SCHED __builtin_amdgcn_sched_barrier(0)
    Unit cur, nxt; int ui = 0;
    if (!S.next(0, cur)) return;
    f32x4 acc[2][2][4][2];
#pragma unroll
    for (int a = 0; a < 2; ++a)
#pragma unroll
        for (int b = 0; b < 2; ++b)
#pragma unroll
            for (int m = 0; m < 4; ++m)
#pragma unroll
                for (int n = 0; n < 2; ++n) acc[a][b][m][n] = (f32x4){0.f, 0.f, 0.f, 0.f};
    union Frag { bf16x8 h[2]; i32x8 w; };
    Frag At[4], B0[2], B1[2];
    const char* cA = (const char*)g.A + (size_t)cur.pm * tstep; const char* cB = (const char*)g.Bt + (size_t)cur.pb * tstep;
    PG8_STAGE(PG8_SB(0, 0), cB, voffB); PG8_STAGE(PG8_SB(0, 1), cB + hstep, voffB); PG8_STAGE(PG8_SA(0, 0), cA, voffA); PG8_STAGE(PG8_SA(0, 1), cA + hstep, voffA);
    if (wr == 1) PG8_BAR;
    PG8_WAIT_V(2); PG8_BAR;
    PG8_STAGE(PG8_SB(1, 0), cB + kstep, voffB); PG8_STAGE(PG8_SA(1, 0), cA + kstep, voffA); PG8_STAGE(PG8_SB(1, 1), cB + hstep + kstep, voffB);
    PG8_WAIT_V(6); PG8_BAR;
    for (;;) {
        const bool has_next = S.next(ui + 1, nxt);
        const char* nA = has_next ? (const char*)g.A + (size_t)nxt.pm * tstep : cA; const char* nB = has_next ? (const char*)g.Bt + (size_t)nxt.pb * tstep : cB;
        for (int t = 0; t < nt; t += 2) {
            const bool last = (t == nt - 2);
            const char* a1 = cA + (size_t)(t + 1) * kstep;
            const char* a2 = last ? nA : cA + (size_t)(t + 2) * kstep; const char* b2 = last ? nB : cB + (size_t)(t + 2) * kstep;
            const char* a3 = a2 + kstep; const char* b3 = b2 + kstep;
            PG8_LDB(B0, 0, 0); PG8_LDB(B1, 0, 1); PG8_SCHED; PG8_LDA(At, 0, 0); PG8_STAGE(PG8_SA(1, 1), a1 + hstep, voffA);
            PG8_WAIT_V(8); PG8_WAIT_L(0); PG8_BAR; PG8_MMA(0, 0, At, B0); PG8_MMA(0, 1, At, B1); PG8_BAR; PG8_SCHED;
            PG8_LDA(At, 0, 1); PG8_STAGE(PG8_SB(0, 0), b2, voffB); PG8_STAGE(PG8_SB(0, 1), b2 + hstep, voffB); PG8_STAGE(PG8_SA(0, 0), a2, voffA);
            PG8_WAIT_V(8); PG8_WAIT_L(0); PG8_BAR; PG8_MMA(1, 0, At, B0); PG8_MMA(1, 1, At, B1); PG8_BAR; PG8_SCHED;
            PG8_LDB(B0, 1, 0); PG8_LDB(B1, 1, 1); PG8_SCHED; PG8_LDA(At, 1, 0); PG8_STAGE(PG8_SA(0, 1), a2 + hstep, voffA);
            PG8_WAIT_V(8); PG8_WAIT_L(0); PG8_BAR; PG8_MMA(0, 0, At, B0); PG8_MMA(0, 1, At, B1); PG8_BAR; PG8_SCHED;
            PG8_LDA(At, 1, 1); PG8_STAGE(PG8_SB(1, 0), b3, voffB); PG8_STAGE(PG8_SB(1, 1), b3 + hstep, voffB); PG8_STAGE(PG8_SA(1, 0), a3, voffA);
            PG8_WAIT_V(8); PG8_WAIT_L(0); PG8_BAR; PG8_MMA(1, 0, At, B0); PG8_MMA(1, 1, At, B1); PG8_BAR; PG8_SCHED;
        }
        if (wr == 0) PG8_BAR;
        if constexpr (FP8) asm volatile("s_nop 15\n\ts_nop 15" ::: "memory");
        { int fr_ = fr, fq_ = fq; asm volatile("" : "+v"(fr_), "+v"(fq_));
          E(acc, cur, wr, wc, fr_, fq_); }
        if (!has_next) break;
#pragma unroll
        for (int a = 0; a < 2; ++a)
#pragma unroll
            for (int b = 0; b < 2; ++b)
#pragma unroll
                for (int m = 0; m < 4; ++m)
#pragma unroll
                    for (int n = 0; n < 2; ++n) { acc[a][b][m][n] = (f32x4){0.f, 0.f, 0.f, 0.f}; if constexpr (FP8) asm volatile("" : "+v"(acc[a][b][m][n])); }
        cur = nxt; cA = nA; cB = nB; ++ui;
        if (wr == 1) PG8_BAR;
    }
    PG8_WAIT_V(0);
    PG8_BAR;
#undef PG8_SA
#undef PG8_SB
#undef PG8_STAGE
#undef PG8_LDA
#undef PG8_LDB
#undef PG8_MMA
#undef PG8_LD2
#undef PG8_WAIT_V
#undef PG8_WAIT_L
#undef PG8_BAR
#undef PG8_SCHED
}

struct EpiProj {
    static constexpr bool PERM = true;
    bf16_t* O;
    __device__ __forceinline__ void operator()(const f32x4 (&acc)[2][2][4][2], const Unit& u, int wr, int wc, int fr, int fq) const {
        const int row0 = u.pm * BM + wr * 64 + fr, col0 = u.pn * BM + wc * 32 + 8 * fq;
        const int act = u.pn < 4 ? 1 : (u.pn >= 10 ? 2 : 0);
#pragma unroll
        for (int ai = 0; ai < 2; ++ai)
#pragma unroll
            for (int m = 0; m < 4; ++m) { bf16_t* rowp = O + (size_t)(row0 + ai * HALF + m * 16) * NPROJ + col0;
#pragma unroll
                for (int bj = 0; bj < 2; ++bj) { f32x4 v0 = acc[ai][bj][m][0], v1 = acc[ai][bj][m][1];
                    if (act == 1) { f32x2 a = gelu_pk((f32x2){v0[0], v0[1]}), b = gelu_pk((f32x2){v0[2], v0[3]}), c = gelu_pk((f32x2){v1[0], v1[1]}), d = gelu_pk((f32x2){v1[2], v1[3]});
                        v0 = (f32x4){a.x, a.y, b.x, b.y}; v1 = (f32x4){c.x, c.y, d.x, d.y}; }
                    else if (act == 2) {
#pragma unroll
                        for (int j = 0; j < 4; ++j) { v0[j] = silu_f(v0[j]); v1[j] = silu_f(v1[j]); } }
                    u32x4 w; w.x = cvt_pk_bf16(v0[0], v0[1]); w.y = cvt_pk_bf16(v0[2], v0[3]); w.z = cvt_pk_bf16(v1[0], v1[1]); w.w = cvt_pk_bf16(v1[2], v1[3]);
                    *(u32x4*)(rowp + bj * HALF) = w; } }
    }
};
struct EpiResid {
    static constexpr bool PERM = false;
    const float* X; float* H;
    __device__ __forceinline__ void operator()(const f32x4 (&acc)[2][2][4][2], const Unit& u, int wr, int wc, int fr, int fq) const {
        const int row0 = u.pm * BM + wr * 64 + fr, col0 = u.pn * BM + wc * 32 + 4 * fq;
#pragma unroll
        for (int ai = 0; ai < 2; ++ai)
#pragma unroll
            for (int m = 0; m < 4; ++m) { const size_t off = (size_t)(row0 + ai * HALF + m * 16) * D + col0;
#pragma unroll
                for (int bj = 0; bj < 2; ++bj)
#pragma unroll
                    for (int n = 0; n < 2; ++n) { const f32x4 xv = *(const f32x4*)(X + off + bj * HALF + n * 16); *(f32x4*)(H + off + bj * HALF + n * 16) = acc[ai][bj][m][n] + xv; } }
    }
};
struct EpiSwiglu {
    static constexpr bool PERM = true;
    unsigned char* O; const float* bgu;
    __device__ __forceinline__ void operator()(const f32x4 (&acc)[2][2][4][2], const Unit& u, int wr, int wc, int fr, int fq) const {
        const int row0 = u.pm * BM + wr * 64 + fr, j0 = u.pn * HALF + wc * 32 + 8 * fq, e = u.pb >> 3;
        const float* bg = bgu + (size_t)e * 2048 + j0;
#pragma unroll
        for (int ai = 0; ai < 2; ++ai)
#pragma unroll
            for (int m = 0; m < 4; ++m) { unsigned char* rowp = O + (size_t)(row0 + ai * HALF + m * 16) * DFF + j0;
                u32x2 w;
#pragma unroll
                for (int n = 0; n < 2; ++n) { const f32x4 g4 = acc[ai][0][m][n] * W8_INV + *(const f32x4*)(bg + 4 * n), u4 = acc[ai][1][m][n] * W8_INV + *(const f32x4*)(bg + 1024 + 4 * n); f32x4 r;
#pragma unroll
                    for (int j = 0; j < 4; ++j) { const float ga = fminf(g4[j], 7.0f), ua = fminf(fmaxf(u4[j], -7.0f), 7.0f); r[j] = (ua + 1.0f) * (ga * sigmoid_f(1.702f * ga)); }
                    w[n] = cvt4_fp8(r[0], r[1], r[2], r[3]); }
                *(u32x2*)rowp = w; asm volatile("" ::: "memory"); }
    }
};
struct EpiDown {
    static constexpr bool PERM = true;
    bf16_t* O; const float* bdn; const float* gsort;
    __device__ __forceinline__ void operator()(const f32x4 (&acc)[2][2][4][2], const Unit& u, int wr, int wc, int fr, int fq) const {
        const int row0 = u.pm * BM + wr * 64 + fr, col0 = u.pn * BM + wc * 32 + 8 * fq, e = u.pb >> 2;
        const float* bp = bdn + (size_t)e * D + col0;
#pragma unroll
        for (int ai = 0; ai < 2; ++ai)
#pragma unroll
            for (int m = 0; m < 4; ++m) { const int r = row0 + ai * HALF + m * 16; const float gw = gsort[r]; bf16_t* rowp = O + (size_t)r * D + col0;
#pragma unroll
                for (int bj = 0; bj < 2; ++bj) { const f32x4 v0 = (acc[ai][bj][m][0] * W8_INV + *(const f32x4*)(bp + bj * HALF)) * gw, v1 = (acc[ai][bj][m][1] * W8_INV + *(const f32x4*)(bp + bj * HALF + 4)) * gw;
                    u32x4 w; w.x = cvt_pk_bf16(v0[0], v0[1]); w.y = cvt_pk_bf16(v0[2], v0[3]); w.z = cvt_pk_bf16(v1[0], v1[1]); w.w = cvt_pk_bf16(v1[2], v1[3]);
                    *(u32x4*)(rowp + bj * HALF) = w; } asm volatile("" ::: "memory"); }
    }
};
}

struct Args {
    const float* in[19]; float* out; unsigned char* ws; int ph_lo, ph_hi;
};
struct Frame {
    LAS unsigned char* lds;
    int tid, lane, wave, G, vcu;
    unsigned char* ws;
};
#define MFMA16(a, b, c) __builtin_amdgcn_mfma_f32_16x16x32_bf16((a), (b), (c), 0, 0, 0)

__device__ __forceinline__ void tr_item(const float* src, size_t ldw, bf16_t* dst, LAS float* scr, int lane) {
    f32x4 v[16];
    const int kq = lane >> 4, n4 = 4 * (lane & 15);
#pragma unroll
    for (int i = 0; i < 16; ++i) v[i] = *(const f32x4*)(src + (size_t)(4 * i + kq) * ldw + n4);
#pragma unroll
    for (int i = 0; i < 16; ++i) { LAS float* s = scr + (4 * i + kq) * 65 + n4; s[0] = v[i][0]; s[1] = v[i][1]; s[2] = v[i][2]; s[3] = v[i][3]; }
    LDS_WAIT();
    const int c = lane & 7;
#pragma unroll
    for (int r = 0; r < 8; ++r) { const int n = 8 * r + (lane >> 3); const LAS float* s = scr + (8 * c) * 65 + n;
        u32x4 o; o.x = cvt_pk_bf16(s[0 * 65], s[1 * 65]); o.y = cvt_pk_bf16(s[2 * 65], s[3 * 65]); o.z = cvt_pk_bf16(s[4 * 65], s[5 * 65]); o.w = cvt_pk_bf16(s[6 * 65], s[7 * 65]);
        *(u32x4*)(dst + (size_t)n * 1024 + 8 * c) = o; }
    LDS_WAIT();
}
__device__ __forceinline__ void tr_item8(const float* src, size_t ldw, unsigned char* dst, LAS float* scr, int lane) {
    f32x4 v[16];
    const int kq = lane >> 3, n4 = 4 * (lane & 7);
#pragma unroll
    for (int i = 0; i < 16; ++i) v[i] = *(const f32x4*)(src + (size_t)(8 * i + kq) * ldw + n4);
#pragma unroll
    for (int i = 0; i < 16; ++i) { LAS float* s = scr + (8 * i + kq) * 33 + n4; s[0] = v[i][0]; s[1] = v[i][1]; s[2] = v[i][2]; s[3] = v[i][3]; }
    LDS_WAIT();
    const int c = lane >> 3, nn = lane & 7;
#pragma unroll
    for (int r = 0; r < 4; ++r) { const int n = 8 * r + nn; const LAS float* s = scr + (16 * c) * 33 + n;
        u32x4 o;
#pragma unroll
        for (int q = 0; q < 4; ++q) o[q] = cvt4_fp8(s[(4 * q) * 33] * W8_SCALE, s[(4 * q + 1) * 33] * W8_SCALE, s[(4 * q + 2) * 33] * W8_SCALE, s[(4 * q + 3) * 33] * W8_SCALE);
        *(u32x4*)(dst + (size_t)n * 1024 + 16 * c) = o; }
    LDS_WAIT();
}
__device__ __forceinline__ void p0_prologue(const Frame& F, const Args& a) {
    LAS float* scr = (LAS float*)(F.lds + F.wave * 16896);
    const int gw = F.vcu * NWAVES + F.wave, NGW = F.G * NWAVES;
    const float* w_in = a.in[2]; const float* w_out = a.in[10]; const float* w_gu = a.in[14]; const float* w_dn = a.in[16]; const float* rw = a.in[12];
    bf16_t* WIN = (bf16_t*)(F.ws + WS_WIN); bf16_t* WOUT = (bf16_t*)(F.ws + WS_WOUT); unsigned char* WGU = F.ws + WS_WGU; unsigned char* WDN = F.ws + WS_WDN; bf16_t* RWT = (bf16_t*)(F.ws + WS_RWT);
    constexpr int I_IN = 16 * 48, I_OUT = 16 * 16, I_GU = NE * 8 * 64, I_DN = NE * 8 * 32, NITEMS = I_IN + I_OUT + I_GU + I_DN;
    for (int rep0_ = 0; rep0_ < ((PROBE_DOUBLE) == 20 ? 2 : 1); ++rep0_)
    for (int it = gw; it < NITEMS; it += NGW) {
        int r = it;
        if (r < I_IN) { const int kb = r / 48, nb = r % 48; tr_item(w_in + (size_t)(64 * kb) * DIN + 64 * nb, DIN, WIN + (size_t)(64 * nb) * 1024 + 64 * kb, scr, F.lane); continue; } r -= I_IN;
        if (r < I_OUT) { const int kb = r / 16, nb = r % 16; tr_item(w_out + (size_t)(64 * kb) * D + 64 * nb, D, WOUT + (size_t)(64 * nb) * 1024 + 64 * kb, scr, F.lane); continue; } r -= I_OUT;
        if (r < I_GU) { const int e = r / 512, q = r % 512, kb = q / 64, nb = q % 64; const int c0 = 32 * nb, j = c0 & 1023, drow = (j >> 7) * 256 + (c0 >= 1024 ? 128 : 0) + (j & 127);
            tr_item8(w_gu + (size_t)e * 1024 * 2048 + (size_t)(128 * kb) * 2048 + c0, 2048, WGU + (size_t)e * 2048 * 1024 + (size_t)drow * 1024 + 128 * kb, scr, F.lane); continue; } r -= I_GU;
        { const int e = r / 256, q = r % 256, kb = q / 32, nb = q % 32;
            tr_item8(w_dn + (size_t)e * 1024 * 1024 + (size_t)(128 * kb) * 1024 + 32 * nb, 1024, WDN + (size_t)e * 1024 * 1024 + (size_t)(32 * nb) * 1024 + 128 * kb, scr, F.lane); }
    }
    for (int i = gw * 64 + F.lane; i < 32 * 1024; i += NGW * 64) { const int e = i >> 10, k = i & 1023; RWT[i] = f2bf(rw[(size_t)k * 32 + e]); }
    const float* x = a.in[0]; const float* g1 = a.in[1];
    bf16_t* Y = (bf16_t*)(F.ws + WS_Y); float* AB = (float*)(F.ws + WS_AB);
    f32x4 gv[4]; f32x4 wab[4][4][2];
#pragma unroll
    for (int j = 0; j < 4; ++j) { gv[j] = *(const f32x4*)(g1 + 4 * F.lane + 256 * j);
#pragma unroll
        for (int i = 0; i < 4; ++i) { const float* p = w_in + (size_t)(4 * F.lane + 256 * j + i) * DIN + NPROJ; wab[j][i][0] = *(const f32x4*)p; wab[j][i][1] = *(const f32x4*)(p + 4); } }
    for (int rep1_ = 0; rep1_ < ((PROBE_DOUBLE) == 21 ? 2 : 1); ++rep1_)
    for (int m = gw; m < T; m += NGW) {
        const f32x4* xr = (const f32x4*)(x + (size_t)m * D) + F.lane;
        f32x4 v[4]; float ss = 0.f;
#pragma unroll
        for (int j = 0; j < 4; ++j) { v[j] = xr[64 * j]; ss += (v[j][0] * v[j][0] + v[j][1] * v[j][1]) + (v[j][2] * v[j][2] + v[j][3] * v[j][3]); }
        const float rstd = rsqrtf(wave_sum(ss) * (1.0f / D) + EPS);
        f32x4 p0 = (f32x4){0.f, 0.f, 0.f, 0.f}, p1 = p0;
        u32x2* yo = (u32x2*)(Y + (size_t)m * D) + F.lane;
#pragma unroll
        for (int j = 0; j < 4; ++j) { const f32x4 y = v[j] * rstd * gv[j];
#pragma unroll
            for (int i = 0; i < 4; ++i) { p0 += wab[j][i][0] * y[i]; p1 += wab[j][i][1] * y[i]; }
            u32x2 w; w.x = cvt_pk_bf16(y[0], y[1]); w.y = cvt_pk_bf16(y[2], y[3]); yo[64 * j] = w; }
#pragma unroll
        for (int i = 0; i < 4; ++i) { p0[i] = wave_sum(p0[i]); p1[i] = wave_sum(p1[i]); }
        if (F.lane == 0) { *(f32x4*)(AB + (size_t)m * 8) = p0; *(f32x4*)(AB + (size_t)m * 8 + 4) = p1; }
    }
}

constexpr int GM_LDT = 136;
__device__ __forceinline__ void gmlp_unit(const Frame& F, const Args& a, int unit) {
    const int h = unit & 3, bn = unit >> 2;
    const bf16_t* PROJ = (const bf16_t*)(F.ws + WS_R3); bf16_t* MIX = (bf16_t*)(F.ws + WS_MIX);
    const float* gmg = a.in[3] + h * HD; const float* Wh = a.in[4] + (size_t)h * GMC * GMC; const float* bs = a.in[5] + h * GMC;
    LAS bf16_t* vnT = (LAS bf16_t*)F.lds;
    const size_t row0 = (size_t)bn * GMC;
    {
        const int sp = F.tid >> 3, seg = F.tid & 7;
        const bf16_t* p0 = PROJ + (row0 + 2 * sp) * NPROJ + 512 + h * HD + 16 * seg; const bf16_t* p1 = p0 + NPROJ;
        const u32x4 a0 = *(const u32x4*)p0, a1 = *(const u32x4*)(p0 + 8), b0 = *(const u32x4*)p1, b1 = *(const u32x4*)(p1 + 8);
        float x0[16], x1[16];
#pragma unroll
        for (int i = 0; i < 4; ++i) { x0[2 * i] = bflo(a0[i]); x0[2 * i + 1] = bfhi(a0[i]); x0[8 + 2 * i] = bflo(a1[i]); x0[9 + 2 * i] = bfhi(a1[i]);
                                      x1[2 * i] = bflo(b0[i]); x1[2 * i + 1] = bfhi(b0[i]); x1[8 + 2 * i] = bflo(b1[i]); x1[9 + 2 * i] = bfhi(b1[i]); }
        float s0 = 0.f, s1 = 0.f;
#pragma unroll
        for (int i = 0; i < 16; ++i) { s0 += x0[i] * x0[i]; s1 += x1[i] * x1[i]; }
#pragma unroll
        for (int o = 1; o < 8; o <<= 1) { s0 += __shfl_xor(s0, o); s1 += __shfl_xor(s1, o); }
        const float r0 = rsqrtf(s0 * (1.0f / HD) + EPS), r1 = rsqrtf(s1 * (1.0f / HD) + EPS);
#pragma unroll
        for (int i = 0; i < 16; ++i) { const float gg = gmg[16 * seg + i];
            *(LAS unsigned*)(vnT + (16 * seg + i) * GM_LDT + 2 * sp) = cvt_pk_bf16(x0[i] * r0 * gg, x1[i] * r1 * gg); }
    }
    const int fr = F.lane & 15, fq = F.lane >> 4, trow = 16 * F.wave + fr;
    bf16x8 af[4];
#pragma unroll
    for (int kk = 0; kk < 4; ++kk) { const int s0 = 32 * kk + 8 * fq; const float* wp = Wh + (size_t)trow * GMC + s0;
        const f32x4 w0 = *(const f32x4*)wp, w1 = *(const f32x4*)(wp + 4); float wv[8] = {w0[0], w0[1], w0[2], w0[3], w1[0], w1[1], w1[2], w1[3]};
#pragma unroll
        for (int j = 0; j < 8; ++j) if (s0 + j > trow) wv[j] = 0.f;
        u32x4 pk; pk.x = cvt_pk_bf16(wv[0], wv[1]); pk.y = cvt_pk_bf16(wv[2], wv[3]); pk.z = cvt_pk_bf16(wv[4], wv[5]); pk.w = cvt_pk_bf16(wv[6], wv[7]);
        af[kk] = __builtin_bit_cast(bf16x8, pk); }
    LDS_WAIT(); __syncthreads();
    f32x4 acc[8];
#pragma unroll
    for (int nt = 0; nt < 8; ++nt) { acc[nt] = (f32x4){0.f, 0.f, 0.f, 0.f};
#pragma unroll
        for (int kk = 0; kk < 4; ++kk) { const bf16x8 bfr = *(const LAS bf16x8*)(vnT + (16 * nt + fr) * GM_LDT + 32 * kk + 8 * fq); acc[nt] = MFMA16(af[kk], bfr, acc[nt]); } }
#pragma unroll
    for (int r = 0; r < 4; ++r) { const int t = 16 * F.wave + 4 * fq + r; const float bias = bs[t];
        const bf16_t* up = PROJ + (row0 + t) * NPROJ + h * HD + fr; bf16_t* op = MIX + (row0 + t) * D + h * HD + fr;
#pragma unroll
        for (int nt = 0; nt < 8; ++nt) op[16 * nt] = f2bf(bf2f(up[16 * nt]) * (acc[nt][r] + bias)); }
    __syncthreads();
}

constexpr int DN_QS = 0;
constexpr int DN_KS = 17408;
constexpr int DN_KT = 34816;
constexpr int DN_XT = 53248;
constexpr int DN_LN = 90112;
constexpr int DN_LD = 99328;
constexpr int DN_TI = 103680;
constexpr int DN_YT = 106752;
constexpr int DN_GC = 119040;
static_assert(DN_GC + 768 <= RING_BYTES, "DeltaNet chunk LDS map");
__device__ __forceinline__ void dn_chunk(const Frame& F, const Args& a, int unit) {
    const int n = unit & 63, bh = unit >> 6, h = bh & 3, b = bh >> 2;
    const bf16_t* PROJ = (const bf16_t*)(F.ws + WS_R3); const float* AB = (const float*)(F.ws + WS_AB);
    const float* cw = a.in[6];
    LAS unsigned char* L = F.lds;
    LAS bf16_t* qs = (LAS bf16_t*)(L + DN_QS); LAS bf16_t* ks = (LAS bf16_t*)(L + DN_KS); LAS bf16_t* kT = (LAS bf16_t*)(L + DN_KT); LAS bf16_t* XT = (LAS bf16_t*)(L + DN_XT);
    LAS bf16_t* Ln = (LAS bf16_t*)(L + DN_LN); LAS float* Ld = (LAS float*)(L + DN_LD); LAS bf16_t* Ti = (LAS bf16_t*)(L + DN_TI); LAS bf16_t* YT = (LAS bf16_t*)(L + DN_YT + F.wave * 1536);
    LAS float* gcs = (LAS float*)(L + DN_GC); LAS float* bts = gcs + 64; LAS float* egs = gcs + 128;
    const size_t trow0 = (size_t)b * SEQ + (size_t)n * DNC;
    const int fr = F.lane & 15, fq = F.lane >> 4;
    float my_gc, my_beta, my_eg;
    {
        const float av = AB[(trow0 + F.lane) * 8 + h], bv = AB[(trow0 + F.lane) * 8 + 4 + h];
        const float xg = av + a.in[8][h];
        const float sp = xg > 20.f ? xg : log1pf(__expf(xg));
        float g = -__expf(a.in[7][h]) * sp;
#pragma unroll
        for (int o = 1; o < 64; o <<= 1) { const float t = __shfl_up(g, o); if (F.lane >= o) g += t; }
        my_gc = g; my_beta = sigmoid_f(bv); my_eg = __expf(g);
        if (F.wave == 0) { gcs[F.lane] = my_gc; bts[F.lane] = my_beta; egs[F.lane] = my_eg; }
    }
    bf16_t* QDg = (bf16_t*)(F.ws + WS_QD) + (size_t)unit * 64 * 128;
#pragma unroll
    for (int ten = 0; ten < 3; ++ten) {
        const int ch = ten * 512 + h * HD + 8 * fr;
        f32x4 w0[4], w1[4];
#pragma unroll
        for (int j = 0; j < 4; ++j) { w0[j] = *(const f32x4*)(cw + (size_t)j * 1536 + ch); w1[j] = *(const f32x4*)(cw + (size_t)j * 1536 + ch + 4); }
        u32x4 xv[2][4];
#pragma unroll
        for (int hp = 0; hp < 2; ++hp) { const int pos = hp * 32 + 4 * F.wave + fq;
#pragma unroll
            for (int j = 0; j < 4; ++j) { const int sp = n * DNC + pos - 3 + j;
                xv[hp][j] = (sp >= 0) ? *(const u32x4*)(PROJ + ((size_t)b * SEQ + sp) * NPROJ + 1024 + ch) : (u32x4){0u, 0u, 0u, 0u}; } }
#pragma unroll
        for (int hp = 0; hp < 2; ++hp) { const int pos = hp * 32 + 4 * F.wave + fq;
            float accv[8];
#pragma unroll
            for (int i = 0; i < 8; ++i) accv[i] = 0.f;
#pragma unroll
            for (int j = 0; j < 4; ++j) { const u32x4 x = xv[hp][j];
                accv[0] += bflo(x[0]) * w0[j][0]; accv[1] += bfhi(x[0]) * w0[j][1]; accv[2] += bflo(x[1]) * w0[j][2]; accv[3] += bfhi(x[1]) * w0[j][3];
                accv[4] += bflo(x[2]) * w1[j][0]; accv[5] += bfhi(x[2]) * w1[j][1]; accv[6] += bflo(x[3]) * w1[j][2]; accv[7] += bfhi(x[3]) * w1[j][3]; }
            float ss = 0.f;
#pragma unroll
            for (int i = 0; i < 8; ++i) { accv[i] = silu_f(accv[i]); ss += accv[i] * accv[i]; }
#pragma unroll
            for (int o = 1; o < 16; o <<= 1) ss += __shfl_xor(ss, o);
            const float bp = __shfl(my_beta, pos), ep = __shfl(my_eg, pos);
            if (ten == 0) { const float sc = rsqrtf(ss + EPS) * 0.08838834764831845f;
#pragma unroll
                for (int i = 0; i < 8; ++i) accv[i] *= sc;
                u32x4 w; w.x = cvt_pk_bf16(accv[0], accv[1]); w.y = cvt_pk_bf16(accv[2], accv[3]); w.z = cvt_pk_bf16(accv[4], accv[5]); w.w = cvt_pk_bf16(accv[6], accv[7]);
                *(LAS u32x4*)(qs + pos * 136 + 8 * fr) = w;
                u32x4 wd; wd.x = cvt_pk_bf16(accv[0] * ep, accv[1] * ep); wd.y = cvt_pk_bf16(accv[2] * ep, accv[3] * ep); wd.z = cvt_pk_bf16(accv[4] * ep, accv[5] * ep); wd.w = cvt_pk_bf16(accv[6] * ep, accv[7] * ep);
                *(u32x4*)(QDg + pos * 128 + 8 * fr) = wd;
            } else if (ten == 1) { const float sc = rsqrtf(ss + EPS);
#pragma unroll
                for (int i = 0; i < 8; ++i) accv[i] *= sc;
                u32x4 w; w.x = cvt_pk_bf16(accv[0], accv[1]); w.y = cvt_pk_bf16(accv[2], accv[3]); w.z = cvt_pk_bf16(accv[4], accv[5]); w.w = cvt_pk_bf16(accv[6], accv[7]);
                *(LAS u32x4*)(ks + pos * 136 + 8 * fr) = w;
                const float rs = bp * ep;
#pragma unroll
                for (int i = 0; i < 8; ++i) { kT[(8 * fr + i) * 72 + pos] = f2bf(accv[i]); XT[(128 + 8 * fr + i) * 72 + pos] = f2bf(accv[i] * rs); }
            } else {
#pragma unroll
                for (int i = 0; i < 8; ++i) XT[(8 * fr + i) * 72 + pos] = f2bf(accv[i] * bp);
            }
        }
    }
    LDS_WAIT(); __syncthreads();
    bf16_t* ATg = (bf16_t*)(F.ws + WS_AT) + (size_t)unit * 64 * 64;
    {
        const int mt = F.wave & 3; const LAS bf16_t* Asrc = (F.wave < 4) ? ks : qs;
        f32x4 acc[4];
#pragma unroll
        for (int nt = 0; nt < 4; ++nt) acc[nt] = (f32x4){0.f, 0.f, 0.f, 0.f};
#pragma unroll
        for (int kk = 0; kk < 4; ++kk) { const bf16x8 af = *(const LAS bf16x8*)(Asrc + (16 * mt + fr) * 136 + 32 * kk + 8 * fq);
#pragma unroll
            for (int nt = 0; nt < 4; ++nt) { const bf16x8 bfr = *(const LAS bf16x8*)(ks + (16 * nt + fr) * 136 + 32 * kk + 8 * fq); acc[nt] = MFMA16(af, bfr, acc[nt]); } }
#pragma unroll
        for (int r = 0; r < 4; ++r) { const int i = 16 * mt + 4 * fq + r; const float gi = gcs[i], bi = bts[i];
#pragma unroll
            for (int nt = 0; nt < 4; ++nt) { const int j = 16 * nt + fr; const float dec = __expf(fminf(gi - gcs[j], 0.f));
                if (F.wave < 4) { const float lv = (j < i) ? bi * acc[nt][r] * dec : 0.f; Ln[i * 72 + j] = f2bf(-lv); if (nt == mt) Ld[(mt * 16 + 4 * fq + r) * 17 + fr] = lv; }
                else ATg[i * 64 + j] = f2bf((j <= i) ? acc[nt][r] * dec : 0.f); } }
    }
    LDS_WAIT(); __syncthreads();
    if (F.wave == 0) {
        const int blk = fq, c = fr;
        float t[16];
#pragma unroll
        for (int i = 0; i < 16; ++i) { float s = (i == c) ? 1.f : 0.f;
#pragma unroll
            for (int j = 0; j < i; ++j) s -= Ld[(blk * 16 + i) * 17 + j] * t[j];
            t[i] = s; }
#pragma unroll
        for (int i = 0; i < 16; ++i) Ti[(16 * blk + i) * 24 + c] = f2bf(t[i]);
    } else {
        bf16_t* KETg = (bf16_t*)(F.ws + WS_KET) + (size_t)unit * 128 * 64;
        const float glast = gcs[63];
        for (int idx = F.tid - 64; idx < 128 * 8; idx += NTHREADS - 64) {
            const int d = idx >> 3, gp = idx & 7;
            const u32x4 v = *(const LAS u32x4*)(kT + d * 72 + 8 * gp); u32x4 w;
#pragma unroll
            for (int i = 0; i < 4; ++i) w[i] = cvt_pk_bf16(bflo(v[i]) * __expf(glast - gcs[8 * gp + 2 * i]), bfhi(v[i]) * __expf(glast - gcs[8 * gp + 2 * i + 1]));
            *(u32x4*)(KETg + d * 64 + 8 * gp) = w;
        }
        if (F.tid == 64) ((float*)(F.ws + WS_GLAST))[unit] = __expf(glast);
    }
    LDS_WAIT(); __syncthreads();
    {
        bf16_t* Og = (bf16_t*)(F.ws + (F.wave < 4 ? WS_UC : WS_WC)) + (size_t)unit * 64 * 128;
        const int ncol0 = (F.wave & 3) * 32;
        const bf16x8 zf = (bf16x8){0, 0, 0, 0, 0, 0, 0, 0};
#pragma unroll
        for (int bb = 0; bb < 4; ++bb) {
            f32x4 acc[2];
#pragma unroll
            for (int t = 0; t < 2; ++t) { const u32x2 rv = *(const LAS u32x2*)(XT + (32 * F.wave + 16 * t + fr) * 72 + 16 * bb + 4 * fq);
                acc[t] = (f32x4){bflo(rv.x), bfhi(rv.x), bflo(rv.y), bfhi(rv.y)}; }
            if (bb >= 1) {
#pragma unroll
                for (int kk = 0; kk < 2; ++kk) if (32 * kk < 16 * bb) {
                    bf16x8 af = *(const LAS bf16x8*)(Ln + (16 * bb + fr) * 72 + 32 * kk + 8 * fq);
                    if (32 * kk + 8 * fq >= 16 * bb) af = zf;
#pragma unroll
                    for (int t = 0; t < 2; ++t) { const bf16x8 bfr = *(const LAS bf16x8*)(XT + (32 * F.wave + 16 * t + fr) * 72 + 32 * kk + 8 * fq); acc[t] = MFMA16(af, bfr, acc[t]); }
                }
            }
#pragma unroll
            for (int t = 0; t < 2; ++t) { u32x2 w; w.x = cvt_pk_bf16(acc[t][0], acc[t][1]); w.y = cvt_pk_bf16(acc[t][2], acc[t][3]); *(LAS u32x2*)(YT + (16 * t + fr) * 24 + 4 * fq) = w; }
            LDS_WAIT();
            bf16x8 a2 = *(const LAS bf16x8*)(Ti + (16 * bb + fr) * 24 + 8 * (fq & 1));
            if (fq >= 2) a2 = zf;
#pragma unroll
            for (int t = 0; t < 2; ++t) { bf16x8 b2 = *(const LAS bf16x8*)(YT + (16 * t + fr) * 24 + 8 * (fq & 1)); if (fq >= 2) b2 = zf;
                f32x4 x = MFMA16(a2, b2, ((f32x4){0.f, 0.f, 0.f, 0.f}));
                u32x2 w; w.x = cvt_pk_bf16(x[0], x[1]); w.y = cvt_pk_bf16(x[2], x[3]);
                *(LAS u32x2*)(XT + (32 * F.wave + 16 * t + fr) * 72 + 16 * bb + 4 * fq) = w;
                if (F.wave < 4) *(u32x2*)(Og + (ncol0 + 16 * t + fr) * 64 + 16 * bb + 4 * fq) = w;
                else {
#pragma unroll
                    for (int r = 0; r < 4; ++r) Og[(16 * bb + 4 * fq + r) * 128 + ncol0 + 16 * t + fr] = f2bf(x[r]); } }
            LDS_WAIT();
        }
    }
    LDS_WAIT(); __syncthreads();
}

constexpr int SC_WC = 0, SC_QD = 17408, SC_AT = 34816, SC_KE = 44032, SC_UC = 62464, SC_GL = 64512, SC_BUF = 64768;
constexpr int SC_ST = 2 * SC_BUF, SC_VT = SC_ST + 4352, SC_OT = SC_VT + 2304;
static_assert(SC_OT + 8192 <= RING_BYTES, "scan LDS map");
struct ScanRegs { u32x4 v[9]; float gl; };
__device__ __forceinline__ void scan_load(const Frame& F, ScanRegs& R, size_t cu, int sl, int ltid, int nld) {
    asm volatile("" : "+v"(ltid));
    const bf16_t* wc = (const bf16_t*)(F.ws + WS_WC) + cu * 8192; const bf16_t* qd = (const bf16_t*)(F.ws + WS_QD) + cu * 8192; const bf16_t* uc = (const bf16_t*)(F.ws + WS_UC) + cu * 8192 + (size_t)sl * 16 * 64;
    const bf16_t* ke = (const bf16_t*)(F.ws + WS_KET) + cu * 8192; const bf16_t* at = (const bf16_t*)(F.ws + WS_AT) + cu * 4096;
#pragma unroll
    for (int i = 0; i < 9; ++i) { const int p = ltid + i * nld;
        const bf16_t* src = wc;
        if (p < 1024) src = wc + (p >> 4) * 128 + (p & 15) * 8;
        else if (p < 2048) src = qd + ((p - 1024) >> 4) * 128 + (p & 15) * 8;
        else if (p < 2560) src = at + (p - 2048) * 8;
        else if (p < 3584) src = ke + (p - 2560) * 8;
        else if (p < 3712) src = uc + (p - 3584) * 8;
        R.v[i] = (p < 3712) ? *(const u32x4*)src : (u32x4){0u, 0u, 0u, 0u}; }
    R.gl = (ltid == 0) ? ((const float*)(F.ws + WS_GLAST))[cu] : 0.f;
}
__device__ __forceinline__ void scan_store(LAS unsigned char* buf, const ScanRegs& R, int ltid, int nld) {
    asm volatile("" : "+v"(ltid));
    if (ltid == 0) *(LAS float*)(buf + SC_GL) = R.gl;
#pragma unroll
    for (int i = 0; i < 9; ++i) { const int p = ltid + i * nld;
        LAS unsigned char* dst = buf;
        if (p < 1024) dst = buf + SC_WC + ((p >> 4) * 136 + (p & 15) * 8) * 2;
        else if (p < 2048) dst = buf + SC_QD + (((p - 1024) >> 4) * 136 + (p & 15) * 8) * 2;
        else if (p < 2560) dst = buf + SC_AT + (((p - 2048) >> 3) * 72 + (p & 7) * 8) * 2;
        else if (p < 3584) dst = buf + SC_KE + (((p - 2560) >> 3) * 72 + (p & 7) * 8) * 2;
        else dst = buf + SC_UC + (p - 3584) * 16;
        if (p < 3712) *(LAS u32x4*)dst = R.v[i]; }
}
__device__ __forceinline__ void dn_scan(const Frame& F, int item) {
    const int bh = item >> 3, sl = item & 7, h = bh & 3, b = bh >> 2;
    LAS bf16_t* ST = (LAS bf16_t*)(F.lds + SC_ST); LAS bf16_t* VT = (LAS bf16_t*)(F.lds + SC_VT);
    const int fr = F.lane & 15, fq = F.lane >> 4;
    float* Og = (float*)(F.ws + WS_O);
    f32x4 S[8];
#pragma unroll
    for (int mt = 0; mt < 8; ++mt) S[mt] = (f32x4){0.f, 0.f, 0.f, 0.f};
    if (F.wave == 0) {
#pragma unroll
        for (int mt = 0; mt < 8; ++mt) *(LAS u32x2*)(ST + fr * 136 + 16 * mt + 4 * fq) = (u32x2){0u, 0u};
    }
    ScanRegs R;
    scan_load(F, R, (size_t)bh * NCH, sl, F.tid, NTHREADS); scan_store(F.lds, R, F.tid, NTHREADS);
    if (F.wave != 0) scan_load(F, R, (size_t)bh * NCH + 1, sl, F.tid - 64, NTHREADS - 64);
    LDS_WAIT(); __syncthreads();
#pragma unroll 1
    for (int n = 0; n < NCH; ++n) {
        LAS unsigned char* buf = F.lds + (n & 1) * SC_BUF;
        if (F.wave != 0) {
            if (n + 1 < NCH) scan_store(F.lds + ((n + 1) & 1) * SC_BUF, R, F.tid - 64, NTHREADS - 64);
            if (n + 2 < NCH) scan_load(F, R, (size_t)bh * NCH + n + 2, sl, F.tid - 64, NTHREADS - 64);
            if (n >= 1 && F.tid < 320) {
                const int q = F.tid - 64, pos = q >> 2, e4 = (q & 3) * 4; const LAS float* OT = (const LAS float*)(F.lds + SC_OT + ((n - 1) & 1) * 4096);
                const f32x4 ov = (f32x4){OT[e4 * 64 + pos], OT[(e4 + 1) * 64 + pos], OT[(e4 + 2) * 64 + pos], OT[(e4 + 3) * 64 + pos]};
                *(f32x4*)(Og + ((size_t)b * SEQ + (size_t)(n - 1) * DNC + pos) * 512 + h * HD + 16 * sl + e4) = ov; }
        } else {
            const LAS bf16_t* wc = (const LAS bf16_t*)(buf + SC_WC); const LAS bf16_t* qd = (const LAS bf16_t*)(buf + SC_QD); const LAS bf16_t* at = (const LAS bf16_t*)(buf + SC_AT);
            const LAS bf16_t* ke = (const LAS bf16_t*)(buf + SC_KE); const LAS bf16_t* uc = (const LAS bf16_t*)(buf + SC_UC);
            bf16x8 sb[4];
#pragma unroll
            for (int kk = 0; kk < 4; ++kk) sb[kk] = *(const LAS bf16x8*)(ST + fr * 136 + 32 * kk + 8 * fq);
            f32x4 vn[4], oo[4];
#pragma unroll
            for (int hf = 0; hf < 2; ++hf) {
                bf16x8 aw[2][4], aq[2][4];
#pragma unroll
                for (int m2 = 0; m2 < 2; ++m2)
#pragma unroll
                    for (int kk = 0; kk < 4; ++kk) { aw[m2][kk] = *(const LAS bf16x8*)(wc + (16 * (2 * hf + m2) + fr) * 136 + 32 * kk + 8 * fq); aq[m2][kk] = *(const LAS bf16x8*)(qd + (16 * (2 * hf + m2) + fr) * 136 + 32 * kk + 8 * fq); }
                __builtin_amdgcn_sched_barrier(0);
#pragma unroll
                for (int m2 = 0; m2 < 2; ++m2) { const int mt = 2 * hf + m2; vn[mt] = (f32x4){0.f, 0.f, 0.f, 0.f}; oo[mt] = (f32x4){0.f, 0.f, 0.f, 0.f}; }
#pragma unroll
                for (int kk = 0; kk < 4; ++kk)
#pragma unroll
                    for (int m2 = 0; m2 < 2; ++m2) { const int mt = 2 * hf + m2; vn[mt] = MFMA16(aw[m2][kk], sb[kk], vn[mt]); oo[mt] = MFMA16(aq[m2][kk], sb[kk], oo[mt]); }
                __builtin_amdgcn_sched_barrier(0);
            }
            u32x2 uvv[4];
#pragma unroll
            for (int mt = 0; mt < 4; ++mt) uvv[mt] = *(const LAS u32x2*)(uc + fr * 64 + 16 * mt + 4 * fq);
            __builtin_amdgcn_sched_barrier(0);
#pragma unroll
            for (int mt = 0; mt < 4; ++mt) { const u32x2 uv = uvv[mt];
                vn[mt][0] = bflo(uv.x) - vn[mt][0]; vn[mt][1] = bfhi(uv.x) - vn[mt][1]; vn[mt][2] = bflo(uv.y) - vn[mt][2]; vn[mt][3] = bfhi(uv.y) - vn[mt][3];
                u32x2 w; w.x = cvt_pk_bf16(vn[mt][0], vn[mt][1]); w.y = cvt_pk_bf16(vn[mt][2], vn[mt][3]);
                *(LAS u32x2*)(VT + fr * 72 + 16 * mt + 4 * fq) = w; }
            LDS_WAIT();
            bf16x8 vb[2];
#pragma unroll
            for (int kk = 0; kk < 2; ++kk) vb[kk] = *(const LAS bf16x8*)(VT + fr * 72 + 32 * kk + 8 * fq);
            bf16x8 aa[4][2];
#pragma unroll
            for (int mt = 0; mt < 4; ++mt)
#pragma unroll
                for (int kk = 0; kk < 2; ++kk) aa[mt][kk] = *(const LAS bf16x8*)(at + (16 * mt + fr) * 72 + 32 * kk + 8 * fq);
            bf16x8 ak[8][2];
#pragma unroll
            for (int mt = 0; mt < 4; ++mt)
#pragma unroll
                for (int kk = 0; kk < 2; ++kk) ak[mt][kk] = *(const LAS bf16x8*)(ke + (16 * mt + fr) * 72 + 32 * kk + 8 * fq);
            const float dec = *(const LAS float*)(buf + SC_GL);
            __builtin_amdgcn_sched_barrier(0);
#pragma unroll
            for (int mt = 0; mt < 4; ++mt) {
#pragma unroll
                for (int kk = 0; kk < 2; ++kk) oo[mt] = MFMA16(aa[mt][kk], vb[kk], oo[mt]); }
#pragma unroll
            for (int mt = 4; mt < 8; ++mt)
#pragma unroll
                for (int kk = 0; kk < 2; ++kk) ak[mt][kk] = *(const LAS bf16x8*)(ke + (16 * mt + fr) * 72 + 32 * kk + 8 * fq);
            __builtin_amdgcn_sched_barrier(0);
#pragma unroll
            for (int mt = 0; mt < 8; ++mt) { S[mt] = S[mt] * dec;
#pragma unroll
                for (int kk = 0; kk < 2; ++kk) S[mt] = MFMA16(ak[mt][kk], vb[kk], S[mt]); }
            __builtin_amdgcn_sched_barrier(0);
#pragma unroll
            for (int mt = 0; mt < 8; ++mt) { u32x2 w; w.x = cvt_pk_bf16(S[mt][0], S[mt][1]); w.y = cvt_pk_bf16(S[mt][2], S[mt][3]);
                *(LAS u32x2*)(ST + fr * 136 + 16 * mt + 4 * fq) = w; }
            LAS float* OT = (LAS float*)(F.lds + SC_OT + (n & 1) * 4096);
#pragma unroll
            for (int mt = 0; mt < 4; ++mt) *(LAS f32x4*)(OT + fr * 64 + 16 * mt + 4 * fq) = oo[mt];
        }
        LDS_WAIT(); __builtin_amdgcn_s_barrier(); asm volatile("" ::: "memory");
    }
    if (F.tid >= 64 && F.tid < 320) {
        const int q = F.tid - 64, pos = q >> 2, e4 = (q & 3) * 4; const LAS float* OT = (const LAS float*)(F.lds + SC_OT + ((NCH - 1) & 1) * 4096);
        const f32x4 ov = (f32x4){OT[e4 * 64 + pos], OT[(e4 + 1) * 64 + pos], OT[(e4 + 2) * 64 + pos], OT[(e4 + 3) * 64 + pos]};
        *(f32x4*)(Og + ((size_t)b * SEQ + (size_t)(NCH - 1) * DNC + pos) * 512 + h * HD + 16 * sl + e4) = ov; }
    LDS_WAIT(); __syncthreads();
}

__device__ __forceinline__ void dn_out(const Frame& F, const Args& a) {
    const int gw = F.vcu * NWAVES + F.wave, NGW = F.G * NWAVES;
    const float* Og = (const float*)(F.ws + WS_O); const bf16_t* PROJ = (const bf16_t*)(F.ws + WS_R3); bf16_t* MIX = (bf16_t*)(F.ws + WS_MIX);
    const float* ng = a.in[9] + 8 * (F.lane & 15);
    const f32x4 g0 = *(const f32x4*)ng, g1 = *(const f32x4*)(ng + 4);
    for (int m = gw; m < T; m += NGW) {
        const float* op = Og + (size_t)m * 512 + 8 * F.lane;
        f32x4 o0 = *(const f32x4*)op, o1 = *(const f32x4*)(op + 4);
        const u32x4 z = *(const u32x4*)(PROJ + (size_t)m * NPROJ + 2560 + 8 * F.lane);
        float ss = (o0[0] * o0[0] + o0[1] * o0[1]) + (o0[2] * o0[2] + o0[3] * o0[3]) + (o1[0] * o1[0] + o1[1] * o1[1]) + (o1[2] * o1[2] + o1[3] * o1[3]);
#pragma unroll
        for (int o = 1; o < 16; o <<= 1) ss += __shfl_xor(ss, o);
        const float rstd = rsqrtf(ss * (1.0f / HD) + EPS);
        o0 = o0 * rstd * g0; o1 = o1 * rstd * g1;
        u32x4 w; w.x = cvt_pk_bf16(o0[0] * bflo(z[0]), o0[1] * bfhi(z[0])); w.y = cvt_pk_bf16(o0[2] * bflo(z[1]), o0[3] * bfhi(z[1]));
        w.z = cvt_pk_bf16(o1[0] * bflo(z[2]), o1[1] * bfhi(z[2])); w.w = cvt_pk_bf16(o1[2] * bflo(z[3]), o1[3] * bfhi(z[3]));
        *(u32x4*)(MIX + (size_t)m * D + 512 + 8 * F.lane) = w;
    }
}

__device__ __forceinline__ void norm_h(const Frame& F, const Args& a) {
    const int gw = F.vcu * NWAVES + F.wave, NGW = F.G * NWAVES;
    const float* H = (const float*)(F.ws + WS_H); bf16_t* HN = (bf16_t*)(F.ws + WS_HN); const float* g2 = a.in[11];
    f32x4 gv[4];
#pragma unroll
    for (int j = 0; j < 4; ++j) gv[j] = *(const f32x4*)(g2 + 4 * F.lane + 256 * j);
    for (int m = gw; m < T; m += NGW) {
        const f32x4* xr = (const f32x4*)(H + (size_t)m * D) + F.lane;
        f32x4 v[4]; float ss = 0.f;
#pragma unroll
        for (int j = 0; j < 4; ++j) { v[j] = xr[64 * j]; ss += (v[j][0] * v[j][0] + v[j][1] * v[j][1]) + (v[j][2] * v[j][2] + v[j][3] * v[j][3]); }
        const float rstd = rsqrtf(wave_sum(ss) * (1.0f / D) + EPS);
        u32x2* yo = (u32x2*)(HN + (size_t)m * D) + F.lane; unsigned* y8 = (unsigned*)(F.ws + WS_HN8 + (size_t)m * D) + F.lane;
#pragma unroll
        for (int j = 0; j < 4; ++j) { const f32x4 y = v[j] * rstd * gv[j]; u32x2 w; w.x = cvt_pk_bf16(y[0], y[1]); w.y = cvt_pk_bf16(y[2], y[3]); yo[64 * j] = w; y8[64 * j] = cvt4_fp8(y[0], y[1], y[2], y[3]); }
    }
}

__device__ __forceinline__ void router(const Frame& F, const Args& a) {
    const int gw = F.vcu * NWAVES + F.wave, NGW = F.G * NWAVES;
    const bf16_t* HN = (const bf16_t*)(F.ws + WS_HN); const bf16_t* RWT = (const bf16_t*)(F.ws + WS_RWT); const float* rb = a.in[13];
    int* EIDX = (int*)(F.ws + WS_EIDX); float* GATEW = (float*)(F.ws + WS_GATEW); int* EPOS = (int*)(F.ws + WS_EPOS); int* LIST = (int*)(F.ws + WS_LIST);
    unsigned* cnt = (unsigned*)(F.ws + WS_CTL) + CW_CNT;
    LAS float* lg = (LAS float*)(F.lds + F.wave * 2304);
    const int fr = F.lane & 15, fq = F.lane >> 4;
    for (int tile = gw; tile < T / 16; tile += NGW) {
        const size_t r0 = (size_t)tile * 16;
        f32x4 acc0 = (f32x4){0.f, 0.f, 0.f, 0.f}, acc1 = acc0;
#pragma unroll 4
        for (int kk = 0; kk < 32; ++kk) {
            const bf16x8 af = *(const bf16x8*)(HN + (r0 + fr) * D + 32 * kk + 8 * fq);
            const bf16x8 b0 = *(const bf16x8*)(RWT + (size_t)fr * D + 32 * kk + 8 * fq), b1 = *(const bf16x8*)(RWT + (size_t)(16 + fr) * D + 32 * kk + 8 * fq);
            acc0 = MFMA16(af, b0, acc0); acc1 = MFMA16(af, b1, acc1);
        }
        const float bb0 = rb[fr], bb1 = rb[16 + fr];
#pragma unroll
        for (int r = 0; r < 4; ++r) { lg[(4 * fq + r) * 36 + fr] = acc0[r] + bb0; lg[(4 * fq + r) * 36 + 16 + fr] = acc1[r] + bb1; }
        LDS_WAIT();
        if (F.lane < 16) {
            const int row = F.lane; const size_t t = r0 + row;
            float v[32];
#pragma unroll
            for (int q = 0; q < 8; ++q) { const f32x4 x = *(const LAS f32x4*)(lg + row * 36 + 4 * q); v[4 * q] = x[0]; v[4 * q + 1] = x[1]; v[4 * q + 2] = x[2]; v[4 * q + 3] = x[3]; }
            float tv[4]; int ti[4];
#pragma unroll
            for (int k = 0; k < 4; ++k) { float best = -3.0e38f; int bi = 0;
#pragma unroll
                for (int e = 0; e < 32; ++e) { if (v[e] > best) { best = v[e]; bi = e; } }
                tv[k] = best; ti[k] = bi;
#pragma unroll
                for (int e = 0; e < 32; ++e) v[e] = (e == bi) ? -3.0e38f : v[e]; }
            const float e1 = __expf(tv[1] - tv[0]), e2 = __expf(tv[2] - tv[0]), e3 = __expf(tv[3] - tv[0]); const float inv = 1.0f / (1.0f + e1 + e2 + e3);
            const float gk[4] = {inv, e1 * inv, e2 * inv, e3 * inv};
#pragma unroll
            for (int k = 0; k < 4; ++k) {
                const unsigned pos = __hip_atomic_fetch_add(cnt + 64 * ti[k], 1u, __ATOMIC_RELAXED, __HIP_MEMORY_SCOPE_AGENT);
                EIDX[t * 4 + k] = ti[k]; GATEW[t * 4 + k] = gk[k]; EPOS[t * 4 + k] = (int)pos; LIST[(size_t)ti[k] * T + pos] = (int)(t * 4 + k);
            }
        }
        LDS_WAIT();
    }
}

constexpr int TB_OFF = 131072;
__device__ __forceinline__ void build_tables(const Frame& F) {
    LAS int* pst = (LAS int*)(F.lds + TB_OFF); LAS int* cn = pst + 40; LAS int* tile_e = pst + 80;
    const unsigned* cnt = (const unsigned*)(F.ws + WS_CTL) + CW_CNT;
    if (F.tid < 64) {
        const int e = F.lane & 31; const int c = (int)__hip_atomic_load(cnt + 64 * e, __ATOMIC_RELAXED, __HIP_MEMORY_SCOPE_AGENT);
        const int padded = (c + 255) & ~255;
        int incl = padded;
#pragma unroll
        for (int o = 1; o < 32; o <<= 1) { const int t = __shfl_up(incl, o); if (e >= o) incl += t; }
        if (F.lane < 32) { pst[e] = incl - padded; cn[e] = c; if (e == 31) pst[32] = incl;
            for (int j = 0; j < padded / 256; ++j) tile_e[(incl - padded) / 256 + j] = e; }
    }
    LDS_WAIT(); __syncthreads();
}

__device__ __forceinline__ void gather_rows(const Frame& F) {
    const int gw = F.vcu * NWAVES + F.wave, NGW = F.G * NWAVES;
    LAS int* pst = (LAS int*)(F.lds + TB_OFF); LAS int* cn = pst + 40; LAS int* tile_e = pst + 80;
    const unsigned char* HN8 = F.ws + WS_HN8; unsigned char* XS = F.ws + WS_R3;
    const int* LIST = (const int*)(F.ws + WS_LIST); const float* GATEW = (const float*)(F.ws + WS_GATEW); float* GSORT = (float*)(F.ws + WS_GSORT); int* ROWOF = (int*)(F.ws + WS_ROWOF);
    const int rtot = pst[32];
    for (int R = gw; R < rtot; R += NGW) {
        const int e = tile_e[R >> 8], pos = R - pst[e];
        u32x4 v0 = (u32x4){0u, 0u, 0u, 0u}; float gwt = 0.f;
        if (pos < cn[e]) {
            const int slot = LIST[(size_t)e * T + pos]; const int tok = slot >> 2;
            v0 = *((const u32x4*)(HN8 + (size_t)tok * D) + F.lane);
            gwt = GATEW[slot];
            if (F.lane == 0) ROWOF[slot] = R;
        }
        *((u32x4*)(XS + (size_t)R * D) + F.lane) = v0;
        if (F.lane == 0) GSORT[R] = gwt;
    }
}

__device__ __forceinline__ void combine(const Frame& F, const Args& a) {
    const int gw = F.vcu * NWAVES + F.wave, NGW = F.G * NWAVES;
    const float* H = (const float*)(F.ws + WS_H); const bf16_t* YS = (const bf16_t*)(F.ws + WS_YS); const int* ROWOF = (const int*)(F.ws + WS_ROWOF); const float* gf = a.in[18];
    f32x4 gv[4];
#pragma unroll
    for (int j = 0; j < 4; ++j) gv[j] = *(const f32x4*)(gf + 4 * F.lane + 256 * j);
    for (int m = gw; m < T; m += NGW) {
        const f32x4* xr = (const f32x4*)(H + (size_t)m * D) + F.lane;
        f32x4 v[4];
#pragma unroll
        for (int j = 0; j < 4; ++j) v[j] = xr[64 * j];
#if !defined(DBG_SKIP_MOE)
#pragma unroll
        for (int k = 0; k < 4; ++k) { const int R = ROWOF[m * 4 + k]; const u32x2* yr = (const u32x2*)(YS + (size_t)R * D) + F.lane;
#pragma unroll
            for (int j = 0; j < 4; ++j) { const u32x2 w = yr[64 * j]; v[j][0] += bflo(w.x); v[j][1] += bfhi(w.x); v[j][2] += bflo(w.y); v[j][3] += bfhi(w.y); } }
#endif
        float ss = 0.f;
#pragma unroll
        for (int j = 0; j < 4; ++j) ss += (v[j][0] * v[j][0] + v[j][1] * v[j][1]) + (v[j][2] * v[j][2] + v[j][3] * v[j][3]);
        const float rstd = rsqrtf(wave_sum(ss) * (1.0f / D) + EPS);
        f32x4* o = (f32x4*)(a.out + (size_t)m * D) + F.lane;
#pragma unroll
        for (int j = 0; j < 4; ++j) o[64 * j] = v[j] * rstd * gv[j];
    }
}

__device__ __forceinline__ void dbg_dump(const Frame& F, const Args& a, int what) {
    const int gw = F.vcu * NWAVES + F.wave, NGW = F.G * NWAVES;
    for (int m = gw; m < T; m += NGW) {
        for (int c = F.lane; c < D; c += 64) {
            float v = 0.f;
            if (what == 1) v = bf2f(((const bf16_t*)(F.ws + WS_R3))[(size_t)m * NPROJ + c]);
            else if (what == 2) v = bf2f(((const bf16_t*)(F.ws + WS_MIX))[(size_t)m * D + c]);
            else if (what == 3) v = ((const float*)(F.ws + WS_O))[(size_t)m * 512 + (c & 511)];
            else if (what == 4) v = ((const float*)(F.ws + WS_H))[(size_t)m * D + c];
            else if (what == 5) v = bf2f(((const bf16_t*)(F.ws + WS_R3))[(size_t)m * NPROJ + 1024 + c]);
            else if (what == 6) v = bf2f(((const bf16_t*)(F.ws + WS_R3))[(size_t)m * NPROJ + 2048 + c]);
            else if (what == 7) v = bf2f(((const bf16_t*)(F.ws + WS_Y))[(size_t)m * D + c]);
            else if (what == 9) v = bf2f(((const bf16_t*)(F.ws + WS_WC))[((size_t)m * D + c) & 0xFFFFFF]);
            else if (what == 10) v = bf2f(((const bf16_t*)(F.ws + WS_UC))[((size_t)m * D + c) & 0xFFFFFF]);
            else if (what == 11) v = bf2f(((const bf16_t*)(F.ws + WS_QD))[((size_t)m * D + c) & 0xFFFFFF]);
            else if (what == 12) v = bf2f(((const bf16_t*)(F.ws + WS_KET))[((size_t)m * D + c) & 0xFFFFFF]);
            else if (what == 13) v = bf2f(((const bf16_t*)(F.ws + WS_AT))[((size_t)m * D + c) & 0x7FFFFF]);
            else if (what == 14) v = ((const float*)(F.ws + WS_AB))[(size_t)m * 8 + (c & 7)];
            else if (what == 8) v = bf2f(((const bf16_t*)(F.ws + WS_MIX))[(size_t)m * D + (c & 511)]);
            if (!(v - v == 0.f)) v = 12345.f;
            a.out[(size_t)m * D + c] = v;
        }
    }
}

constexpr int NPHASES = 12;
__global__ void __launch_bounds__(NTHREADS, 2) fwd(Args args) {
    __shared__ __attribute__((aligned(16))) unsigned char lds_raw[LDS_BYTES];
    Frame F;
    F.lds = (LAS unsigned char*)lds_raw;
    F.tid = threadIdx.x; F.lane = F.tid & 63; F.wave = __builtin_amdgcn_readfirstlane(F.tid >> 6);
    F.G = gridDim.x; { const int bx = blockIdx.x; F.vcu = (F.G % 8 == 0) ? (bx % 8) * (F.G / 8) + bx / 8 : bx; }
    F.ws = args.ws;
    volatile LAS unsigned* MISC = (volatile LAS unsigned*)(F.lds + LDSCTL_OFF);
    for (int u = F.tid; u < (LDS_BYTES - LDSCTL_OFF) / 4; u += NTHREADS) MISC[u] = 0u;
    __syncthreads();
#if !MK_PER_PHASE
    XcdBarrier bar = xcd_barrier_post((unsigned*)(F.ws + WS_CTL) + CW_BAR, MISC + 8);
#define GRID_BAR() xcd_barrier(bar)
#else
#define GRID_BAR() do { } while (0)
#endif
    const int lo = args.ph_lo, hi = args.ph_hi;
#define IN(k) (lo <= (k) && (k) < hi)
#ifndef PROBE_DOUBLE
#define PROBE_DOUBLE (-1)
#endif
#define REP(k) for (int rep_ = 0; rep_ < ((PROBE_DOUBLE) == (k) ? 2 : 1); ++rep_)
#define SEAM(k) do { if (IN(k) && IN((k) + 1)) GRID_BAR(); } while (0)

    if (IN(0)) REP(0) { p0_prologue(F, args); } SEAM(0);
    if (IN(1)) REP(1) {
        pg8::Gemm g{(const bf16_t*)(F.ws + WS_Y), (const bf16_t*)(F.ws + WS_WIN), T, NPROJ, D}; pg8::StaticOrder S; S.init(T, NPROJ, F.G, (int)blockIdx.x);
        pg8::EpiProj E{(bf16_t*)(F.ws + WS_R3)};
        pg8::gemm_phase<pg8::EpiProj, pg8::StaticOrder>(F.lds, g, S, E);
    } SEAM(1);
    if (IN(2)) REP(2) {
        for (int u = F.vcu; u < NB * 32 * NH; u += F.G) gmlp_unit(F, args, u);
        for (int u = F.vcu; u < NCHUNKS; u += F.G) dn_chunk(F, args, u);
    } SEAM(2);
    if (IN(3)) REP(3) {
        for (int it = F.vcu; it < NB * NH * 8; it += F.G) dn_scan(F, it);
    } SEAM(3);
    if (IN(4)) REP(4) { dn_out(F, args); } SEAM(4);
    if (IN(5)) REP(5) {
        pg8::Gemm g{(const bf16_t*)(F.ws + WS_MIX), (const bf16_t*)(F.ws + WS_WOUT), T, D, D}; pg8::StaticOrder S; S.init(T, D, F.G, (int)blockIdx.x);
        pg8::EpiResid E{args.in[0], (float*)(F.ws + WS_H)};
        pg8::gemm_phase<pg8::EpiResid, pg8::StaticOrder>(F.lds, g, S, E);
    } SEAM(5);
    if (IN(6)) REP(6) { norm_h(F, args); } SEAM(6);
    if (IN(7)) { router(F, args); } SEAM(7);
    if (IN(8)) { build_tables(F); REP(8) gather_rows(F); } SEAM(8);
    if (IN(9)) {
        if (!IN(8)) build_tables(F);
        const int rtot = ((LAS int*)(F.lds + TB_OFF))[32];
        REP(9) {
        pg8::Gemm g{(const bf16_t*)(F.ws + WS_R3), (const bf16_t*)(F.ws + WS_WGU), rtot, 2048, D / 2}; pg8::MoeOrder S; S.init(rtot, 2048, F.G, (int)blockIdx.x); S.tile_e = (const LAS int*)(F.lds + TB_OFF) + 80;
        pg8::EpiSwiglu E{F.ws + WS_R4, args.in[15]};
        pg8::gemm_phase<pg8::EpiSwiglu, pg8::MoeOrder, true>(F.lds, g, S, E);
        }
    } SEAM(9);
    if (IN(10)) {
        if (!IN(9)) build_tables(F);
        const int rtot = ((LAS int*)(F.lds + TB_OFF))[32];
        REP(10) {
        pg8::Gemm g{(const bf16_t*)(F.ws + WS_R4), (const bf16_t*)(F.ws + WS_WDN), rtot, D, DFF / 2}; pg8::MoeOrder S; S.init(rtot, D, F.G, (int)blockIdx.x); S.tile_e = (const LAS int*)(F.lds + TB_OFF) + 80;
        pg8::EpiDown E{(bf16_t*)(F.ws + WS_YS), args.in[17], (const float*)(F.ws + WS_GSORT)};
        pg8::gemm_phase<pg8::EpiDown, pg8::MoeOrder, true>(F.lds, g, S, E);
        }
    } SEAM(10);
    if (IN(11)) REP(11) { combine(F, args); }
#if defined(DBG_DUMP)
    if (IN(12)) { dbg_dump(F, args, DBG_DUMP); }
#endif
#undef IN
#undef SEAM
}

extern "C" void kernel_launch(void* const* d_in, const int* in_sizes, int n_in, void* d_out, int out_size, void* d_ws, size_t ws_size, hipStream_t stream) {
    static int grid = 0;
    if (grid == 0) {
        if (n_in != 19 || out_size != T * D || ws_size < WS_END) { fprintf(stderr, "kernel_launch: unexpected shapes (n_in %d, out %d, ws %zu)\n", n_in, out_size, ws_size); grid = -1; return; }
        int dev = 0, cus = 0, per_cu = 0;
        if (hipGetDevice(&dev) != hipSuccess || hipDeviceGetAttribute(&cus, hipDeviceAttributeMultiprocessorCount, dev) != hipSuccess) { grid = -1; return; }
        if (hipOccupancyMaxActiveBlocksPerMultiprocessor(&per_cu, (const void*)fwd, NTHREADS, 0) != hipSuccess || per_cu < 1) fprintf(stderr, "kernel_launch: occupancy query reports %d\n", per_cu);
        (void)hipGetLastError();
        grid = cus;
    }
    if (grid < 0) return;
    (void)hipMemsetAsync((char*)d_ws + WS_CTL, 0, CTL_ZERO_BYTES, stream);
    Args a{};
    for (int i = 0; i < 19; ++i) a.in[i] = (const float*)d_in[i];
    a.out = (float*)d_out; a.ws = (unsigned char*)d_ws;
#if MK_PER_PHASE
    for (int p = 0; p < NPHASES; ++p) {
#if defined(DBG_DUMP)
        if (p > DBG_LAST) continue;
#endif
        a.ph_lo = p; a.ph_hi = p + 1; hipLaunchKernelGGL(fwd, dim3(grid), dim3(NTHREADS), 0, stream, a); }
#if defined(DBG_DUMP)
    a.ph_lo = 12; a.ph_hi = 13; hipLaunchKernelGGL(fwd, dim3(grid), dim3(NTHREADS), 0, stream, a);
#endif
#else
    a.ph_lo = 0; a.ph_hi = NPHASES; hipLaunchKernelGGL(fwd, dim3(grid), dim3(NTHREADS), 0, stream, a);
#endif
}
```

```cpp
#include <hip/hip_runtime.h>
#include <cstdio>
#include <cstdint>

#ifndef MK_PER_PHASE
#define MK_PER_PHASE 0
#endif

#define LAS __attribute__((address_space(3)))
#define GAS __attribute__((address_space(1)))
typedef unsigned short bf16_t;
typedef short bf16x8 __attribute__((ext_vector_type(8)));
typedef float f32x4 __attribute__((ext_vector_type(4)));
typedef float f32x2 __attribute__((ext_vector_type(2)));
typedef unsigned u32x4 __attribute__((ext_vector_type(4)));
typedef unsigned u32x2 __attribute__((ext_vector_type(2)));
typedef int i32x4 __attribute__((ext_vector_type(4)));
typedef int i32x8 __attribute__((ext_vector_type(8)));

constexpr int NB = 8, SEQ = 4096, D = 1024, T = NB * SEQ;
constexpr int DIN = 3080, NPROJ = 3072;
constexpr int NE = 32, TOPK = 4, DFF = 1024;
constexpr int NH = 4, HD = 128, GMC = 128, DNC = 64;
constexpr int NCH = SEQ / DNC;
constexpr int NCHUNKS = NB * NH * NCH;
constexpr int RMAX = T * TOPK + NE * 256;
constexpr float EPS = 1e-6f;
constexpr int NWAVES = 8, NTHREADS = 512;

constexpr size_t MiB = 1u << 20;
constexpr size_t WS_CTL = 0, CTL_ZERO_BYTES = 32768;
constexpr size_t WS_AB = 1 * MiB;
constexpr size_t WS_EIDX = 2 * MiB;
constexpr size_t WS_GATEW = 2 * MiB + 512 * 1024;
constexpr size_t WS_ROWOF = 3 * MiB;
constexpr size_t WS_EPOS = 3 * MiB + 512 * 1024;
constexpr size_t WS_GSORT = 4 * MiB;
constexpr size_t WS_LIST = 5 * MiB;
constexpr size_t WS_RWT = 9 * MiB;
constexpr size_t WS_GLAST = 10 * MiB;
constexpr size_t WS_WIN = 16 * MiB;
constexpr size_t WS_WOUT = 22 * MiB;
constexpr size_t WS_WGU = 24 * MiB;
constexpr size_t WS_WDN = 152 * MiB;
constexpr size_t WS_HN8 = 88 * MiB;
constexpr size_t WS_H = 216 * MiB;
constexpr size_t WS_R3 = 344 * MiB;
constexpr size_t WS_R4 = 616 * MiB;
constexpr size_t WS_Y = WS_R4;
constexpr size_t WS_WC = WS_R4;
constexpr size_t WS_UC = WS_R4 + 32 * MiB;
constexpr size_t WS_QD = WS_R4 + 64 * MiB;
constexpr size_t WS_KET = WS_R4 + 96 * MiB;
constexpr size_t WS_AT = WS_R4 + 128 * MiB;
constexpr size_t WS_MIX = WS_R4 + 144 * MiB;
constexpr size_t WS_O = WS_R4 + 208 * MiB;
constexpr size_t WS_HN = 888 * MiB;
constexpr size_t WS_YS = WS_R3 + 136 * MiB;
constexpr size_t WS_END = 952 * MiB;
constexpr int CW_BAR = 0;
constexpr int CW_CNT = 4096;

constexpr int RING_BYTES = 139264;
constexpr int LDSCTL_OFF = RING_BYTES;
constexpr int LDS_BYTES = RING_BYTES + 1024;

#define LDS_WAIT() asm volatile("s_waitcnt lgkmcnt(0)" ::: "memory")
#define VM_WAIT() asm volatile("s_waitcnt vmcnt(0)" ::: "memory")
typedef __bf16 bf16x2_t __attribute__((ext_vector_type(2)));
__device__ __forceinline__ unsigned cvt_pk_bf16(float lo, float hi) { const bf16x2_t r = __builtin_convertvector((f32x2){lo, hi}, bf16x2_t); return __builtin_bit_cast(unsigned, r); }
__device__ __forceinline__ float bf2f(unsigned short b) { return __uint_as_float(((unsigned)b) << 16); }
__device__ __forceinline__ float bflo(unsigned w) { return __uint_as_float(w << 16); }
__device__ __forceinline__ float bfhi(unsigned w) { return __uint_as_float(w & 0xffff0000u); }
__device__ __forceinline__ bf16_t f2bf(float f) { return (bf16_t)(cvt_pk_bf16(f, 0.f) & 0xffffu); }
__device__ __forceinline__ unsigned cvt4_fp8(float a, float b, float c, float d) { int r = __builtin_amdgcn_cvt_pk_fp8_f32(a, b, 0, false); r = __builtin_amdgcn_cvt_pk_fp8_f32(c, d, r, true); return (unsigned)r; }
constexpr float W8_SCALE = 32.0f, W8_INV = 1.0f / 32.0f;
__device__ __forceinline__ float wave_sum(float v) {
#pragma unroll
    for (int o = 1; o < 64; o <<= 1) v += __shfl_xor(v, o);
    return v;
}
__device__ __forceinline__ float silu_f(float v) { return v / (1.0f + __expf(-v)); }
__device__ __forceinline__ float sigmoid_f(float v) { return 1.0f / (1.0f + __expf(-v)); }
__device__ __forceinline__ f32x2 gelu_pk(f32x2 v) {
    const f32x2 av = __builtin_elementwise_abs(v), d = av * 0.2316418882f + 1.0f;
    f32x2 t; t.x = __builtin_amdgcn_rcpf(d.x); t.y = __builtin_amdgcn_rcpf(d.y);
    f32x2 q = t * 0.5307027145f + (-0.7265760135f); q = q * t + 0.7107068705f; q = q * t + (-0.142248368f); q = q * t + 0.127414796f; q = q * t;
    const f32x2 s = (v * v) * (-0.72134752044f);
    f32x2 e; e.x = __builtin_amdgcn_exp2f(s.x); e.y = __builtin_amdgcn_exp2f(s.y);
    const f32x2 m = v * (q * e), r = v - m;
    f32x2 o; o.x = v.x < 0.f ? m.x : r.x; o.y = v.y < 0.f ? m.y : r.y; return o;
}

#define XB_TMO      128
#define XB_XCNT(j)  (256  + 64 * (j))
#define XB_XSUB(j)  (1280 + 64 * (j))
#define XB_XGEN(j)  (2304 + 64 * (j))
#define XB_TOP      3328
#define XB_TOPGEN   3392
#define XCD_BAR_WORDS 3456
#define XB_SPIN_CAP (1u << 18)
__device__ __forceinline__ unsigned xb_ld(unsigned* p)              { return __hip_atomic_load(p, __ATOMIC_RELAXED, __HIP_MEMORY_SCOPE_AGENT); }
__device__ __forceinline__ unsigned xb_add(unsigned* p, unsigned v) { return __hip_atomic_fetch_add(p, v, __ATOMIC_RELAXED, __HIP_MEMORY_SCOPE_AGENT); }
__device__ __forceinline__ unsigned xb_xcc_id() { return (unsigned)__builtin_amdgcn_s_getreg((3 << 11) | 20) & 0xFu; }
#define XB_SPIN(cond, bar) do { unsigned _sp = 0; while (cond) { __builtin_amdgcn_s_sleep(1); \
    if ((++_sp & 255u) == 0u) { if (xb_ld(&(bar)[XB_TMO])) break; if (_sp > XB_SPIN_CAP) { atomicAdd(&(bar)[XB_TMO], 1u); break; } } } } while (0)
struct XcdBarrier { unsigned* bar; unsigned x; volatile LAS unsigned* st; };
__device__ __forceinline__ XcdBarrier xcd_barrier_post(unsigned* bar, volatile LAS unsigned* st) {
    XcdBarrier b; b.bar = bar; b.x = xb_xcc_id(); b.st = st;
    if (threadIdx.x == 0) (void)xb_add(&bar[XB_XCNT(b.x)], 1u);
    return b;
}
__device__ __forceinline__ void xcd_barrier_complete(unsigned* bar, unsigned x, unsigned& nloc, unsigned& nx) {
    const unsigned G = gridDim.x * gridDim.y * gridDim.z;
    unsigned sum, cnt, mine, sp = 0u;
    for (;;) {
        sum = 0u; cnt = 0u; mine = 0u;
#pragma unroll
        for (unsigned j = 0; j < 16; ++j) { const unsigned c = xb_ld(&bar[XB_XCNT(j)]); sum += c; cnt += (c > 0u) ? 1u : 0u; mine = (j == x) ? c : mine; }
        if (sum == G) break;
        __builtin_amdgcn_s_sleep(1);
        if ((++sp & 255u) == 0u) { if (xb_ld(&bar[XB_TMO])) break; if (sp > XB_SPIN_CAP) { atomicAdd(&bar[XB_TMO], 1u); break; } }
    }
    nloc = mine > 0u ? mine : 1u; nx = cnt > 0u ? cnt : 1u;
}
__device__ __forceinline__ void xcd_barrier(const XcdBarrier& b) {
    asm volatile("s_waitcnt vmcnt(0)" ::: "memory");
    __syncthreads();
    if (threadIdx.x == 0) {
        unsigned* bar = b.bar;
        __builtin_amdgcn_s_waitcnt(0);
        unsigned nloc = b.st[0], nx = b.st[1];
        if (nloc == 0u) { xcd_barrier_complete(bar, b.x, nloc, nx); b.st[0] = nloc; b.st[1] = nx; }
        const unsigned old = xb_add(&bar[XB_XSUB(b.x)], 1u);
        const unsigned gen = old / nloc;
        if (old + 1u == (gen + 1u) * nloc) {
            __builtin_amdgcn_fence(__ATOMIC_RELEASE, "agent");
            asm volatile("s_waitcnt vmcnt(0)" ::: "memory");
            const unsigned og = xb_add(&bar[XB_TOP], 1u);
            const unsigned tg = og / nx;
            if (og + 1u == (tg + 1u) * nx) xb_add(&bar[XB_TOPGEN], 1u);
            else XB_SPIN(xb_ld(&bar[XB_TOPGEN]) == tg, bar);
            __builtin_amdgcn_fence(__ATOMIC_ACQUIRE, "agent");
            xb_add(&bar[XB_XGEN(b.x)], 1u);
            asm volatile("s_waitcnt vmcnt(0)" ::: "memory");
        } else {
            XB_SPIN(xb_ld(&bar[XB_XGEN(b.x)]) == gen, bar);
            __builtin_amdgcn_fence(__ATOMIC_ACQUIRE, "agent");
            asm volatile("s_waitcnt vmcnt(0)" ::: "memory");
        }
    }
    __syncthreads();
}

namespace pg8 {
constexpr int BM = 256, BK = 64, HALF = 128, HTB = HALF * BK * 2, STAGE_BYTES = 8 * HTB, NXCD = 8, WGM = 8;
__host__ __device__ __forceinline__ int lds_byte(int r, int c) { const int st = (r >> 4) * 2 + (c >> 5), rr = r & 15, cc = c & 31, ob = rr * 64 + cc * 2; return st * 1024 + (ob ^ (((ob >> 9) & 1) << 5)); }
__host__ __device__ __forceinline__ void stage_rc(int b, int& R, int& C) { const int st = b / 1024, sb = b % 1024, swz = sb ^ (((sb >> 9) & 1) << 5); R = (st >> 1) * 16 + swz / 64; C = (st & 1) * 32 + (swz % 64) / 2; }
__host__ __device__ __forceinline__ int perm32(int rho) { const int n = rho >> 4, i = rho & 15; return 8 * (i >> 2) + 4 * n + (i & 3); }

struct Unit { int pm, pn, pb; };
struct Gemm { const bf16_t* A; const bf16_t* Bt; int M, N, K; };

struct StaticOrder {
    int nM, nN, nwg, G, c;
    __device__ void init(int M, int N, int G_, int c_) { nM = M / BM; nN = N / BM; nwg = nM * nN; G = G_; c = c_; }
    __device__ bool next(int i, Unit& u) const {
        const long L = (long)i * G + c; if (L >= nwg) return false;
        int wgid = (int)L; { const int q = nwg / NXCD, r = nwg % NXCD, xcd = wgid % NXCD, off = wgid / NXCD; wgid = (xcd < r ? xcd * (q + 1) : r * (q + 1) + (xcd - r) * q) + off; }
        const int nig = WGM * nN, gid = wgid / nig, fm = gid * WGM, gsz = (nM - fm) < WGM ? (nM - fm) : WGM;
        u.pm = fm + ((wgid % nig) % gsz); u.pn = (wgid % nig) / gsz; u.pb = u.pn; return true;
    }
};
struct MoeOrder : StaticOrder {
    const LAS int* tile_e;
    __device__ bool next(int i, Unit& u) const { if (!StaticOrder::next(i, u)) return false; u.pb = __builtin_amdgcn_readfirstlane(tile_e[u.pm]) * nN + u.pn; return true; }
};

template <class Epi, class Sched, bool FP8 = false>
__device__ __forceinline__ void gemm_phase(LAS unsigned char* lds, const Gemm g, const Sched& S, const Epi& E) {
    const int tid = threadIdx.x, wid = __builtin_amdgcn_readfirstlane(tid >> 6), lane = tid & 63, wr = wid >> 2, wc = wid & 3, fr = lane & 15, fq = lane >> 4;
    const int K = g.K, nt = K / BK;
    unsigned voffA[2], voffB[2];
#pragma unroll
    for (int i = 0; i < 2; ++i) { int R, C; stage_rc(tid * 16 + i * 8192, R, C); const int Rb = Epi::PERM ? ((R & ~31) + perm32(R & 31)) : R;
        voffA[i] = (unsigned)(R * K + C) * 2u; voffB[i] = (unsigned)(Rb * K + C) * 2u; }
    const size_t kstep = (size_t)(BK * 2);
    const size_t hstep = (size_t)HALF * K * 2;
    const size_t tstep = 2 * hstep;
    const unsigned ldsw = (unsigned)wid * 1024u;
    const int aoff = lds_byte(wr * 64 + fr, fq * 8), boff = lds_byte(wc * 32 + fr, fq * 8);
    LAS unsigned char* ldsA = lds + aoff; LAS unsigned char* ldsB = lds + 4 * HTB + boff;
    asm volatile("" : "+v"(ldsA)); asm volatile("" : "+v"(ldsB));
#define PG8_SA(b, h) (((b) * 2 + (h)) * HTB)
#define PG8_SB(b, h) ((4 + (b) * 2 + (h)) * HTB)
#define PG8_STAGE(bufoff, gbase, voff) do { _Pragma("unroll") for (int _i = 0; _i < 2; ++_i) \
        __builtin_amdgcn_global_load_lds((const unsigned*)((const char*)(gbase) + (voff)[_i]), (LAS unsigned*)(lds + (bufoff) + ldsw + _i * 8192), 16, 0, 0); } while (0)
#define PG8_LD2(dst, addr) do { if constexpr (FP8) { const i32x4 lo_ = *(const LAS i32x4*)(addr), hi_ = *(const LAS i32x4*)((addr) + 1024); (dst).w = __builtin_shufflevector(lo_, hi_, 0, 1, 2, 3, 4, 5, 6, 7); } \
        else { (dst).h[0] = *(const LAS bf16x8*)(addr); (dst).h[1] = *(const LAS bf16x8*)((addr) + 1024); } } while (0)
#define PG8_LDA(dst, b, h) do { _Pragma("unroll") for (int m = 0; m < 4; ++m) PG8_LD2(dst[m], ldsA + PG8_SA(b, h) + m * 2048); } while (0)
#define PG8_LDB(dst, b, h) do { _Pragma("unroll") for (int n = 0; n < 2; ++n) PG8_LD2(dst[n], ldsB + PG8_SA(b, h) + n * 2048); } while (0)
#define PG8_MMA(ai, bj, At, Bt) do { __builtin_amdgcn_s_setprio(1); \
        if constexpr (FP8) { _Pragma("unroll") for (int m = 0; m < 4; ++m) _Pragma("unroll") for (int n = 0; n < 2; ++n) \
            asm volatile("v_mfma_f32_16x16x128_f8f6f4 %0, %1, %2, %0" : "+v"(acc[ai][bj][m][n]) : "v"(Bt[n].w), "v"(At[m].w)); } \
        else { _Pragma("unroll") for (int m = 0; m < 4; ++m) _Pragma("unroll") for (int n = 0; n < 2; ++n) _Pragma("unroll") for (int k = 0; k < 2; ++k) \
            acc[ai][bj][m][n] = __builtin_amdgcn_mfma_f32_16x16x32_bf16(Bt[n].h[k], At[m].h[k], acc[ai][bj][m][n], 0, 0, 0); } \
        __builtin_amdgcn_s_setprio(0); } while (0)
#define PG8_WAIT_V(n) asm volatile("s_waitcnt vmcnt(" #n ")" ::: "memory")
#define PG8_WAIT_L(n) asm volatile("s_waitcnt lgkmcnt(" #n ")" ::: "memory")
#define PG8_BAR __builtin_amdgcn_s_barrier()
#define PG8_SCHED __builtin_amdgcn_sched_barrier(0)
    Unit cur, nxt; int ui = 0;
    if (!S.next(0, cur)) return;
    f32x4 acc[2][2][4][2];
#pragma unroll
    for (int a = 0; a < 2; ++a)
#pragma unroll
        for (int b = 0; b < 2; ++b)
#pragma unroll
            for (int m = 0; m < 4; ++m)
#pragma unroll
                for (int n = 0; n < 2; ++n) acc[a][b][m][n] = (f32x4){0.f, 0.f, 0.f, 0.f};
    union Frag { bf16x8 h[2]; i32x8 w; };
    Frag At[4], B0[2], B1[2];
    const char* cA = (const char*)g.A + (size_t)cur.pm * tstep; const char* cB = (const char*)g.Bt + (size_t)cur.pb * tstep;
    PG8_STAGE(PG8_SB(0, 0), cB, voffB); PG8_STAGE(PG8_SB(0, 1), cB + hstep, voffB); PG8_STAGE(PG8_SA(0, 0), cA, voffA); PG8_STAGE(PG8_SA(0, 1), cA + hstep, voffA);
    if (wr == 1) PG8_BAR;
    PG8_WAIT_V(2); PG8_BAR;
    PG8_STAGE(PG8_SB(1, 0), cB + kstep, voffB); PG8_STAGE(PG8_SA(1, 0), cA + kstep, voffA); PG8_STAGE(PG8_SB(1, 1), cB + hstep + kstep, voffB);
    PG8_WAIT_V(6); PG8_BAR;
    for (;;) {
        const bool has_next = S.next(ui + 1, nxt);
        const char* nA = has_next ? (const char*)g.A + (size_t)nxt.pm * tstep : cA; const char* nB = has_next ? (const char*)g.Bt + (size_t)nxt.pb * tstep : cB;
        for (int t = 0; t < nt; t += 2) {
            const bool last = (t == nt - 2);
            const char* a1 = cA + (size_t)(t + 1) * kstep;
            const char* a2 = last ? nA : cA + (size_t)(t + 2) * kstep; const char* b2 = last ? nB : cB + (size_t)(t + 2) * kstep;
            const char* a3 = a2 + kstep; const char* b3 = b2 + kstep;
            PG8_LDB(B0, 0, 0); PG8_LDB(B1, 0, 1); PG8_SCHED; PG8_LDA(At, 0, 0); PG8_STAGE(PG8_SA(1, 1), a1 + hstep, voffA);
            PG8_WAIT_V(8); PG8_WAIT_L(0); PG8_BAR; PG8_MMA(0, 0, At, B0); PG8_MMA(0, 1, At, B1); PG8_BAR; PG8_SCHED;
            PG8_LDA(At, 0, 1); PG8_STAGE(PG8_SB(0, 0), b2, voffB); PG8_STAGE(PG8_SB(0, 1), b2 + hstep, voffB); PG8_STAGE(PG8_SA(0, 0), a2, voffA);
            PG8_WAIT_V(8); PG8_WAIT_L(0); PG8_BAR; PG8_MMA(1, 0, At, B0); PG8_MMA(1, 1, At, B1); PG8_BAR; PG8_SCHED;
            PG8_LDB(B0, 1, 0); PG8_LDB(B1, 1, 1); PG8_SCHED; PG8_LDA(At, 1, 0); PG8_STAGE(PG8_SA(0, 1), a2 + hstep, voffA);
            PG8_WAIT_V(8); PG8_WAIT_L(0); PG8_BAR; PG8_MMA(0, 0, At, B0); PG8_MMA(0, 1, At, B1); PG8_BAR; PG8_SCHED;
            PG8_LDA(At, 1, 1); PG8_STAGE(PG8_SB(1, 0), b3, voffB); PG8_STAGE(PG8_SB(1, 1), b3 + hstep, voffB); PG8_STAGE(PG8_SA(1, 0), a3, voffA);
            PG8_WAIT_V(8); PG8_WAIT_L(0); PG8_BAR; PG8_MMA(1, 0, At, B0); PG8_MMA(1, 1, At, B1); PG8_BAR; PG8_SCHED;
        }
        if (wr == 0) PG8_BAR;
        if constexpr (FP8) asm volatile("s_nop 15\n\ts_nop 15" ::: "memory");
        { int fr_ = fr, fq_ = fq; asm volatile("" : "+v"(fr_), "+v"(fq_));
          E(acc, cur, wr, wc, fr_, fq_); }
        if (!has_next) break;
#pragma unroll
        for (int a = 0; a < 2; ++a)
#pragma unroll
            for (int b = 0; b < 2; ++b)
#pragma unroll
                for (int m = 0; m < 4; ++m)
#pragma unroll
                    for (int n = 0; n < 2; ++n) { acc[a][b][m][n] = (f32x4){0.f, 0.f, 0.f, 0.f}; if constexpr (FP8) asm volatile("" : "+v"(acc[a][b][m][n])); }
        cur = nxt; cA = nA; cB = nB; ++ui;
        if (wr == 1) PG8_BAR;
    }
    PG8_WAIT_V(0);
    PG8_BAR;
#undef PG8_SA
#undef PG8_SB
#undef PG8_STAGE
#undef PG8_LDA
#undef PG8_LDB
#undef PG8_MMA
#undef PG8_LD2
#undef PG8_WAIT_V
#undef PG8_WAIT_L
#undef PG8_BAR
#undef PG8_SCHED
}

struct EpiProj {
    static constexpr bool PERM = true;
    bf16_t* O;
    __device__ __forceinline__ void operator()(const f32x4 (&acc)[2][2][4][2], const Unit& u, int wr, int wc, int fr, int fq) const {
        const int row0 = u.pm * BM + wr * 64 + fr, col0 = u.pn * BM + wc * 32 + 8 * fq;
        const int act = u.pn < 4 ? 1 : (u.pn >= 10 ? 2 : 0);
#pragma unroll
        for (int ai = 0; ai < 2; ++ai)
#pragma unroll
            for (int m = 0; m < 4; ++m) { bf16_t* rowp = O + (size_t)(row0 + ai * HALF + m * 16) * NPROJ + col0;
#pragma unroll
                for (int bj = 0; bj < 2; ++bj) { f32x4 v0 = acc[ai][bj][m][0], v1 = acc[ai][bj][m][1];
                    if (act == 1) { f32x2 a = gelu_pk((f32x2){v0[0], v0[1]}), b = gelu_pk((f32x2){v0[2], v0[3]}), c = gelu_pk((f32x2){v1[0], v1[1]}), d = gelu_pk((f32x2){v1[2], v1[3]});
                        v0 = (f32x4){a.x, a.y, b.x, b.y}; v1 = (f32x4){c.x, c.y, d.x, d.y}; }
                    else if (act == 2) {
#pragma unroll
                        for (int j = 0; j < 4; ++j) { v0[j] = silu_f(v0[j]); v1[j] = silu_f(v1[j]); } }
                    u32x4 w; w.x = cvt_pk_bf16(v0[0], v0[1]); w.y = cvt_pk_bf16(v0[2], v0[3]); w.z = cvt_pk_bf16(v1[0], v1[1]); w.w = cvt_pk_bf16(v1[2], v1[3]);
                    *(u32x4*)(rowp + bj * HALF) = w; } }
    }
};
struct EpiResid {
    static constexpr bool PERM = false;
    const float* X; float* H;
    __device__ __forceinline__ void operator()(const f32x4 (&acc)[2][2][4][2], const Unit& u, int wr, int wc, int fr, int fq) const {
        const int row0 = u.pm * BM + wr * 64 + fr, col0 = u.pn * BM + wc * 32 + 4 * fq;
#pragma unroll
        for (int ai = 0; ai < 2; ++ai)
#pragma unroll
            for (int m = 0; m < 4; ++m) { const size_t off = (size_t)(row0 + ai * HALF + m * 16) * D + col0;
#pragma unroll
                for (int bj = 0; bj < 2; ++bj)
#pragma unroll
                    for (int n = 0; n < 2; ++n) { const f32x4 xv = *(const f32x4*)(X + off + bj * HALF + n * 16); *(f32x4*)(H + off + bj * HALF + n * 16) = acc[ai][bj][m][n] + xv; } }
    }
};
struct EpiSwiglu {
    static constexpr bool PERM = true;
    unsigned char* O; const float* bgu;
    __device__ __forceinline__ void operator()(const f32x4 (&acc)[2][2][4][2], const Unit& u, int wr, int wc, int fr, int fq) const {
        const int row0 = u.pm * BM + wr * 64 + fr, j0 = u.pn * HALF + wc * 32 + 8 * fq, e = u.pb >> 3;
        const float* bg = bgu + (size_t)e * 2048 + j0;
#pragma unroll
        for (int ai = 0; ai < 2; ++ai)
#pragma unroll
            for (int m = 0; m < 4; ++m) { unsigned char* rowp = O + (size_t)(row0 + ai * HALF + m * 16) * DFF + j0;
                u32x2 w;
#pragma unroll
                for (int n = 0; n < 2; ++n) { const f32x4 g4 = acc[ai][0][m][n] * W8_INV + *(const f32x4*)(bg + 4 * n), u4 = acc[ai][1][m][n] * W8_INV + *(const f32x4*)(bg + 1024 + 4 * n); f32x4 r;
#pragma unroll
                    for (int j = 0; j < 4; ++j) { const float ga = fminf(g4[j], 7.0f), ua = fminf(fmaxf(u4[j], -7.0f), 7.0f); r[j] = (ua + 1.0f) * (ga * sigmoid_f(1.702f * ga)); }
                    w[n] = cvt4_fp8(r[0], r[1], r[2], r[3]); }
                *(u32x2*)rowp = w; asm volatile("" ::: "memory"); }
    }
};
struct EpiDown {
    static constexpr bool PERM = true;
    unsigned char* O; const float* bdn; const float* gsort;
    __device__ __forceinline__ void operator()(const f32x4 (&acc)[2][2][4][2], const Unit& u, int wr, int wc, int fr, int fq) const {
        const int row0 = u.pm * BM + wr * 64 + fr, col0 = u.pn * BM + wc * 32 + 8 * fq, e = u.pb >> 2;
        const float* bp = bdn + (size_t)e * D + col0;
#pragma unroll
        for (int ai = 0; ai < 2; ++ai)
#pragma unroll
            for (int m = 0; m < 4; ++m) { const int r = row0 + ai * HALF + m * 16; const float gw = gsort[r]; unsigned char* rowp = O + (size_t)r * D + col0;
#pragma unroll
                for (int bj = 0; bj < 2; ++bj) { const f32x4 v0 = (acc[ai][bj][m][0] * W8_INV + *(const f32x4*)(bp + bj * HALF)) * gw, v1 = (acc[ai][bj][m][1] * W8_INV + *(const f32x4*)(bp + bj * HALF + 4)) * gw;
                    u32x2 w; w.x = cvt4_fp8(v0[0], v0[1], v0[2], v0[3]); w.y = cvt4_fp8(v1[0], v1[1], v1[2], v1[3]);
                    *(u32x2*)(rowp + bj * HALF) = w; } asm volatile("" ::: "memory"); }
    }
};
}

struct Args {
    const float* in[19]; float* out; unsigned char* ws; int ph_lo, ph_hi;
};
struct Frame {
    LAS unsigned char* lds;
    int tid, lane, wave, G, vcu;
    unsigned char* ws;
};
#define MFMA16(a, b, c) __builtin_amdgcn_mfma_f32_16x16x32_bf16((a), (b), (c), 0, 0, 0)

__device__ __forceinline__ void tr_item(const float* src, size_t ldw, bf16_t* dst, LAS float* scr, int lane) {
    f32x4 v[16];
    const int kq = lane >> 4, n4 = 4 * (lane & 15);
#pragma unroll
    for (int i = 0; i < 16; ++i) v[i] = *(const f32x4*)(src + (size_t)(4 * i + kq) * ldw + n4);
#pragma unroll
    for (int i = 0; i < 16; ++i) { LAS float* s = scr + (4 * i + kq) * 65 + n4; s[0] = v[i][0]; s[1] = v[i][1]; s[2] = v[i][2]; s[3] = v[i][3]; }
    LDS_WAIT();
    const int c = lane & 7;
#pragma unroll
    for (int r = 0; r < 8; ++r) { const int n = 8 * r + (lane >> 3); const LAS float* s = scr + (8 * c) * 65 + n;
        u32x4 o; o.x = cvt_pk_bf16(s[0 * 65], s[1 * 65]); o.y = cvt_pk_bf16(s[2 * 65], s[3 * 65]); o.z = cvt_pk_bf16(s[4 * 65], s[5 * 65]); o.w = cvt_pk_bf16(s[6 * 65], s[7 * 65]);
        *(u32x4*)(dst + (size_t)n * 1024 + 8 * c) = o; }
    LDS_WAIT();
}
__device__ __forceinline__ void tr_item8(const float* src, size_t ldw, unsigned char* dst, LAS float* scr, int lane) {
    f32x4 v[16];
    const int kq = lane >> 3, n4 = 4 * (lane & 7);
#pragma unroll
    for (int i = 0; i < 16; ++i) v[i] = *(const f32x4*)(src + (size_t)(8 * i + kq) * ldw + n4);
#pragma unroll
    for (int i = 0; i < 16; ++i) { LAS float* s = scr + (8 * i + kq) * 33 + n4; s[0] = v[i][0]; s[1] = v[i][1]; s[2] = v[i][2]; s[3] = v[i][3]; }
    LDS_WAIT();
    const int c = lane >> 3, nn = lane & 7;
#pragma unroll
    for (int r = 0; r < 4; ++r) { const int n = 8 * r + nn; const LAS float* s = scr + (16 * c) * 33 + n;
        u32x4 o;
#pragma unroll
        for (int q = 0; q < 4; ++q) o[q] = cvt4_fp8(s[(4 * q) * 33] * W8_SCALE, s[(4 * q + 1) * 33] * W8_SCALE, s[(4 * q + 2) * 33] * W8_SCALE, s[(4 * q + 3) * 33] * W8_SCALE);
        *(u32x4*)(dst + (size_t)n * 1024 + 16 * c) = o; }
    LDS_WAIT();
}
__device__ __forceinline__ void p0_prologue(const Frame& F, const Args& a) {
    LAS float* scr = (LAS float*)(F.lds + F.wave * 16896);
    const int gw = F.vcu * NWAVES + F.wave, NGW = F.G * NWAVES;
    const float* w_in = a.in[2]; const float* w_out = a.in[10]; const float* w_gu = a.in[14]; const float* w_dn = a.in[16]; const float* rw = a.in[12];
    bf16_t* WIN = (bf16_t*)(F.ws + WS_WIN); bf16_t* WOUT = (bf16_t*)(F.ws + WS_WOUT); unsigned char* WGU = F.ws + WS_WGU; unsigned char* WDN = F.ws + WS_WDN; bf16_t* RWT = (bf16_t*)(F.ws + WS_RWT);
    constexpr int I_IN = 16 * 48, I_OUT = 16 * 16, I_GU = NE * 8 * 64, I_DN = NE * 8 * 32, NITEMS = I_IN + I_OUT + I_GU + I_DN;
    for (int it = gw; it < NITEMS; it += NGW) {
        int r = it;
        if (r < I_IN) { const int kb = r / 48, nb = r % 48; tr_item(w_in + (size_t)(64 * kb) * DIN + 64 * nb, DIN, WIN + (size_t)(64 * nb) * 1024 + 64 * kb, scr, F.lane); continue; } r -= I_IN;
        if (r < I_OUT) { const int kb = r / 16, nb = r % 16; tr_item(w_out + (size_t)(64 * kb) * D + 64 * nb, D, WOUT + (size_t)(64 * nb) * 1024 + 64 * kb, scr, F.lane); continue; } r -= I_OUT;
        if (r < I_GU) { const int e = r / 512, q = r % 512, kb = q / 64, nb = q % 64; const int c0 = 32 * nb, j = c0 & 1023, drow = (j >> 7) * 256 + (c0 >= 1024 ? 128 : 0) + (j & 127);
            tr_item8(w_gu + (size_t)e * 1024 * 2048 + (size_t)(128 * kb) * 2048 + c0, 2048, WGU + (size_t)e * 2048 * 1024 + (size_t)drow * 1024 + 128 * kb, scr, F.lane); continue; } r -= I_GU;
        { const int e = r / 256, q = r % 256, kb = q / 32, nb = q % 32;
            tr_item8(w_dn + (size_t)e * 1024 * 1024 + (size_t)(128 * kb) * 1024 + 32 * nb, 1024, WDN + (size_t)e * 1024 * 1024 + (size_t)(32 * nb) * 1024 + 128 * kb, scr, F.lane); }
    }
    for (int i = gw * 64 + F.lane; i < 32 * 1024; i += NGW * 64) { const int e = i >> 10, k = i & 1023; RWT[i] = f2bf(rw[(size_t)k * 32 + e]); }
    const float* x = a.in[0]; const float* g1 = a.in[1];
    bf16_t* Y = (bf16_t*)(F.ws + WS_Y); float* AB = (float*)(F.ws + WS_AB);
    f32x4 gv[4]; f32x4 wab[4][4][2];
#pragma unroll
    for (int j = 0; j < 4; ++j) { gv[j] = *(const f32x4*)(g1 + 4 * F.lane + 256 * j);
#pragma unroll
        for (int i = 0; i < 4; ++i) { const float* p = w_in + (size_t)(4 * F.lane + 256 * j + i) * DIN + NPROJ; wab[j][i][0] = *(const f32x4*)p; wab[j][i][1] = *(const f32x4*)(p + 4); } }
    for (int m = gw; m < T; m += NGW) {
        const f32x4* xr = (const f32x4*)(x + (size_t)m * D) + F.lane;
        f32x4 v[4]; float ss = 0.f;
#pragma unroll
        for (int j = 0; j < 4; ++j) { v[j] = xr[64 * j]; ss += (v[j][0] * v[j][0] + v[j][1] * v[j][1]) + (v[j][2] * v[j][2] + v[j][3] * v[j][3]); }
        const float rstd = rsqrtf(wave_sum(ss) * (1.0f / D) + EPS);
        f32x4 p0 = (f32x4){0.f, 0.f, 0.f, 0.f}, p1 = p0;
        u32x2* yo = (u32x2*)(Y + (size_t)m * D) + F.lane;
#pragma unroll
        for (int j = 0; j < 4; ++j) { const f32x4 y = v[j] * rstd * gv[j];
#pragma unroll
            for (int i = 0; i < 4; ++i) { p0 += wab[j][i][0] * y[i]; p1 += wab[j][i][1] * y[i]; }
            u32x2 w; w.x = cvt_pk_bf16(y[0], y[1]); w.y = cvt_pk_bf16(y[2], y[3]); yo[64 * j] = w; }
#pragma unroll
        for (int i = 0; i < 4; ++i) { p0[i] = wave_sum(p0[i]); p1[i] = wave_sum(p1[i]); }
        if (F.lane == 0) { *(f32x4*)(AB + (size_t)m * 8) = p0; *(f32x4*)(AB + (size_t)m * 8 + 4) = p1; }
    }
}

constexpr int GM_LDT = 136;
__device__ __forceinline__ void gmlp_unit(const Frame& F, const Args& a, int unit) {
    const int h = unit & 3, bn = unit >> 2;
    const bf16_t* PROJ = (const bf16_t*)(F.ws + WS_R3); bf16_t* MIX = (bf16_t*)(F.ws + WS_MIX);
    const float* gmg = a.in[3] + h * HD; const float* Wh = a.in[4] + (size_t)h * GMC * GMC; const float* bs = a.in[5] + h * GMC;
    LAS bf16_t* vnT = (LAS bf16_t*)F.lds;
    const size_t row0 = (size_t)bn * GMC;
    {
        const int sp = F.tid >> 3, seg = F.tid & 7;
        const bf16_t* p0 = PROJ + (row0 + 2 * sp) * NPROJ + 512 + h * HD + 16 * seg; const bf16_t* p1 = p0 + NPROJ;
        const u32x4 a0 = *(const u32x4*)p0, a1 = *(const u32x4*)(p0 + 8), b0 = *(const u32x4*)p1, b1 = *(const u32x4*)(p1 + 8);
        float x0[16], x1[16];
#pragma unroll
        for (int i = 0; i < 4; ++i) { x0[2 * i] = bflo(a0[i]); x0[2 * i + 1] = bfhi(a0[i]); x0[8 + 2 * i] = bflo(a1[i]); x0[9 + 2 * i] = bfhi(a1[i]);
                                      x1[2 * i] = bflo(b0[i]); x1[2 * i + 1] = bfhi(b0[i]); x1[8 + 2 * i] = bflo(b1[i]); x1[9 + 2 * i] = bfhi(b1[i]); }
        float s0 = 0.f, s1 = 0.f;
#pragma unroll
        for (int i = 0; i < 16; ++i) { s0 += x0[i] * x0[i]; s1 += x1[i] * x1[i]; }
#pragma unroll
        for (int o = 1; o < 8; o <<= 1) { s0 += __shfl_xor(s0, o); s1 += __shfl_xor(s1, o); }
        const float r0 = rsqrtf(s0 * (1.0f / HD) + EPS), r1 = rsqrtf(s1 * (1.0f / HD) + EPS);
#pragma unroll
        for (int i = 0; i < 16; ++i) { const float gg = gmg[16 * seg + i];
            *(LAS unsigned*)(vnT + (16 * seg + i) * GM_LDT + (((((sp >> 2) ^ seg) & 7) | ((sp >> 2) & 8)) << 3) + ((2 * sp) & 7)) = cvt_pk_bf16(x0[i] * r0 * gg, x1[i] * r1 * gg); }
    }
    const int fr = F.lane & 15, fq = F.lane >> 4, trow = 16 * F.wave + fr;
    bf16x8 af[4];
#pragma unroll
    for (int kk = 0; kk < 4; ++kk) { const int s0 = 32 * kk + 8 * fq; const float* wp = Wh + (size_t)trow * GMC + s0;
        const f32x4 w0 = *(const f32x4*)wp, w1 = *(const f32x4*)(wp + 4); float wv[8] = {w0[0], w0[1], w0[2], w0[3], w1[0], w1[1], w1[2], w1[3]};
#pragma unroll
        for (int j = 0; j < 8; ++j) if (s0 + j > trow) wv[j] = 0.f;
        u32x4 pk; pk.x = cvt_pk_bf16(wv[0], wv[1]); pk.y = cvt_pk_bf16(wv[2], wv[3]); pk.z = cvt_pk_bf16(wv[4], wv[5]); pk.w = cvt_pk_bf16(wv[6], wv[7]);
        af[kk] = __builtin_bit_cast(bf16x8, pk); }
    LDS_WAIT(); __syncthreads();
    f32x4 acc[8];
#pragma unroll
    for (int nt = 0; nt < 8; ++nt) { acc[nt] = (f32x4){0.f, 0.f, 0.f, 0.f};
#pragma unroll
        for (int kk = 0; kk < 4; ++kk) { const int ch = 4 * kk + fq; const bf16x8 bfr = *(const LAS bf16x8*)(vnT + (16 * nt + fr) * GM_LDT + ((((ch ^ nt) & 7) | (ch & 8)) << 3)); acc[nt] = MFMA16(af[kk], bfr, acc[nt]); } }
#pragma unroll
    for (int r = 0; r < 4; ++r) { const int t = 16 * F.wave + 4 * fq + r; const float bias = bs[t];
        const bf16_t* up = PROJ + (row0 + t) * NPROJ + h * HD + fr; bf16_t* op = MIX + (row0 + t) * D + h * HD + fr;
#pragma unroll
        for (int nt = 0; nt < 8; ++nt) op[16 * nt] = f2bf(bf2f(up[16 * nt]) * (acc[nt][r] + bias)); }
    __syncthreads();
}

constexpr int DN_QS = 0;
constexpr int DN_KS = 17408;
constexpr int DN_KT = 34816;
constexpr int DN_XT = 53248;
constexpr int DN_LN = 90112;
constexpr int DN_LD = 99328;
constexpr int DN_TI = 103680;
constexpr int DN_YT = 106752;
constexpr int DN_GC = 119040;
constexpr int DN_CW = 120064;
static_assert(DN_CW + 6144 <= RING_BYTES, "DeltaNet chunk LDS map");
__device__ __forceinline__ int tsw(int r, int pos) { return r * 72 + ((((pos >> 3) ^ (r >> 3)) & 7) << 3) + (pos & 7); }
struct DnPre { u32x4 xv[3][2][4]; float av, bv; };
__device__ __forceinline__ void dn_prefetch(const Frame& F, DnPre& P, int unit) {
    const int n = unit & 63, bh = unit >> 6, h = bh & 3, b = bh >> 2, fr = F.lane & 15, fq = F.lane >> 4;
    const bf16_t* PROJ = (const bf16_t*)(F.ws + WS_R3); const float* AB = (const float*)(F.ws + WS_AB);
    const size_t trow0 = (size_t)b * SEQ + (size_t)n * DNC;
    P.av = AB[(trow0 + F.lane) * 8 + h]; P.bv = AB[(trow0 + F.lane) * 8 + 4 + h];
#pragma unroll
    for (int ten = 0; ten < 3; ++ten) { const int ch = ten * 512 + h * HD + 8 * fr;
#pragma unroll
        for (int hp = 0; hp < 2; ++hp) { const int pos = hp * 32 + 4 * F.wave + fq;
#pragma unroll
            for (int j = 0; j < 4; ++j) { const int sp = n * DNC + pos - 3 + j;
                P.xv[ten][hp][j] = (sp >= 0) ? *(const u32x4*)(PROJ + ((size_t)b * SEQ + sp) * NPROJ + 1024 + ch) : (u32x4){0u, 0u, 0u, 0u}; } } }
}
__device__ __forceinline__ void dn_chunk(const Frame& F, const Args& a, int unit, DnPre& P, int next_unit) {
    const int n = unit & 63, bh = unit >> 6, h = bh & 3, b = bh >> 2;
    const LAS float* cwL = (const LAS float*)(F.lds + DN_CW);
    LAS unsigned char* L = F.lds;
    LAS bf16_t* qs = (LAS bf16_t*)(L + DN_QS); LAS bf16_t* ks = (LAS bf16_t*)(L + DN_KS); LAS bf16_t* kT = (LAS bf16_t*)(L + DN_KT); LAS bf16_t* XT = (LAS bf16_t*)(L + DN_XT);
    LAS bf16_t* Ln = (LAS bf16_t*)(L + DN_LN); LAS float* Ld = (LAS float*)(L + DN_LD); LAS bf16_t* Ti = (LAS bf16_t*)(L + DN_TI); LAS bf16_t* YT = (LAS bf16_t*)(L + DN_YT + F.wave * 1536);
    LAS float* gcs = (LAS float*)(L + DN_GC); LAS float* bts = gcs + 64; LAS float* egs = gcs + 128;
    const size_t trow0 = (size_t)b * SEQ + (size_t)n * DNC;
    int fr = F.lane & 15, fq = F.lane >> 4;
    asm volatile("" : "+v"(fr), "+v"(fq));
    float my_gc, my_beta, my_eg;
    {
        const float av = P.av, bv = P.bv;
        const float xg = av + a.in[8][h];
        const float sp = xg > 20.f ? xg : log1pf(__expf(xg));
        float g = -__expf(a.in[7][h]) * sp;
#pragma unroll
        for (int o = 1; o < 64; o <<= 1) { const float t = __shfl_up(g, o); if (F.lane >= o) g += t; }
        my_gc = g; my_beta = sigmoid_f(bv); my_eg = __expf(g);
        if (F.wave == 0) { gcs[F.lane] = my_gc; bts[F.lane] = my_beta; egs[F.lane] = my_eg; }
    }
    bf16_t* QDg = (bf16_t*)(F.ws + WS_QD) + (size_t)unit * 64 * 128;
#pragma unroll
    for (int ten = 0; ten < 3; ++ten) {
        f32x4 w0[4], w1[4];
#pragma unroll
        for (int j = 0; j < 4; ++j) { w0[j] = *(const LAS f32x4*)(cwL + (ten * 4 + j) * 128 + 8 * fr); w1[j] = *(const LAS f32x4*)(cwL + (ten * 4 + j) * 128 + 8 * fr + 4); }
#pragma unroll
        for (int hp = 0; hp < 2; ++hp) { const int pos = hp * 32 + 4 * F.wave + fq;
            float accv[8];
#pragma unroll
            for (int i = 0; i < 8; ++i) accv[i] = 0.f;
#pragma unroll
            for (int j = 0; j < 4; ++j) { const u32x4 x = P.xv[ten][hp][j];
                accv[0] += bflo(x[0]) * w0[j][0]; accv[1] += bfhi(x[0]) * w0[j][1]; accv[2] += bflo(x[1]) * w0[j][2]; accv[3] += bfhi(x[1]) * w0[j][3];
                accv[4] += bflo(x[2]) * w1[j][0]; accv[5] += bfhi(x[2]) * w1[j][1]; accv[6] += bflo(x[3]) * w1[j][2]; accv[7] += bfhi(x[3]) * w1[j][3]; }
            float ss = 0.f;
#pragma unroll
            for (int i = 0; i < 8; ++i) { accv[i] = silu_f(accv[i]); ss += accv[i] * accv[i]; }
#pragma unroll
            for (int o = 1; o < 16; o <<= 1) ss += __shfl_xor(ss, o);
            const float bp = __shfl(my_beta, pos), ep = __shfl(my_eg, pos);
            if (ten == 0) { const float sc = rsqrtf(ss + EPS) * 0.08838834764831845f;
#pragma unroll
                for (int i = 0; i < 8; ++i) accv[i] *= sc;
                u32x4 w; w.x = cvt_pk_bf16(accv[0], accv[1]); w.y = cvt_pk_bf16(accv[2], accv[3]); w.z = cvt_pk_bf16(accv[4], accv[5]); w.w = cvt_pk_bf16(accv[6], accv[7]);
                *(LAS u32x4*)(qs + pos * 136 + 8 * fr) = w;
                u32x4 wd; wd.x = cvt_pk_bf16(accv[0] * ep, accv[1] * ep); wd.y = cvt_pk_bf16(accv[2] * ep, accv[3] * ep); wd.z = cvt_pk_bf16(accv[4] * ep, accv[5] * ep); wd.w = cvt_pk_bf16(accv[6] * ep, accv[7] * ep);
                *(u32x4*)(QDg + pos * 128 + 8 * fr) = wd;
            } else if (ten == 1) { const float sc = rsqrtf(ss + EPS);
#pragma unroll
                for (int i = 0; i < 8; ++i) accv[i] *= sc;
                u32x4 w; w.x = cvt_pk_bf16(accv[0], accv[1]); w.y = cvt_pk_bf16(accv[2], accv[3]); w.z = cvt_pk_bf16(accv[4], accv[5]); w.w = cvt_pk_bf16(accv[6], accv[7]);
                *(LAS u32x4*)(ks + pos * 136 + 8 * fr) = w;
                const float rs = bp * ep;
#pragma unroll
                for (int i = 0; i < 8; ++i) { kT[tsw(8 * fr + i, pos)] = f2bf(accv[i]); XT[tsw(128 + 8 * fr + i, pos)] = f2bf(accv[i] * rs); }
            } else {
#pragma unroll
                for (int i = 0; i < 8; ++i) XT[tsw(8 * fr + i, pos)] = f2bf(accv[i] * bp);
            }
        }
    }
    if (next_unit >= 0) dn_prefetch(F, P, next_unit);
    LDS_WAIT(); __syncthreads();
    bf16_t* ATg = (bf16_t*)(F.ws + WS_AT) + (size_t)unit * 64 * 64;
    {
        const int mt = F.wave & 3; const LAS bf16_t* Asrc = (F.wave < 4) ? ks : qs;
        f32x4 acc[4];
#pragma unroll
        for (int nt = 0; nt < 4; ++nt) acc[nt] = (f32x4){0.f, 0.f, 0.f, 0.f};
#pragma unroll
        for (int kk = 0; kk < 4; ++kk) { const bf16x8 af = *(const LAS bf16x8*)(Asrc + (16 * mt + fr) * 136 + 32 * kk + 8 * fq);
#pragma unroll
            for (int nt = 0; nt < 4; ++nt) { const bf16x8 bfr = *(const LAS bf16x8*)(ks + (16 * nt + fr) * 136 + 32 * kk + 8 * fq); acc[nt] = MFMA16(af, bfr, acc[nt]); } }
#pragma unroll
        for (int r = 0; r < 4; ++r) { const int i = 16 * mt + 4 * fq + r; const float gi = gcs[i], bi = bts[i];
#pragma unroll
            for (int nt = 0; nt < 4; ++nt) { const int j = 16 * nt + fr; const float dec = __expf(fminf(gi - gcs[j], 0.f));
                if (F.wave < 4) { const float lv = (j < i) ? bi * acc[nt][r] * dec : 0.f; Ln[i * 72 + j] = f2bf(-lv); if (nt == mt) Ld[(mt * 16 + 4 * fq + r) * 17 + fr] = lv; }
                else ATg[i * 64 + j] = f2bf((j <= i) ? acc[nt][r] * dec : 0.f); } }
    }
    LDS_WAIT(); __syncthreads();
    if (F.wave == 0) {
        const int blk = fq, c = fr;
        float t[16];
#pragma unroll
        for (int i = 0; i < 16; ++i) { float s = (i == c) ? 1.f : 0.f;
#pragma unroll
            for (int j = 0; j < i; ++j) s -= Ld[(blk * 16 + i) * 17 + j] * t[j];
            t[i] = s; }
#pragma unroll
        for (int i = 0; i < 16; ++i) Ti[(16 * blk + i) * 24 + c] = f2bf(t[i]);
    } else {
        bf16_t* KETg = (bf16_t*)(F.ws + WS_KET) + (size_t)unit * 128 * 64;
        const float glast = gcs[63];
        for (int idx = F.tid - 64; idx < 128 * 8; idx += NTHREADS - 64) {
            const int d = idx >> 3, gp = idx & 7;
            const u32x4 v = *(const LAS u32x4*)(kT + tsw(d, 8 * gp)); u32x4 w;
#pragma unroll
            for (int i = 0; i < 4; ++i) w[i] = cvt_pk_bf16(bflo(v[i]) * __expf(glast - gcs[8 * gp + 2 * i]), bfhi(v[i]) * __expf(glast - gcs[8 * gp + 2 * i + 1]));
            *(u32x4*)(KETg + d * 64 + 8 * gp) = w;
        }
        if (F.tid == 64) ((float*)(F.ws + WS_GLAST))[unit] = __expf(glast);
    }
    LDS_WAIT(); __syncthreads();
    {
        bf16_t* Og = (bf16_t*)(F.ws + (F.wave < 4 ? WS_UC : WS_WC)) + (size_t)unit * 64 * 128;
        const int ncol0 = (F.wave & 3) * 32;
        const bf16x8 zf = (bf16x8){0, 0, 0, 0, 0, 0, 0, 0};
#pragma unroll
        for (int bb = 0; bb < 4; ++bb) {
            f32x4 acc[2];
#pragma unroll
            for (int t = 0; t < 2; ++t) { const u32x2 rv = *(const LAS u32x2*)(XT + tsw(32 * F.wave + 16 * t + fr, 16 * bb + 4 * fq));
                acc[t] = (f32x4){bflo(rv.x), bfhi(rv.x), bflo(rv.y), bfhi(rv.y)}; }
            if (bb >= 1) {
#pragma unroll
                for (int kk = 0; kk < 2; ++kk) if (32 * kk < 16 * bb) {
                    bf16x8 af = *(const LAS bf16x8*)(Ln + (16 * bb + fr) * 72 + 32 * kk + 8 * fq);
                    if (32 * kk + 8 * fq >= 16 * bb) af = zf;
#pragma unroll
                    for (int t = 0; t < 2; ++t) { const bf16x8 bfr = *(const LAS bf16x8*)(XT + tsw(32 * F.wave + 16 * t + fr, 32 * kk + 8 * fq)); acc[t] = MFMA16(af, bfr, acc[t]); }
                }
            }
#pragma unroll
            for (int t = 0; t < 2; ++t) { u32x2 w; w.x = cvt_pk_bf16(acc[t][0], acc[t][1]); w.y = cvt_pk_bf16(acc[t][2], acc[t][3]); *(LAS u32x2*)(YT + (16 * t + fr) * 24 + 4 * fq) = w; }
            LDS_WAIT();
            bf16x8 a2 = *(const LAS bf16x8*)(Ti + (16 * bb + fr) * 24 + 8 * (fq & 1));
            if (fq >= 2) a2 = zf;
#pragma unroll
            for (int t = 0; t < 2; ++t) { bf16x8 b2 = *(const LAS bf16x8*)(YT + (16 * t + fr) * 24 + 8 * (fq & 1)); if (fq >= 2) b2 = zf;
                f32x4 x = MFMA16(a2, b2, ((f32x4){0.f, 0.f, 0.f, 0.f}));
                u32x2 w; w.x = cvt_pk_bf16(x[0], x[1]); w.y = cvt_pk_bf16(x[2], x[3]);
                *(LAS u32x2*)(XT + tsw(32 * F.wave + 16 * t + fr, 16 * bb + 4 * fq)) = w;
                if (F.wave < 4) *(u32x2*)(Og + (ncol0 + 16 * t + fr) * 64 + 16 * bb + 4 * fq) = w;
                else {
#pragma unroll
                    for (int r = 0; r < 4; ++r) Og[(16 * bb + 4 * fq + r) * 128 + ncol0 + 16 * t + fr] = f2bf(x[r]); } }
            LDS_WAIT();
        }
    }
    LDS_WAIT(); __syncthreads();
}

constexpr int SC_WC = 0, SC_QD = 17408, SC_AT = 34816, SC_KE = 44032, SC_UC = 62464, SC_GL = 64512, SC_BUF = 64768;
constexpr int SC_ST = 2 * SC_BUF, SC_VT = SC_ST + 4352;
static_assert(SC_VT + 2304 <= RING_BYTES, "scan LDS map");
__device__ __forceinline__ void scan_stage(const Frame& F, LAS unsigned char* buf, size_t cu, int sl, int ltid, int nld) {
    const bf16_t* wc = (const bf16_t*)(F.ws + WS_WC) + cu * 8192; const bf16_t* qd = (const bf16_t*)(F.ws + WS_QD) + cu * 8192; const bf16_t* uc = (const bf16_t*)(F.ws + WS_UC) + cu * 8192 + (size_t)sl * 16 * 64;
    const bf16_t* ke = (const bf16_t*)(F.ws + WS_KET) + cu * 8192; const bf16_t* at = (const bf16_t*)(F.ws + WS_AT) + cu * 4096;
    u32x4 v[9];
#pragma unroll
    for (int i = 0; i < 9; ++i) { const int p = ltid + i * nld;
        const bf16_t* src = wc;
        if (p < 1024) src = wc + (p >> 4) * 128 + (p & 15) * 8;
        else if (p < 2048) src = qd + ((p - 1024) >> 4) * 128 + (p & 15) * 8;
        else if (p < 2560) src = at + (p - 2048) * 8;
        else if (p < 3584) src = ke + (p - 2560) * 8;
        else if (p < 3712) src = uc + (p - 3584) * 8;
        v[i] = (p < 3712) ? *(const u32x4*)src : (u32x4){0u, 0u, 0u, 0u}; }
    if (ltid == 0) *(LAS float*)(buf + SC_GL) = ((const float*)(F.ws + WS_GLAST))[cu];
#pragma unroll
    for (int i = 0; i < 9; ++i) { const int p = ltid + i * nld;
        LAS unsigned char* dst = buf;
        if (p < 1024) dst = buf + SC_WC + ((p >> 4) * 136 + (p & 15) * 8) * 2;
        else if (p < 2048) dst = buf + SC_QD + (((p - 1024) >> 4) * 136 + (p & 15) * 8) * 2;
        else if (p < 2560) dst = buf + SC_AT + (((p - 2048) >> 3) * 72 + (p & 7) * 8) * 2;
        else if (p < 3584) dst = buf + SC_KE + (((p - 2560) >> 3) * 72 + (p & 7) * 8) * 2;
        else dst = buf + SC_UC + (p - 3584) * 16;
        if (p < 3712) *(LAS u32x4*)dst = v[i]; }
}
__device__ __forceinline__ void dn_scan(const Frame& F, int item) {
    const int bh = item >> 3, sl = item & 7, h = bh & 3, b = bh >> 2;
    LAS bf16_t* ST = (LAS bf16_t*)(F.lds + SC_ST); LAS bf16_t* VT = (LAS bf16_t*)(F.lds + SC_VT);
    const int fr = F.lane & 15, fq = F.lane >> 4;
    float* Og = (float*)(F.ws + WS_O);
    f32x4 S[8];
#pragma unroll
    for (int mt = 0; mt < 8; ++mt) S[mt] = (f32x4){0.f, 0.f, 0.f, 0.f};
    if (F.wave == 0) {
#pragma unroll
        for (int mt = 0; mt < 8; ++mt) *(LAS u32x2*)(ST + fr * 136 + 16 * mt + 4 * fq) = (u32x2){0u, 0u};
    }
    scan_stage(F, F.lds, (size_t)bh * NCH, sl, F.tid, NTHREADS);
    LDS_WAIT(); __syncthreads();
#pragma unroll 1
    for (int n = 0; n < NCH; ++n) {
        LAS unsigned char* buf = F.lds + (n & 1) * SC_BUF;
        if (F.wave != 0) {
            if (n + 1 < NCH) scan_stage(F, F.lds + ((n + 1) & 1) * SC_BUF, (size_t)bh * NCH + n + 1, sl, F.tid - 64, NTHREADS - 64);
        } else {
            const LAS bf16_t* wc = (const LAS bf16_t*)(buf + SC_WC); const LAS bf16_t* qd = (const LAS bf16_t*)(buf + SC_QD); const LAS bf16_t* at = (const LAS bf16_t*)(buf + SC_AT);
            const LAS bf16_t* ke = (const LAS bf16_t*)(buf + SC_KE); const LAS bf16_t* uc = (const LAS bf16_t*)(buf + SC_UC);
            bf16x8 sb[4];
#pragma unroll
            for (int kk = 0; kk < 4; ++kk) sb[kk] = *(const LAS bf16x8*)(ST + fr * 136 + 32 * kk + 8 * fq);
            f32x4 vn[4], oo[4];
#pragma unroll
            for (int mt = 0; mt < 4; ++mt) { vn[mt] = (f32x4){0.f, 0.f, 0.f, 0.f}; oo[mt] = (f32x4){0.f, 0.f, 0.f, 0.f};
#pragma unroll
                for (int kk = 0; kk < 4; ++kk) { const bf16x8 aw = *(const LAS bf16x8*)(wc + (16 * mt + fr) * 136 + 32 * kk + 8 * fq), aq = *(const LAS bf16x8*)(qd + (16 * mt + fr) * 136 + 32 * kk + 8 * fq);
                    vn[mt] = MFMA16(aw, sb[kk], vn[mt]); oo[mt] = MFMA16(aq, sb[kk], oo[mt]); } }
#pragma unroll
            for (int mt = 0; mt < 4; ++mt) { const u32x2 uv = *(const LAS u32x2*)(uc + fr * 64 + 16 * mt + 4 * fq);
                vn[mt][0] = bflo(uv.x) - vn[mt][0]; vn[mt][1] = bfhi(uv.x) - vn[mt][1]; vn[mt][2] = bflo(uv.y) - vn[mt][2]; vn[mt][3] = bfhi(uv.y) - vn[mt][3];
                u32x2 w; w.x = cvt_pk_bf16(vn[mt][0], vn[mt][1]); w.y = cvt_pk_bf16(vn[mt][2], vn[mt][3]);
                *(LAS u32x2*)(VT + fr * 72 + 16 * mt + 4 * fq) = w; }
            LDS_WAIT();
            bf16x8 vb[2];
#pragma unroll
            for (int kk = 0; kk < 2; ++kk) vb[kk] = *(const LAS bf16x8*)(VT + fr * 72 + 32 * kk + 8 * fq);
#pragma unroll
            for (int mt = 0; mt < 4; ++mt) {
#pragma unroll
                for (int kk = 0; kk < 2; ++kk) { const bf16x8 aa = *(const LAS bf16x8*)(at + (16 * mt + fr) * 72 + 32 * kk + 8 * fq); oo[mt] = MFMA16(aa, vb[kk], oo[mt]); }
#pragma unroll
                for (int r = 0; r < 4; ++r) Og[((size_t)b * SEQ + (size_t)n * DNC + 16 * mt + 4 * fq + r) * 512 + h * HD + 16 * sl + fr] = oo[mt][r]; }
            const float dec = *(const LAS float*)(buf + SC_GL);
#pragma unroll
            for (int mt = 0; mt < 8; ++mt) { S[mt] = S[mt] * dec;
#pragma unroll
                for (int kk = 0; kk < 2; ++kk) { const bf16x8 ak = *(const LAS bf16x8*)(ke + (16 * mt + fr) * 72 + 32 * kk + 8 * fq); S[mt] = MFMA16(ak, vb[kk], S[mt]); }
                u32x2 w; w.x = cvt_pk_bf16(S[mt][0], S[mt][1]); w.y = cvt_pk_bf16(S[mt][2], S[mt][3]);
                *(LAS u32x2*)(ST + fr * 136 + 16 * mt + 4 * fq) = w; }
        }
        LDS_WAIT(); __syncthreads();
    }
}

__device__ __forceinline__ void dn_out(const Frame& F, const Args& a) {
    const int gw = F.vcu * NWAVES + F.wave, NGW = F.G * NWAVES;
    const float* Og = (const float*)(F.ws + WS_O); const bf16_t* PROJ = (const bf16_t*)(F.ws + WS_R3); bf16_t* MIX = (bf16_t*)(F.ws + WS_MIX);
    const float* ng = a.in[9] + 8 * (F.lane & 15);
    const f32x4 g0 = *(const f32x4*)ng, g1 = *(const f32x4*)(ng + 4);
    for (int m = gw; m < T; m += NGW) {
        const float* op = Og + (size_t)m * 512 + 8 * F.lane;
        f32x4 o0 = *(const f32x4*)op, o1 = *(const f32x4*)(op + 4);
        const u32x4 z = *(const u32x4*)(PROJ + (size_t)m * NPROJ + 2560 + 8 * F.lane);
        float ss = (o0[0] * o0[0] + o0[1] * o0[1]) + (o0[2] * o0[2] + o0[3] * o0[3]) + (o1[0] * o1[0] + o1[1] * o1[1]) + (o1[2] * o1[2] + o1[3] * o1[3]);
#pragma unroll
        for (int o = 1; o < 16; o <<= 1) ss += __shfl_xor(ss, o);
        const float rstd = rsqrtf(ss * (1.0f / HD) + EPS);
        o0 = o0 * rstd * g0; o1 = o1 * rstd * g1;
        u32x4 w; w.x = cvt_pk_bf16(o0[0] * bflo(z[0]), o0[1] * bfhi(z[0])); w.y = cvt_pk_bf16(o0[2] * bflo(z[1]), o0[3] * bfhi(z[1]));
        w.z = cvt_pk_bf16(o1[0] * bflo(z[2]), o1[1] * bfhi(z[2])); w.w = cvt_pk_bf16(o1[2] * bflo(z[3]), o1[3] * bfhi(z[3]));
        *(u32x4*)(MIX + (size_t)m * D + 512 + 8 * F.lane) = w;
    }
}

__device__ __forceinline__ void norm_h(const Frame& F, const Args& a) {
    const int gw = F.vcu * NWAVES + F.wave, NGW = F.G * NWAVES;
    const float* H = (const float*)(F.ws + WS_H); bf16_t* HN = (bf16_t*)(F.ws + WS_HN); const float* g2 = a.in[11];
    f32x4 gv[4];
#pragma unroll
    for (int j = 0; j < 4; ++j) gv[j] = *(const f32x4*)(g2 + 4 * F.lane + 256 * j);
    for (int m = gw; m < T; m += NGW) {
        const f32x4* xr = (const f32x4*)(H + (size_t)m * D) + F.lane;
        f32x4 v[4]; float ss = 0.f;
#pragma unroll
        for (int j = 0; j < 4; ++j) { v[j] = xr[64 * j]; ss += (v[j][0] * v[j][0] + v[j][1] * v[j][1]) + (v[j][2] * v[j][2] + v[j][3] * v[j][3]); }
        const float rstd = rsqrtf(wave_sum(ss) * (1.0f / D) + EPS);
        u32x2* yo = (u32x2*)(HN + (size_t)m * D) + F.lane; unsigned* y8 = (unsigned*)(F.ws + WS_HN8 + (size_t)m * D) + F.lane;
#pragma unroll
        for (int j = 0; j < 4; ++j) { const f32x4 y = v[j] * rstd * gv[j]; u32x2 w; w.x = cvt_pk_bf16(y[0], y[1]); w.y = cvt_pk_bf16(y[2], y[3]); yo[64 * j] = w; y8[64 * j] = cvt4_fp8(y[0], y[1], y[2], y[3]); }
    }
}

__device__ __forceinline__ void router(const Frame& F, const Args& a) {
    const int gw = F.vcu * NWAVES + F.wave, NGW = F.G * NWAVES;
    const bf16_t* HN = (const bf16_t*)(F.ws + WS_HN); const bf16_t* RWT = (const bf16_t*)(F.ws + WS_RWT); const float* rb = a.in[13];
    int* EIDX = (int*)(F.ws + WS_EIDX); float* GATEW = (float*)(F.ws + WS_GATEW); int* EPOS = (int*)(F.ws + WS_EPOS); int* LIST = (int*)(F.ws + WS_LIST);
    unsigned* cnt = (unsigned*)(F.ws + WS_CTL) + CW_CNT;
    LAS float* lg = (LAS float*)(F.lds + F.wave * 2304);
    const int fr = F.lane & 15, fq = F.lane >> 4;
    for (int tile = gw; tile < T / 16; tile += NGW) {
        const size_t r0 = (size_t)tile * 16;
        f32x4 acc0 = (f32x4){0.f, 0.f, 0.f, 0.f}, acc1 = acc0;
#pragma unroll 4
        for (int kk = 0; kk < 32; ++kk) {
            const bf16x8 af = *(const bf16x8*)(HN + (r0 + fr) * D + 32 * kk + 8 * fq);
            const bf16x8 b0 = *(const bf16x8*)(RWT + (size_t)fr * D + 32 * kk + 8 * fq), b1 = *(const bf16x8*)(RWT + (size_t)(16 + fr) * D + 32 * kk + 8 * fq);
            acc0 = MFMA16(af, b0, acc0); acc1 = MFMA16(af, b1, acc1);
        }
        const float bb0 = rb[fr], bb1 = rb[16 + fr];
#pragma unroll
        for (int r = 0; r < 4; ++r) { lg[(4 * fq + r) * 36 + fr] = acc0[r] + bb0; lg[(4 * fq + r) * 36 + 16 + fr] = acc1[r] + bb1; }
        LDS_WAIT();
        if (F.lane < 16) {
            const int row = F.lane; const size_t t = r0 + row;
            float v[32];
#pragma unroll
            for (int q = 0; q < 8; ++q) { const f32x4 x = *(const LAS f32x4*)(lg + row * 36 + 4 * q); v[4 * q] = x[0]; v[4 * q + 1] = x[1]; v[4 * q + 2] = x[2]; v[4 * q + 3] = x[3]; }
            float tv[4]; int ti[4];
#pragma unroll
            for (int k = 0; k < 4; ++k) { float best = -3.0e38f; int bi = 0;
#pragma unroll
                for (int e = 0; e < 32; ++e) { if (v[e] > best) { best = v[e]; bi = e; } }
                tv[k] = best; ti[k] = bi;
#pragma unroll
                for (int e = 0; e < 32; ++e) v[e] = (e == bi) ? -3.0e38f : v[e]; }
            const float e1 = __expf(tv[1] - tv[0]), e2 = __expf(tv[2] - tv[0]), e3 = __expf(tv[3] - tv[0]); const float inv = 1.0f / (1.0f + e1 + e2 + e3);
            const float gk[4] = {inv, e1 * inv, e2 * inv, e3 * inv};
#pragma unroll
            for (int k = 0; k < 4; ++k) {
                const unsigned pos = __hip_atomic_fetch_add(cnt + 64 * ti[k], 1u, __ATOMIC_RELAXED, __HIP_MEMORY_SCOPE_AGENT);
                EIDX[t * 4 + k] = ti[k]; GATEW[t * 4 + k] = gk[k]; EPOS[t * 4 + k] = (int)pos; LIST[(size_t)ti[k] * T + pos] = (int)(t * 4 + k);
            }
        }
        LDS_WAIT();
    }
}

constexpr int TB_OFF = 131072;
__device__ __forceinline__ void build_tables(const Frame& F) {
    LAS int* pst = (LAS int*)(F.lds + TB_OFF); LAS int* cn = pst + 40; LAS int* tile_e = pst + 80;
    const unsigned* cnt = (const unsigned*)(F.ws + WS_CTL) + CW_CNT;
    if (F.tid < 64) {
        const int e = F.lane & 31; const int c = (int)__hip_atomic_load(cnt + 64 * e, __ATOMIC_RELAXED, __HIP_MEMORY_SCOPE_AGENT);
        const int padded = (c + 255) & ~255;
        int incl = padded;
#pragma unroll
        for (int o = 1; o < 32; o <<= 1) { const int t = __shfl_up(incl, o); if (e >= o) incl += t; }
        if (F.lane < 32) { pst[e] = incl - padded; cn[e] = c; if (e == 31) pst[32] = incl;
            for (int j = 0; j < padded / 256; ++j) tile_e[(incl - padded) / 256 + j] = e; }
    }
    LDS_WAIT(); __syncthreads();
}

__device__ __forceinline__ void gather_rows(const Frame& F) {
    const int gw = F.vcu * NWAVES + F.wave, NGW = F.G * NWAVES;
    LAS int* pst = (LAS int*)(F.lds + TB_OFF); LAS int* cn = pst + 40; LAS int* tile_e = pst + 80;
    const unsigned char* HN8 = F.ws + WS_HN8; unsigned char* XS = F.ws + WS_R3;
    const int* EIDX = (const int*)(F.ws + WS_EIDX); const int* EPOS = (const int*)(F.ws + WS_EPOS); const float* GATEW = (const float*)(F.ws + WS_GATEW); float* GSORT = (float*)(F.ws + WS_GSORT); int* ROWOF = (int*)(F.ws + WS_ROWOF);
    const int rtot = pst[32];
    for (int tl = gw; tl < (rtot >> 8); tl += NGW) { const int e = tile_e[tl], first = pst[e] + cn[e], lo = tl << 8;
        for (int R = (first > lo ? first : lo); R < lo + 256; ++R) { *((u32x4*)(XS + (size_t)R * D) + F.lane) = (u32x4){0u, 0u, 0u, 0u}; if (F.lane == 0) GSORT[R] = 0.f; } }
    for (int t0 = gw * 4; t0 < T; t0 += NGW * 4) {
        int Rl = 0;
        if (F.lane < 16) { const int a = t0 * 4 + F.lane; const int e = EIDX[a]; Rl = pst[e] + EPOS[a]; ROWOF[a] = Rl; GSORT[Rl] = GATEW[a]; }
        u32x4 v[4];
#pragma unroll
        for (int j = 0; j < 4; ++j) v[j] = *((const u32x4*)(HN8 + (size_t)(t0 + j) * D) + F.lane);
#pragma unroll
        for (int j = 0; j < 4; ++j)
#pragma unroll
            for (int k = 0; k < 4; ++k) { const int R = __builtin_amdgcn_readlane(Rl, 4 * j + k); *((u32x4*)(XS + (size_t)R * D) + F.lane) = v[j]; }
    }
}

__device__ __forceinline__ void combine(const Frame& F, const Args& a) {
    const int gw = F.vcu * NWAVES + F.wave, NGW = F.G * NWAVES;
    const float* H = (const float*)(F.ws + WS_H); const unsigned char* YS = F.ws + WS_YS; const int* ROWOF = (const int*)(F.ws + WS_ROWOF); const float* gf = a.in[18];
    f32x4 gv[4];
#pragma unroll
    for (int j = 0; j < 4; ++j) gv[j] = *(const f32x4*)(gf + 4 * F.lane + 256 * j);
    for (int m = gw; m < T; m += NGW) {
        const f32x4* xr = (const f32x4*)(H + (size_t)m * D) + F.lane;
        f32x4 v[4];
#pragma unroll
        for (int j = 0; j < 4; ++j) v[j] = xr[64 * j];
#if !defined(DBG_SKIP_MOE)
#pragma unroll
        for (int k = 0; k < 4; ++k) { const int R = ROWOF[m * 4 + k]; const int* yr = (const int*)(YS + (size_t)R * D) + F.lane;
#pragma unroll
            for (int j = 0; j < 4; ++j) { const int w = yr[64 * j]; const f32x2 lo = __builtin_amdgcn_cvt_pk_f32_fp8(w, false), hi = __builtin_amdgcn_cvt_pk_f32_fp8(w, true);
                v[j][0] += lo.x; v[j][1] += lo.y; v[j][2] += hi.x; v[j][3] += hi.y; } }
#endif
        float ss = 0.f;
#pragma unroll
        for (int j = 0; j < 4; ++j) ss += (v[j][0] * v[j][0] + v[j][1] * v[j][1]) + (v[j][2] * v[j][2] + v[j][3] * v[j][3]);
        const float rstd = rsqrtf(wave_sum(ss) * (1.0f / D) + EPS);
        f32x4* o = (f32x4*)(a.out + (size_t)m * D) + F.lane;
#pragma unroll
        for (int j = 0; j < 4; ++j) o[64 * j] = v[j] * rstd * gv[j];
    }
}

__device__ __forceinline__ void dbg_dump(const Frame& F, const Args& a, int what) {
    const int gw = F.vcu * NWAVES + F.wave, NGW = F.G * NWAVES;
    for (int m = gw; m < T; m += NGW) {
        for (int c = F.lane; c < D; c += 64) {
            float v = 0.f;
            if (what == 1) v = bf2f(((const bf16_t*)(F.ws + WS_R3))[(size_t)m * NPROJ + c]);
            else if (what == 2) v = bf2f(((const bf16_t*)(F.ws + WS_MIX))[(size_t)m * D + c]);
            else if (what == 3) v = ((const float*)(F.ws + WS_O))[(size_t)m * 512 + (c & 511)];
            else if (what == 4) v = ((const float*)(F.ws + WS_H))[(size_t)m * D + c];
            else if (what == 5) v = bf2f(((const bf16_t*)(F.ws + WS_R3))[(size_t)m * NPROJ + 1024 + c]);
            else if (what == 6) v = bf2f(((const bf16_t*)(F.ws + WS_R3))[(size_t)m * NPROJ + 2048 + c]);
            else if (what == 7) v = bf2f(((const bf16_t*)(F.ws + WS_Y))[(size_t)m * D + c]);
            else if (what == 9) v = bf2f(((const bf16_t*)(F.ws + WS_WC))[((size_t)m * D + c) & 0xFFFFFF]);
            else if (what == 10) v = bf2f(((const bf16_t*)(F.ws + WS_UC))[((size_t)m * D + c) & 0xFFFFFF]);
            else if (what == 11) v = bf2f(((const bf16_t*)(F.ws + WS_QD))[((size_t)m * D + c) & 0xFFFFFF]);
            else if (what == 12) v = bf2f(((const bf16_t*)(F.ws + WS_KET))[((size_t)m * D + c) & 0xFFFFFF]);
            else if (what == 13) v = bf2f(((const bf16_t*)(F.ws + WS_AT))[((size_t)m * D + c) & 0x7FFFFF]);
            else if (what == 14) v = ((const float*)(F.ws + WS_AB))[(size_t)m * 8 + (c & 7)];
            else if (what == 8) v = bf2f(((const bf16_t*)(F.ws + WS_MIX))[(size_t)m * D + (c & 511)]);
            if (!(v - v == 0.f)) v = 12345.f;
            a.out[(size_t)m * D + c] = v;
        }
    }
}

constexpr int NPHASES = 12;
__global__ void __launch_bounds__(NTHREADS, 2) fwd(Args args) {
    __shared__ __attribute__((aligned(16))) unsigned char lds_raw[LDS_BYTES];
    Frame F;
    F.lds = (LAS unsigned char*)lds_raw;
    F.tid = threadIdx.x; F.lane = F.tid & 63; F.wave = __builtin_amdgcn_readfirstlane(F.tid >> 6);
    F.G = gridDim.x; { const int bx = blockIdx.x; F.vcu = (F.G % 8 == 0) ? (bx % 8) * (F.G / 8) + bx / 8 : bx; }
    F.ws = args.ws;
    volatile LAS unsigned* MISC = (volatile LAS unsigned*)(F.lds + LDSCTL_OFF);
    for (int u = F.tid; u < (LDS_BYTES - LDSCTL_OFF) / 4; u += NTHREADS) MISC[u] = 0u;
    __syncthreads();
#if !MK_PER_PHASE
    XcdBarrier bar = xcd_barrier_post((unsigned*)(F.ws + WS_CTL) + CW_BAR, MISC + 8);
#define GRID_BAR() xcd_barrier(bar)
#else
#define GRID_BAR() do { } while (0)
#endif
    const int lo = args.ph_lo, hi = args.ph_hi;
#define IN(k) (lo <= (k) && (k) < hi)
#ifndef PROBE_DOUBLE
#define PROBE_DOUBLE (-1)
#endif
#define REP(k) for (int rep_ = 0; rep_ < ((PROBE_DOUBLE) == (k) ? 2 : 1); ++rep_)
#define SEAM(k) do { if (IN(k) && IN((k) + 1)) GRID_BAR(); } while (0)

    if (IN(0)) REP(0) { p0_prologue(F, args); } SEAM(0);
    if (IN(1)) REP(1) {
        pg8::Gemm g{(const bf16_t*)(F.ws + WS_Y), (const bf16_t*)(F.ws + WS_WIN), T, NPROJ, D}; pg8::StaticOrder S; S.init(T, NPROJ, F.G, (int)blockIdx.x);
        pg8::EpiProj E{(bf16_t*)(F.ws + WS_R3)};
        pg8::gemm_phase<pg8::EpiProj, pg8::StaticOrder>(F.lds, g, S, E);
    } SEAM(1);
    if (IN(2)) REP(2) {
        for (int u = F.vcu; u < NB * 32 * NH; u += F.G) gmlp_unit(F, args, u);
        if (F.vcu < NCHUNKS) {
            const int h0 = (F.vcu >> 6) & 3;
            DnPre P; int hcur = -1;
            dn_prefetch(F, P, F.vcu);
            for (int u = F.vcu; u < NCHUNKS; u += F.G) {
                const int hh = (u >> 6) & 3;
                if (hh != hcur) { __syncthreads(); for (int i = F.tid; i < 3 * 4 * 128; i += NTHREADS) { const int ten = i / 512, j = (i >> 7) & 3, c = i & 127; ((LAS float*)(F.lds + DN_CW))[i] = args.in[6][(size_t)j * 1536 + ten * 512 + hh * HD + c]; } hcur = hh; LDS_WAIT(); __syncthreads(); }
                dn_chunk(F, args, u, P, (u + F.G < NCHUNKS) ? u + F.G : -1);
            }
            (void)h0;
        }
    } SEAM(2);
    if (IN(3)) REP(3) {
        for (int it = F.vcu; it < NB * NH * 8; it += F.G) dn_scan(F, it);
    } SEAM(3);
    if (IN(4)) REP(4) { dn_out(F, args); } SEAM(4);
    if (IN(5)) REP(5) {
        pg8::Gemm g{(const bf16_t*)(F.ws + WS_MIX), (const bf16_t*)(F.ws + WS_WOUT), T, D, D}; pg8::StaticOrder S; S.init(T, D, F.G, (int)blockIdx.x);
        pg8::EpiResid E{args.in[0], (float*)(F.ws + WS_H)};
        pg8::gemm_phase<pg8::EpiResid, pg8::StaticOrder>(F.lds, g, S, E);
    } SEAM(5);
    if (IN(6)) REP(6) { norm_h(F, args); } SEAM(6);
    if (IN(7)) { router(F, args); } SEAM(7);
    if (IN(8)) { build_tables(F); REP(8) gather_rows(F); } SEAM(8);
    if (IN(9)) {
        if (!IN(8)) build_tables(F);
        const int rtot = ((LAS int*)(F.lds + TB_OFF))[32];
        REP(9) {
        pg8::Gemm g{(const bf16_t*)(F.ws + WS_R3), (const bf16_t*)(F.ws + WS_WGU), rtot, 2048, D / 2}; pg8::MoeOrder S; S.init(rtot, 2048, F.G, (int)blockIdx.x); S.tile_e = (const LAS int*)(F.lds + TB_OFF) + 80;
        pg8::EpiSwiglu E{F.ws + WS_R4, args.in[15]};
        pg8::gemm_phase<pg8::EpiSwiglu, pg8::MoeOrder, true>(F.lds, g, S, E);
        }
    } SEAM(9);
    if (IN(10)) {
        if (!IN(9)) build_tables(F);
        const int rtot = ((LAS int*)(F.lds + TB_OFF))[32];
        REP(10) {
        pg8::Gemm g{(const bf16_t*)(F.ws + WS_R4), (const bf16_t*)(F.ws + WS_WDN), rtot, D, DFF / 2}; pg8::MoeOrder S; S.init(rtot, D, F.G, (int)blockIdx.x); S.tile_e = (const LAS int*)(F.lds + TB_OFF) + 80;
        pg8::EpiDown E{F.ws + WS_YS, args.in[17], (const float*)(F.ws + WS_GSORT)};
        pg8::gemm_phase<pg8::EpiDown, pg8::MoeOrder, true>(F.lds, g, S, E);
        }
    } SEAM(10);
    if (IN(11)) REP(11) { combine(F, args); }
#if defined(DBG_DUMP)
    if (IN(12)) { dbg_dump(F, args, DBG_DUMP); }
#endif
#undef IN
#undef SEAM
}

extern "C" void kernel_launch(void* const* d_in, const int* in_sizes, int n_in, void* d_out, int out_size, void* d_ws, size_t ws_size, hipStream_t stream) {
    static int grid = 0;
    if (grid == 0) {
        if (n_in != 19 || out_size != T * D || ws_size < WS_END) { fprintf(stderr, "kernel_launch: unexpected shapes (n_in %d, out %d, ws %zu)\n", n_in, out_size, ws_size); grid = -1; return; }
        int dev = 0, cus = 0, per_cu = 0;
        if (hipGetDevice(&dev) != hipSuccess || hipDeviceGetAttribute(&cus, hipDeviceAttributeMultiprocessorCount, dev) != hipSuccess) { grid = -1; return; }
        if (hipOccupancyMaxActiveBlocksPerMultiprocessor(&per_cu, (const void*)fwd, NTHREADS, 0) != hipSuccess || per_cu < 1) fprintf(stderr, "kernel_launch: occupancy query reports %d\n", per_cu);
        (void)hipGetLastError();
        grid = cus;
    }
    if (grid < 0) return;
    (void)hipMemsetAsync((char*)d_ws + WS_CTL, 0, CTL_ZERO_BYTES, stream);
    Args a{};
    for (int i = 0; i < 19; ++i) a.in[i] = (const float*)d_in[i];
    a.out = (float*)d_out; a.ws = (unsigned char*)d_ws;
#if MK_PER_PHASE
    for (int p = 0; p < NPHASES; ++p) {
#if defined(DBG_DUMP)
        if (p > DBG_LAST) continue;
#endif
        a.ph_lo = p; a.ph_hi = p + 1; hipLaunchKernelGGL(fwd, dim3(grid), dim3(NTHREADS), 0, stream, a); }
#if defined(DBG_DUMP)
    a.ph_lo = 12; a.ph_hi = 13; hipLaunchKernelGGL(fwd, dim3(grid), dim3(NTHREADS), 0, stream, a);
#endif
#else
    a.ph_lo = 0; a.ph_hi = NPHASES; hipLaunchKernelGGL(fwd, dim3(grid), dim3(NTHREADS), 0, stream, a);
#endif
}
```

```cpp
#include <hip/hip_runtime.h>
#include <cstdio>
#include <cstdint>

#ifndef MK_PER_PHASE
#define MK_PER_PHASE 0
#endif

#define LAS __attribute__((address_space(3)))
#define GAS __attribute__((address_space(1)))
typedef unsigned short bf16_t;
typedef short bf16x8 __attribute__((ext_vector_type(8)));
typedef float f32x4 __attribute__((ext_vector_type(4)));
typedef float f32x2 __attribute__((ext_vector_type(2)));
typedef unsigned u32x4 __attribute__((ext_vector_type(4)));
typedef unsigned u32x2 __attribute__((ext_vector_type(2)));
typedef int i32x4 __attribute__((ext_vector_type(4)));
typedef int i32x8 __attribute__((ext_vector_type(8)));

constexpr int NB = 8, SEQ = 4096, D = 1024, T = NB * SEQ;
constexpr int DIN = 3080, NPROJ = 3072;
constexpr int NE = 32, TOPK = 4, DFF = 1024;
constexpr int NH = 4, HD = 128, GMC = 128, DNC = 64;
constexpr int NCH = SEQ / DNC;
constexpr int NCHUNKS = NB * NH * NCH;
constexpr int RMAX = T * TOPK + NE * 256;
constexpr float EPS = 1e-6f;
constexpr int NWAVES = 8, NTHREADS = 512;

constexpr size_t MiB = 1u << 20;
constexpr size_t WS_CTL = 0, CTL_ZERO_BYTES = 32768;
constexpr size_t WS_AB = 1 * MiB;
constexpr size_t WS_EIDX = 2 * MiB;
constexpr size_t WS_GATEW = 2 * MiB + 512 * 1024;
constexpr size_t WS_ROWOF = 3 * MiB;
constexpr size_t WS_EPOS = 3 * MiB + 512 * 1024;
constexpr size_t WS_GSORT = 4 * MiB;
constexpr size_t WS_LIST = 5 * MiB;
constexpr size_t WS_RWT = 9 * MiB;
constexpr size_t WS_GLAST = 10 * MiB;
constexpr size_t WS_WIN = 16 * MiB;
constexpr size_t WS_WOUT = 22 * MiB;
constexpr size_t WS_WGU = 24 * MiB;
constexpr size_t WS_WDN = 152 * MiB;
constexpr size_t WS_HN8 = 88 * MiB;
constexpr size_t WS_H = 216 * MiB;
constexpr size_t WS_R3 = 344 * MiB;
constexpr size_t WS_R4 = 616 * MiB;
constexpr size_t WS_Y = WS_R4;
constexpr size_t WS_WC = WS_R4;
constexpr size_t WS_UC = WS_R4 + 32 * MiB;
constexpr size_t WS_QD = WS_R4 + 64 * MiB;
constexpr size_t WS_KET = WS_R4 + 96 * MiB;
constexpr size_t WS_AT = WS_R4 + 128 * MiB;
constexpr size_t WS_MIX = WS_R4 + 144 * MiB;
constexpr size_t WS_O = WS_R4 + 208 * MiB;
constexpr size_t WS_HN = 888 * MiB;
constexpr size_t WS_YS = WS_R3 + 136 * MiB;
constexpr size_t WS_END = 952 * MiB;
constexpr int CW_BAR = 0;
constexpr int CW_CNT = 4096;

constexpr int RING_BYTES = 147456;
constexpr int LDSCTL_OFF = RING_BYTES;
constexpr int LDS_BYTES = RING_BYTES + 1024;

#define LDS_WAIT() asm volatile("s_waitcnt lgkmcnt(0)" ::: "memory")
#define VM_WAIT() asm volatile("s_waitcnt vmcnt(0)" ::: "memory")
typedef __bf16 bf16x2_t __attribute__((ext_vector_type(2)));
__device__ __forceinline__ unsigned cvt_pk_bf16(float lo, float hi) { const bf16x2_t r = __builtin_convertvector((f32x2){lo, hi}, bf16x2_t); return __builtin_bit_cast(unsigned, r); }
__device__ __forceinline__ float bf2f(unsigned short b) { return __uint_as_float(((unsigned)b) << 16); }
__device__ __forceinline__ float bflo(unsigned w) { return __uint_as_float(w << 16); }
__device__ __forceinline__ float bfhi(unsigned w) { return __uint_as_float(w & 0xffff0000u); }
__device__ __forceinline__ bf16_t f2bf(float f) { return (bf16_t)(cvt_pk_bf16(f, 0.f) & 0xffffu); }
__device__ __forceinline__ unsigned cvt4_fp8(float a, float b, float c, float d) { int r = __builtin_amdgcn_cvt_pk_fp8_f32(a, b, 0, false); r = __builtin_amdgcn_cvt_pk_fp8_f32(c, d, r, true); return (unsigned)r; }
constexpr float W8_SCALE = 32.0f, W8_INV = 1.0f / 32.0f;
__device__ __forceinline__ float wave_sum(float v) {
#pragma unroll
    for (int o = 1; o < 64; o <<= 1) v += __shfl_xor(v, o);
    return v;
}
__device__ __forceinline__ float silu_f(float v) { return v / (1.0f + __expf(-v)); }
__device__ __forceinline__ float sigmoid_f(float v) { return 1.0f / (1.0f + __expf(-v)); }
__device__ __forceinline__ f32x2 gelu_pk(f32x2 v) {
    const f32x2 av = __builtin_elementwise_abs(v), d = av * 0.2316418882f + 1.0f;
    f32x2 t; t.x = __builtin_amdgcn_rcpf(d.x); t.y = __builtin_amdgcn_rcpf(d.y);
    f32x2 q = t * 0.5307027145f + (-0.7265760135f); q = q * t + 0.7107068705f; q = q * t + (-0.142248368f); q = q * t + 0.127414796f; q = q * t;
    const f32x2 s = (v * v) * (-0.72134752044f);
    f32x2 e; e.x = __builtin_amdgcn_exp2f(s.x); e.y = __builtin_amdgcn_exp2f(s.y);
    const f32x2 m = v * (q * e), r = v - m;
    f32x2 o; o.x = v.x < 0.f ? m.x : r.x; o.y = v.y < 0.f ? m.y : r.y; return o;
}

#define XB_TMO      128
#define XB_XCNT(j)  (256  + 64 * (j))
#define XB_XSUB(j)  (1280 + 64 * (j))
#define XB_XGEN(j)  (2304 + 64 * (j))
#define XB_TOP      3328
#define XB_TOPGEN   3392
#define XCD_BAR_WORDS 3456
#define XB_SPIN_CAP (1u << 18)
__device__ __forceinline__ unsigned xb_ld(unsigned* p)              { return __hip_atomic_load(p, __ATOMIC_RELAXED, __HIP_MEMORY_SCOPE_AGENT); }
__device__ __forceinline__ unsigned xb_add(unsigned* p, unsigned v) { return __hip_atomic_fetch_add(p, v, __ATOMIC_RELAXED, __HIP_MEMORY_SCOPE_AGENT); }
__device__ __forceinline__ unsigned xb_xcc_id() { return (unsigned)__builtin_amdgcn_s_getreg((3 << 11) | 20) & 0xFu; }
#define XB_SPIN(cond, bar) do { unsigned _sp = 0; while (cond) { __builtin_amdgcn_s_sleep(1); \
    if ((++_sp & 255u) == 0u) { if (xb_ld(&(bar)[XB_TMO])) break; if (_sp > XB_SPIN_CAP) { atomicAdd(&(bar)[XB_TMO], 1u); break; } } } } while (0)
struct XcdBarrier { unsigned* bar; unsigned x; volatile LAS unsigned* st; };
__device__ __forceinline__ XcdBarrier xcd_barrier_post(unsigned* bar, volatile LAS unsigned* st) {
    XcdBarrier b; b.bar = bar; b.x = xb_xcc_id(); b.st = st;
    if (threadIdx.x == 0) (void)xb_add(&bar[XB_XCNT(b.x)], 1u);
    return b;
}
__device__ __forceinline__ void xcd_barrier_complete(unsigned* bar, unsigned x, unsigned& nloc, unsigned& nx) {
    const unsigned G = gridDim.x * gridDim.y * gridDim.z;
    unsigned sum, cnt, mine, sp = 0u;
    for (;;) {
        sum = 0u; cnt = 0u; mine = 0u;
#pragma unroll
        for (unsigned j = 0; j < 16; ++j) { const unsigned c = xb_ld(&bar[XB_XCNT(j)]); sum += c; cnt += (c > 0u) ? 1u : 0u; mine = (j == x) ? c : mine; }
        if (sum == G) break;
        __builtin_amdgcn_s_sleep(1);
        if ((++sp & 255u) == 0u) { if (xb_ld(&bar[XB_TMO])) break; if (sp > XB_SPIN_CAP) { atomicAdd(&bar[XB_TMO], 1u); break; } }
    }
    nloc = mine > 0u ? mine : 1u; nx = cnt > 0u ? cnt : 1u;
}
__device__ __forceinline__ void xcd_barrier(const XcdBarrier& b) {
    asm volatile("s_waitcnt vmcnt(0)" ::: "memory");
    __syncthreads();
    if (threadIdx.x == 0) {
        unsigned* bar = b.bar;
        __builtin_amdgcn_s_waitcnt(0);
        unsigned nloc = b.st[0], nx = b.st[1];
        if (nloc == 0u) { xcd_barrier_complete(bar, b.x, nloc, nx); b.st[0] = nloc; b.st[1] = nx; }
        const unsigned old = xb_add(&bar[XB_XSUB(b.x)], 1u);
        const unsigned gen = old / nloc;
        if (old + 1u == (gen + 1u) * nloc) {
            __builtin_amdgcn_fence(__ATOMIC_RELEASE, "agent");
            asm volatile("s_waitcnt vmcnt(0)" ::: "memory");
            const unsigned og = xb_add(&bar[XB_TOP], 1u);
            const unsigned tg = og / nx;
            if (og + 1u == (tg + 1u) * nx) xb_add(&bar[XB_TOPGEN], 1u);
            else XB_SPIN(xb_ld(&bar[XB_TOPGEN]) == tg, bar);
            __builtin_amdgcn_fence(__ATOMIC_ACQUIRE, "agent");
            xb_add(&bar[XB_XGEN(b.x)], 1u);
            asm volatile("s_waitcnt vmcnt(0)" ::: "memory");
        } else {
            XB_SPIN(xb_ld(&bar[XB_XGEN(b.x)]) == gen, bar);
            __builtin_amdgcn_fence(__ATOMIC_ACQUIRE, "agent");
            asm volatile("s_waitcnt vmcnt(0)" ::: "memory");
        }
    }
    __syncthreads();
}

namespace pg8 {
constexpr int BM = 256, BK = 64, HALF = 128, HTB = HALF * BK * 2, STAGE_BYTES = 8 * HTB, NXCD = 8, WGM = 8;
__host__ __device__ __forceinline__ int lds_byte(int r, int c) { const int st = (r >> 4) * 2 + (c >> 5), rr = r & 15, cc = c & 31, ob = rr * 64 + cc * 2; return st * 1024 + (ob ^ (((ob >> 9) & 1) << 5)); }
__host__ __device__ __forceinline__ void stage_rc(int b, int& R, int& C) { const int st = b / 1024, sb = b % 1024, swz = sb ^ (((sb >> 9) & 1) << 5); R = (st >> 1) * 16 + swz / 64; C = (st & 1) * 32 + (swz % 64) / 2; }
__host__ __device__ __forceinline__ int perm32(int rho) { const int n = rho >> 4, i = rho & 15; return 8 * (i >> 2) + 4 * n + (i & 3); }

struct Unit { int pm, pn, pb; };
struct Gemm { const bf16_t* A; const bf16_t* Bt; int M, N, K; };

struct StaticOrder {
    int nM, nN, nwg, G, c;
    __device__ void init(int M, int N, int G_, int c_) { nM = M / BM; nN = N / BM; nwg = nM * nN; G = G_; c = c_; }
    __device__ bool next(int i, Unit& u) const {
        const long L = (long)i * G + c; if (L >= nwg) return false;
        int wgid = (int)L; { const int q = nwg / NXCD, r = nwg % NXCD, xcd = wgid % NXCD, off = wgid / NXCD; wgid = (xcd < r ? xcd * (q + 1) : r * (q + 1) + (xcd - r) * q) + off; }
        const int nig = WGM * nN, gid = wgid / nig, fm = gid * WGM, gsz = (nM - fm) < WGM ? (nM - fm) : WGM;
        u.pm = fm + ((wgid % nig) % gsz); u.pn = (wgid % nig) / gsz; u.pb = u.pn; return true;
    }
};
struct MoeOrder : StaticOrder {
    const LAS int* tile_e;
    __device__ bool next(int i, Unit& u) const { if (!StaticOrder::next(i, u)) return false; u.pb = __builtin_amdgcn_readfirstlane(tile_e[u.pm]) * nN + u.pn; return true; }
};

template <class Epi, class Sched, bool FP8 = false>
__device__ __forceinline__ void gemm_phase(LAS unsigned char* lds, const Gemm g, const Sched& S, const Epi& E) {
    const int tid = threadIdx.x, wid = __builtin_amdgcn_readfirstlane(tid >> 6), lane = tid & 63, wr = wid >> 2, wc = wid & 3, fr = lane & 15, fq = lane >> 4;
    const int K = g.K, nt = K / BK;
    unsigned voffA[2], voffB[2];
#pragma unroll
    for (int i = 0; i < 2; ++i) { int R, C; stage_rc(tid * 16 + i * 8192, R, C); const int Rb = Epi::PERM ? ((R & ~31) + perm32(R & 31)) : R;
        voffA[i] = (unsigned)(R * K + C) * 2u; voffB[i] = (unsigned)(Rb * K + C) * 2u; }
    const size_t kstep = (size_t)(BK * 2);
    const size_t hstep = (size_t)HALF * K * 2;
    const size_t tstep = 2 * hstep;
    const unsigned ldsw = (unsigned)wid * 1024u;
    const int aoff = lds_byte(wr * 64 + fr, fq * 8), boff = lds_byte(wc * 32 + fr, fq * 8);
    LAS unsigned char* ldsA = lds + aoff; LAS unsigned char* ldsB = lds + 4 * HTB + boff;
    asm volatile("" : "+v"(ldsA)); asm volatile("" : "+v"(ldsB));
#define PG8_SA(b, h) (((b) * 2 + (h)) * HTB)
#define PG8_SB(b, h) ((4 + (b) * 2 + (h)) * HTB)
#define PG8_STAGE(bufoff, gbase, voff) do { _Pragma("unroll") for (int _i = 0; _i < 2; ++_i) \
        __builtin_amdgcn_global_load_lds((const unsigned*)((const char*)(gbase) + (voff)[_i]), (LAS unsigned*)(lds + (bufoff) + ldsw + _i * 8192), 16, 0, 0); } while (0)
#define PG8_LD2(dst, addr) do { if constexpr (FP8) { const i32x4 lo_ = *(const LAS i32x4*)(addr), hi_ = *(const LAS i32x4*)((addr) + 1024); (dst).w = __builtin_shufflevector(lo_, hi_, 0, 1, 2, 3, 4, 5, 6, 7); } \
        else { (dst).h[0] = *(const LAS bf16x8*)(addr); (dst).h[1] = *(const LAS bf16x8*)((addr) + 1024); } } while (0)
#define PG8_LDA(dst, b, h) do { _Pragma("unroll") for (int m = 0; m < 4; ++m) PG8_LD2(dst[m], ldsA + PG8_SA(b, h) + m * 2048); } while (0)
#define PG8_LDB(dst, b, h) do { _Pragma("unroll") for (int n = 0; n < 2; ++n) PG8_LD2(dst[n], ldsB + PG8_SA(b, h) + n * 2048); } while (0)
#define PG8_MMA(ai, bj, At, Bt) do { __builtin_amdgcn_s_setprio(1); \
        if constexpr (FP8) { _Pragma("unroll") for (int m = 0; m < 4; ++m) _Pragma("unroll") for (int n = 0; n < 2; ++n) \
            asm volatile("v_mfma_f32_16x16x128_f8f6f4 %0, %1, %2, %0" : "+v"(acc[ai][bj][m][n]) : "v"(Bt[n].w), "v"(At[m].w)); } \
        else { _Pragma("unroll") for (int m = 0; m < 4; ++m) _Pragma("unroll") for (int n = 0; n < 2; ++n) _Pragma("unroll") for (int k = 0; k < 2; ++k) \
            acc[ai][bj][m][n] = __builtin_amdgcn_mfma_f32_16x16x32_bf16(Bt[n].h[k], At[m].h[k], acc[ai][bj][m][n], 0, 0, 0); } \
        __builtin_amdgcn_s_setprio(0); } while (0)
#define PG8_WAIT_V(n) asm volatile("s_waitcnt vmcnt(" #n ")" ::: "memory")
#define PG8_WAIT_L(n) asm volatile("s_waitcnt lgkmcnt(" #n ")" ::: "memory")
#define PG8_BAR __builtin_amdgcn_s_barrier()
#define PG8_SCHED __builtin_amdgcn_sched_barrier(0)
    Unit cur, nxt; int ui = 0;
    if (!S.next(0, cur)) return;
    f32x4 acc[2][2][4][2];
#pragma unroll
    for (int a = 0; a < 2; ++a)
#pragma unroll
        for (int b = 0; b < 2; ++b)
#pragma unroll
            for (int m = 0; m < 4; ++m)
#pragma unroll
                for (int n = 0; n < 2; ++n) acc[a][b][m][n] = (f32x4){0.f, 0.f, 0.f, 0.f};
    union Frag { bf16x8 h[2]; i32x8 w; };
    Frag At[4], B0[2], B1[2];
    const char* cA = (const char*)g.A + (size_t)cur.pm * tstep; const char* cB = (const char*)g.Bt + (size_t)cur.pb * tstep;
    PG8_STAGE(PG8_SB(0, 0), cB, voffB); PG8_STAGE(PG8_SB(0, 1), cB + hstep, voffB); PG8_STAGE(PG8_SA(0, 0), cA, voffA); PG8_STAGE(PG8_SA(0, 1), cA + hstep, voffA);
    if (wr == 1) PG8_BAR;
    PG8_WAIT_V(2); PG8_BAR;
    PG8_STAGE(PG8_SB(1, 0), cB + kstep, voffB); PG8_STAGE(PG8_SA(1, 0), cA + kstep, voffA); PG8_STAGE(PG8_SB(1, 1), cB + hstep + kstep, voffB);
    PG8_WAIT_V(6); PG8_BAR;
    for (;;) {
        const bool has_next = S.next(ui + 1, nxt);
        const char* nA = has_next ? (const char*)g.A + (size_t)nxt.pm * tstep : cA; const char* nB = has_next ? (const char*)g.Bt + (size_t)nxt.pb * tstep : cB;
        for (int t = 0; t < nt; t += 2) {
            const bool last = (t == nt - 2);
            const char* a1 = cA + (size_t)(t + 1) * kstep;
            const char* a2 = last ? nA : cA + (size_t)(t + 2) * kstep; const char* b2 = last ? nB : cB + (size_t)(t + 2) * kstep;
            const char* a3 = a2 + kstep; const char* b3 = b2 + kstep;
            PG8_LDB(B0, 0, 0); PG8_LDB(B1, 0, 1); PG8_SCHED; PG8_LDA(At, 0, 0); PG8_STAGE(PG8_SA(1, 1), a1 + hstep, voffA);
            PG8_WAIT_V(8); PG8_WAIT_L(0); PG8_BAR; PG8_MMA(0, 0, At, B0); PG8_MMA(0, 1, At, B1); PG8_BAR; PG8_SCHED;
            PG8_LDA(At, 0, 1); PG8_STAGE(PG8_SB(0, 0), b2, voffB); PG8_STAGE(PG8_SB(0, 1), b2 + hstep, voffB); PG8_STAGE(PG8_SA(0, 0), a2, voffA);
            PG8_WAIT_V(8); PG8_WAIT_L(0); PG8_BAR; PG8_MMA(1, 0, At, B0); PG8_MMA(1, 1, At, B1); PG8_BAR; PG8_SCHED;
            PG8_LDB(B0, 1, 0); PG8_LDB(B1, 1, 1); PG8_SCHED; PG8_LDA(At, 1, 0); PG8_STAGE(PG8_SA(0, 1), a2 + hstep, voffA);
            PG8_WAIT_V(8); PG8_WAIT_L(0); PG8_BAR; PG8_MMA(0, 0, At, B0); PG8_MMA(0, 1, At, B1); PG8_BAR; PG8_SCHED;
            PG8_LDA(At, 1, 1); PG8_STAGE(PG8_SB(1, 0), b3, voffB); PG8_STAGE(PG8_SB(1, 1), b3 + hstep, voffB); PG8_STAGE(PG8_SA(1, 0), a3, voffA);
            PG8_WAIT_V(8); PG8_WAIT_L(0); PG8_BAR; PG8_MMA(1, 0, At, B0); PG8_MMA(1, 1, At, B1); PG8_BAR; PG8_SCHED;
        }
        if (wr == 0) PG8_BAR;
        if constexpr (FP8) asm volatile("s_nop 15\n\ts_nop 15" ::: "memory");
        { int fr_ = fr, fq_ = fq; asm volatile("" : "+v"(fr_), "+v"(fq_));
          E(acc, cur, wr, wc, fr_, fq_); }
        if (!has_next) break;
#pragma unroll
        for (int a = 0; a < 2; ++a)
#pragma unroll
            for (int b = 0; b < 2; ++b)
#pragma unroll
                for (int m = 0; m < 4; ++m)
#pragma unroll
                    for (int n = 0; n < 2; ++n) { acc[a][b][m][n] = (f32x4){0.f, 0.f, 0.f, 0.f}; if constexpr (FP8) asm volatile("" : "+v"(acc[a][b][m][n])); }
        cur = nxt; cA = nA; cB = nB; ++ui;
        if (wr == 1) PG8_BAR;
    }
    PG8_WAIT_V(0);
    PG8_BAR;
#undef PG8_SA
#undef PG8_SB
#undef PG8_STAGE
#undef PG8_LDA
#undef PG8_LDB
#undef PG8_MMA
#undef PG8_LD2
#undef PG8_WAIT_V
#undef PG8_WAIT_L
#undef PG8_BAR
#undef PG8_SCHED
}

struct EpiProj {
    static constexpr bool PERM = true;
    bf16_t* O;
    __device__ __forceinline__ void operator()(const f32x4 (&acc)[2][2][4][2], const Unit& u, int wr, int wc, int fr, int fq) const {
        const int row0 = u.pm * BM + wr * 64 + fr, col0 = u.pn * BM + wc * 32 + 8 * fq;
#pragma unroll
        for (int ai = 0; ai < 2; ++ai)
#pragma unroll
            for (int m = 0; m < 4; ++m) { bf16_t* rowp = O + (size_t)(row0 + ai * HALF + m * 16) * NPROJ + col0;
#pragma unroll
                for (int bj = 0; bj < 2; ++bj) { const f32x4 v0 = acc[ai][bj][m][0], v1 = acc[ai][bj][m][1];
                    u32x4 w; w.x = cvt_pk_bf16(v0[0], v0[1]); w.y = cvt_pk_bf16(v0[2], v0[3]); w.z = cvt_pk_bf16(v1[0], v1[1]); w.w = cvt_pk_bf16(v1[2], v1[3]);
                    *(u32x4*)(rowp + bj * HALF) = w; } }
    }
};
struct EpiResid {
    static constexpr bool PERM = true;
    const float* X; bf16_t* H;
    __device__ __forceinline__ void operator()(const f32x4 (&acc)[2][2][4][2], const Unit& u, int wr, int wc, int fr, int fq) const {
        const int row0 = u.pm * BM + wr * 64 + fr, col0 = u.pn * BM + wc * 32 + 8 * fq;
#pragma unroll
        for (int ai = 0; ai < 2; ++ai)
#pragma unroll
            for (int m = 0; m < 4; ++m) { const size_t off = (size_t)(row0 + ai * HALF + m * 16) * D + col0;
#pragma unroll
                for (int bj = 0; bj < 2; ++bj) { const f32x4 v0 = acc[ai][bj][m][0] + *(const f32x4*)(X + off + bj * HALF), v1 = acc[ai][bj][m][1] + *(const f32x4*)(X + off + bj * HALF + 4);
                    u32x4 w; w.x = cvt_pk_bf16(v0[0], v0[1]); w.y = cvt_pk_bf16(v0[2], v0[3]); w.z = cvt_pk_bf16(v1[0], v1[1]); w.w = cvt_pk_bf16(v1[2], v1[3]);
                    *(u32x4*)(H + off + bj * HALF) = w; } }
    }
};
struct EpiSwiglu {
    static constexpr bool PERM = true;
    unsigned char* O; const float* bgu;
    __device__ __forceinline__ void operator()(const f32x4 (&acc)[2][2][4][2], const Unit& u, int wr, int wc, int fr, int fq) const {
        const int row0 = u.pm * BM + wr * 64 + fr, j0 = u.pn * HALF + wc * 32 + 8 * fq, e = u.pb >> 3;
        const float* bg = bgu + (size_t)e * 2048 + j0;
        f32x4 bgv[2], buv[2];
#pragma unroll
        for (int n = 0; n < 2; ++n) { bgv[n] = *(const f32x4*)(bg + 4 * n); buv[n] = *(const f32x4*)(bg + 1024 + 4 * n); }
#pragma unroll
        for (int ai = 0; ai < 2; ++ai)
#pragma unroll
            for (int m = 0; m < 4; ++m) { unsigned char* rowp = O + (size_t)(row0 + ai * HALF + m * 16) * DFF + j0;
                u32x2 w;
#pragma unroll
                for (int n = 0; n < 2; ++n) { const f32x4 g4 = acc[ai][0][m][n] * W8_INV + bgv[n], u4 = acc[ai][1][m][n] * W8_INV + buv[n]; f32x4 r;
#pragma unroll
                    for (int j = 0; j < 4; ++j) { const float ga = fminf(g4[j], 7.0f), ua = fminf(fmaxf(u4[j], -7.0f), 7.0f);
                        r[j] = (ua + 1.0f) * ga * __builtin_amdgcn_rcpf(1.0f + __builtin_amdgcn_exp2f(-2.4554669f * ga)); }
                    w[n] = cvt4_fp8(r[0], r[1], r[2], r[3]); }
                *(u32x2*)rowp = w; }
    }
};
struct EpiDown {
    static constexpr bool PERM = true;
    unsigned char* O; const float* bdn; const float* gsort;
    __device__ __forceinline__ void operator()(const f32x4 (&acc)[2][2][4][2], const Unit& u, int wr, int wc, int fr, int fq) const {
        const int row0 = u.pm * BM + wr * 64 + fr, col0 = u.pn * BM + wc * 32 + 8 * fq, e = u.pb >> 2;
        const float* bp = bdn + (size_t)e * D + col0;
        f32x4 bv[2][2]; float gw[2][4];
#pragma unroll
        for (int bj = 0; bj < 2; ++bj) { bv[bj][0] = *(const f32x4*)(bp + bj * HALF); bv[bj][1] = *(const f32x4*)(bp + bj * HALF + 4); }
#pragma unroll
        for (int ai = 0; ai < 2; ++ai)
#pragma unroll
            for (int m = 0; m < 4; ++m) gw[ai][m] = gsort[row0 + ai * HALF + m * 16];
#pragma unroll
        for (int ai = 0; ai < 2; ++ai)
#pragma unroll
            for (int m = 0; m < 4; ++m) { const int r = row0 + ai * HALF + m * 16; const float g = gw[ai][m] * W8_INV; unsigned char* rowp = O + (size_t)r * D + col0;
#pragma unroll
                for (int bj = 0; bj < 2; ++bj) { const f32x4 v0 = acc[ai][bj][m][0] * g + bv[bj][0] * gw[ai][m], v1 = acc[ai][bj][m][1] * g + bv[bj][1] * gw[ai][m];
                    u32x2 w; w.x = cvt4_fp8(v0[0], v0[1], v0[2], v0[3]); w.y = cvt4_fp8(v1[0], v1[1], v1[2], v1[3]);
                    *(u32x2*)(rowp + bj * HALF) = w; } }
    }
};
}

struct Args {
    const float* in[19]; float* out; unsigned char* ws; int ph_lo, ph_hi;
};
struct Frame {
    LAS unsigned char* lds;
    int tid, lane, wave, G, vcu;
    unsigned char* ws;
};
#define MFMA16(a, b, c) __builtin_amdgcn_mfma_f32_16x16x32_bf16((a), (b), (c), 0, 0, 0)

__device__ __forceinline__ void tr_item(const float* src, size_t ldw, bf16_t* dst, LAS float* scr, int lane) {
    f32x4 v[16];
    const int kq = lane >> 4, n4 = 4 * (lane & 15);
#pragma unroll
    for (int i = 0; i < 16; ++i) v[i] = *(const f32x4*)(src + (size_t)(4 * i + kq) * ldw + n4);
#pragma unroll
    for (int i = 0; i < 16; ++i) { LAS float* s = scr + (4 * i + kq) * 65 + n4; s[0] = v[i][0]; s[1] = v[i][1]; s[2] = v[i][2]; s[3] = v[i][3]; }
    LDS_WAIT();
    const int c = lane & 7;
#pragma unroll
    for (int r = 0; r < 8; ++r) { const int n = 8 * r + (lane >> 3); const LAS float* s = scr + (8 * c) * 65 + n;
        u32x4 o; o.x = cvt_pk_bf16(s[0 * 65], s[1 * 65]); o.y = cvt_pk_bf16(s[2 * 65], s[3 * 65]); o.z = cvt_pk_bf16(s[4 * 65], s[5 * 65]); o.w = cvt_pk_bf16(s[6 * 65], s[7 * 65]);
        *(u32x4*)(dst + (size_t)n * 1024 + 8 * c) = o; }
    LDS_WAIT();
}
__device__ __forceinline__ void tr_item8(const float* src, size_t ldw, unsigned char* dst, LAS float* scr, int lane) {
    f32x4 v[16];
    const int kq = lane >> 3, n4 = 4 * (lane & 7);
#pragma unroll
    for (int i = 0; i < 16; ++i) v[i] = *(const f32x4*)(src + (size_t)(8 * i + kq) * ldw + n4);
#pragma unroll
    for (int i = 0; i < 16; ++i) { LAS float* s = scr + (8 * i + kq) * 33 + n4; s[0] = v[i][0]; s[1] = v[i][1]; s[2] = v[i][2]; s[3] = v[i][3]; }
    LDS_WAIT();
    const int c = lane >> 3, nn = lane & 7;
#pragma unroll
    for (int r = 0; r < 4; ++r) { const int n = 8 * r + nn; const LAS float* s = scr + (16 * c) * 33 + n;
        u32x4 o;
#pragma unroll
        for (int q = 0; q < 4; ++q) o[q] = cvt4_fp8(s[(4 * q) * 33] * W8_SCALE, s[(4 * q + 1) * 33] * W8_SCALE, s[(4 * q + 2) * 33] * W8_SCALE, s[(4 * q + 3) * 33] * W8_SCALE);
        *(u32x4*)(dst + (size_t)n * 1024 + 16 * c) = o; }
    LDS_WAIT();
}
__device__ __forceinline__ void p0_prologue(const Frame& F, const Args& a) {
    LAS float* scr = (LAS float*)(F.lds + F.wave * 16896);
    const int gw = F.vcu * NWAVES + F.wave, NGW = F.G * NWAVES;
    const float* w_in = a.in[2]; const float* w_out = a.in[10]; const float* w_gu = a.in[14]; const float* w_dn = a.in[16]; const float* rw = a.in[12];
    bf16_t* WIN = (bf16_t*)(F.ws + WS_WIN); bf16_t* WOUT = (bf16_t*)(F.ws + WS_WOUT); unsigned char* WGU = F.ws + WS_WGU; unsigned char* WDN = F.ws + WS_WDN; bf16_t* RWT = (bf16_t*)(F.ws + WS_RWT);
    constexpr int I_IN = 16 * 48, I_OUT = 16 * 16, I_GU = NE * 8 * 64, I_DN = NE * 8 * 32, NITEMS = I_IN + I_OUT + I_GU + I_DN;
    for (int it = gw; it < NITEMS; it += NGW) {
        int r = it;
        if (r < I_IN) { const int kb = r / 48, nb = r % 48; tr_item(w_in + (size_t)(64 * kb) * DIN + 64 * nb, DIN, WIN + (size_t)(64 * nb) * 1024 + 64 * kb, scr, F.lane); continue; } r -= I_IN;
        if (r < I_OUT) { const int kb = r / 16, nb = r % 16; tr_item(w_out + (size_t)(64 * kb) * D + 64 * nb, D, WOUT + (size_t)(64 * nb) * 1024 + 64 * kb, scr, F.lane); continue; } r -= I_OUT;
        if (r < I_GU) { const int e = r / 512, q = r % 512, kb = q / 64, nb = q % 64; const int c0 = 32 * nb, j = c0 & 1023, drow = (j >> 7) * 256 + (c0 >= 1024 ? 128 : 0) + (j & 127);
            tr_item8(w_gu + (size_t)e * 1024 * 2048 + (size_t)(128 * kb) * 2048 + c0, 2048, WGU + (size_t)e * 2048 * 1024 + (size_t)drow * 1024 + 128 * kb, scr, F.lane); continue; } r -= I_GU;
        { const int e = r / 256, q = r % 256, kb = q / 32, nb = q % 32;
            tr_item8(w_dn + (size_t)e * 1024 * 1024 + (size_t)(128 * kb) * 1024 + 32 * nb, 1024, WDN + (size_t)e * 1024 * 1024 + (size_t)(32 * nb) * 1024 + 128 * kb, scr, F.lane); }
    }
    for (int i = gw * 64 + F.lane; i < 32 * 1024; i += NGW * 64) { const int e = i >> 10, k = i & 1023; RWT[i] = f2bf(rw[(size_t)k * 32 + e]); }
    const float* x = a.in[0]; const float* g1 = a.in[1];
    bf16_t* Y = (bf16_t*)(F.ws + WS_Y); float* AB = (float*)(F.ws + WS_AB);
    f32x4 gv[4]; f32x4 wab[4][4][2];
#pragma unroll
    for (int j = 0; j < 4; ++j) { gv[j] = *(const f32x4*)(g1 + 4 * F.lane + 256 * j);
#pragma unroll
        for (int i = 0; i < 4; ++i) { const float* p = w_in + (size_t)(4 * F.lane + 256 * j + i) * DIN + NPROJ; wab[j][i][0] = *(const f32x4*)p; wab[j][i][1] = *(const f32x4*)(p + 4); } }
    for (int m = gw; m < T; m += NGW) {
        const f32x4* xr = (const f32x4*)(x + (size_t)m * D) + F.lane;
        f32x4 v[4]; float ss = 0.f;
#pragma unroll
        for (int j = 0; j < 4; ++j) { v[j] = xr[64 * j]; ss += (v[j][0] * v[j][0] + v[j][1] * v[j][1]) + (v[j][2] * v[j][2] + v[j][3] * v[j][3]); }
        const float rstd = rsqrtf(wave_sum(ss) * (1.0f / D) + EPS);
        f32x4 p0 = (f32x4){0.f, 0.f, 0.f, 0.f}, p1 = p0;
        u32x2* yo = (u32x2*)(Y + (size_t)m * D) + F.lane;
#pragma unroll
        for (int j = 0; j < 4; ++j) { const f32x4 y = v[j] * rstd * gv[j];
#pragma unroll
            for (int i = 0; i < 4; ++i) { p0 += wab[j][i][0] * y[i]; p1 += wab[j][i][1] * y[i]; }
            u32x2 w; w.x = cvt_pk_bf16(y[0], y[1]); w.y = cvt_pk_bf16(y[2], y[3]); yo[64 * j] = w; }
#pragma unroll
        for (int i = 0; i < 4; ++i) { p0[i] = wave_sum(p0[i]); p1[i] = wave_sum(p1[i]); }
        if (F.lane == 0) { *(f32x4*)(AB + (size_t)m * 8) = p0; *(f32x4*)(AB + (size_t)m * 8 + 4) = p1; }
    }
}

constexpr int GM_LDT = 136;
__device__ __forceinline__ void gmlp_unit(const Frame& F, const Args& a, int unit) {
    const int h = unit & 3, bn = unit >> 2;
    const bf16_t* PROJ = (const bf16_t*)(F.ws + WS_R3); bf16_t* MIX = (bf16_t*)(F.ws + WS_MIX);
    const float* gmg = a.in[3] + h * HD; const float* Wh = a.in[4] + (size_t)h * GMC * GMC; const float* bs = a.in[5] + h * GMC;
    LAS bf16_t* vnT = (LAS bf16_t*)F.lds;
    const size_t row0 = (size_t)bn * GMC;
    {
        const int sp = F.tid >> 3, seg = F.tid & 7;
        const bf16_t* p0 = PROJ + (row0 + 2 * sp) * NPROJ + 512 + h * HD + 16 * seg; const bf16_t* p1 = p0 + NPROJ;
        const u32x4 a0 = *(const u32x4*)p0, a1 = *(const u32x4*)(p0 + 8), b0 = *(const u32x4*)p1, b1 = *(const u32x4*)(p1 + 8);
        float x0[16], x1[16];
#pragma unroll
        for (int i = 0; i < 4; ++i) { x0[2 * i] = bflo(a0[i]); x0[2 * i + 1] = bfhi(a0[i]); x0[8 + 2 * i] = bflo(a1[i]); x0[9 + 2 * i] = bfhi(a1[i]);
                                      x1[2 * i] = bflo(b0[i]); x1[2 * i + 1] = bfhi(b0[i]); x1[8 + 2 * i] = bflo(b1[i]); x1[9 + 2 * i] = bfhi(b1[i]); }
#pragma unroll
        for (int i = 0; i < 16; ++i) { const f32x2 gg2 = gelu_pk((f32x2){x0[i], x1[i]}); x0[i] = gg2.x; x1[i] = gg2.y; }
        float s0 = 0.f, s1 = 0.f;
#pragma unroll
        for (int i = 0; i < 16; ++i) { s0 += x0[i] * x0[i]; s1 += x1[i] * x1[i]; }
#pragma unroll
        for (int o = 1; o < 8; o <<= 1) { s0 += __shfl_xor(s0, o); s1 += __shfl_xor(s1, o); }
        const float r0 = rsqrtf(s0 * (1.0f / HD) + EPS), r1 = rsqrtf(s1 * (1.0f / HD) + EPS);
#pragma unroll
        for (int i = 0; i < 16; ++i) { const float gg = gmg[16 * seg + i];
            *(LAS unsigned*)(vnT + (16 * seg + i) * GM_LDT + (((((sp >> 2) ^ seg) & 7) | ((sp >> 2) & 8)) << 3) + ((2 * sp) & 7)) = cvt_pk_bf16(x0[i] * r0 * gg, x1[i] * r1 * gg); }
    }
    const int fr = F.lane & 15, fq = F.lane >> 4, trow = 16 * F.wave + fr;
    bf16x8 af[4];
#pragma unroll
    for (int kk = 0; kk < 4; ++kk) { const int s0 = 32 * kk + 8 * fq; const float* wp = Wh + (size_t)trow * GMC + s0;
        const f32x4 w0 = *(const f32x4*)wp, w1 = *(const f32x4*)(wp + 4); float wv[8] = {w0[0], w0[1], w0[2], w0[3], w1[0], w1[1], w1[2], w1[3]};
#pragma unroll
        for (int j = 0; j < 8; ++j) if (s0 + j > trow) wv[j] = 0.f;
        u32x4 pk; pk.x = cvt_pk_bf16(wv[0], wv[1]); pk.y = cvt_pk_bf16(wv[2], wv[3]); pk.z = cvt_pk_bf16(wv[4], wv[5]); pk.w = cvt_pk_bf16(wv[6], wv[7]);
        af[kk] = __builtin_bit_cast(bf16x8, pk); }
    LDS_WAIT(); __syncthreads();
    f32x4 acc[8];
#pragma unroll
    for (int nt = 0; nt < 8; ++nt) { acc[nt] = (f32x4){0.f, 0.f, 0.f, 0.f};
#pragma unroll
        for (int kk = 0; kk < 4; ++kk) { const int ch = 4 * kk + fq; const bf16x8 bfr = *(const LAS bf16x8*)(vnT + (16 * nt + fr) * GM_LDT + ((((ch ^ nt) & 7) | (ch & 8)) << 3)); acc[nt] = MFMA16(af[kk], bfr, acc[nt]); } }
#pragma unroll
    for (int r = 0; r < 4; ++r) { const int t = 16 * F.wave + 4 * fq + r; const float bias = bs[t];
        const bf16_t* up = PROJ + (row0 + t) * NPROJ + h * HD + fr; bf16_t* op = MIX + (row0 + t) * D + h * HD + fr;
#pragma unroll
        for (int nt = 0; nt < 8; nt += 2) { const f32x2 ug = gelu_pk((f32x2){bf2f(up[16 * nt]), bf2f(up[16 * nt + 16])});
            op[16 * nt] = f2bf(ug.x * (acc[nt][r] + bias)); op[16 * nt + 16] = f2bf(ug.y * (acc[nt + 1][r] + bias)); } }
    __syncthreads();
}

constexpr int DN_QS = 0;
constexpr int DN_KS = 17408;
constexpr int DN_KT = 34816;
constexpr int DN_XT = 53248;
constexpr int DN_LN = 90112;
constexpr int DN_LD = 99328;
constexpr int DN_TI = 103680;
constexpr int DN_YT = 106752;
constexpr int DN_GC = 119040;
constexpr int DN_CW = 120064;
static_assert(DN_CW + 6144 <= RING_BYTES, "DeltaNet chunk LDS map");
__device__ __forceinline__ int tsw(int r, int pos) { return r * 72 + ((((pos >> 3) ^ (r >> 3)) & 7) << 3) + (pos & 7); }
struct DnPre { u32x4 xv[3][2][4]; float av, bv; };
__device__ __forceinline__ void dn_prefetch(const Frame& F, DnPre& P, int unit) {
    const int n = unit & 63, bh = unit >> 6, h = bh & 3, b = bh >> 2, fr = F.lane & 15, fq = F.lane >> 4;
    const bf16_t* PROJ = (const bf16_t*)(F.ws + WS_R3); const float* AB = (const float*)(F.ws + WS_AB);
    const size_t trow0 = (size_t)b * SEQ + (size_t)n * DNC;
    P.av = AB[(trow0 + F.lane) * 8 + h]; P.bv = AB[(trow0 + F.lane) * 8 + 4 + h];
#pragma unroll
    for (int ten = 0; ten < 3; ++ten) { const int ch = ten * 512 + h * HD + 8 * fr;
#pragma unroll
        for (int hp = 0; hp < 2; ++hp) { const int pos = hp * 32 + 4 * F.wave + fq;
#pragma unroll
            for (int j = 0; j < 4; ++j) { const int sp = n * DNC + pos - 3 + j;
                P.xv[ten][hp][j] = (sp >= 0) ? *(const u32x4*)(PROJ + ((size_t)b * SEQ + sp) * NPROJ + 1024 + ch) : (u32x4){0u, 0u, 0u, 0u}; } } }
}
__device__ __forceinline__ void dn_chunk(const Frame& F, const Args& a, int unit, DnPre& P, int next_unit) {
    const int n = unit & 63, bh = unit >> 6, h = bh & 3, b = bh >> 2;
    const LAS float* cwL = (const LAS float*)(F.lds + DN_CW);
    LAS unsigned char* L = F.lds;
    LAS bf16_t* qs = (LAS bf16_t*)(L + DN_QS); LAS bf16_t* ks = (LAS bf16_t*)(L + DN_KS); LAS bf16_t* kT = (LAS bf16_t*)(L + DN_KT); LAS bf16_t* XT = (LAS bf16_t*)(L + DN_XT);
    LAS bf16_t* Ln = (LAS bf16_t*)(L + DN_LN); LAS float* Ld = (LAS float*)(L + DN_LD); LAS bf16_t* Ti = (LAS bf16_t*)(L + DN_TI); LAS bf16_t* YT = (LAS bf16_t*)(L + DN_YT + F.wave * 1536);
    LAS float* gcs = (LAS float*)(L + DN_GC); LAS float* bts = gcs + 64; LAS float* egs = gcs + 128;
    const size_t trow0 = (size_t)b * SEQ + (size_t)n * DNC;
    int fr = F.lane & 15, fq = F.lane >> 4;
    asm volatile("" : "+v"(fr), "+v"(fq));
    float my_gc, my_beta, my_eg;
    {
        const float av = P.av, bv = P.bv;
        const float xg = av + a.in[8][h];
        const float sp = xg > 20.f ? xg : log1pf(__expf(xg));
        float g = -__expf(a.in[7][h]) * sp;
#pragma unroll
        for (int o = 1; o < 64; o <<= 1) { const float t = __shfl_up(g, o); if (F.lane >= o) g += t; }
        my_gc = g; my_beta = sigmoid_f(bv); my_eg = __expf(g);
        if (F.wave == 0) { gcs[F.lane] = my_gc; bts[F.lane] = my_beta; egs[F.lane] = my_eg; }
    }
    bf16_t* QDg = (bf16_t*)(F.ws + WS_QD) + (size_t)unit * 64 * 128;
#pragma unroll
    for (int ten = 0; ten < 3; ++ten) {
        f32x4 w0[4], w1[4];
#pragma unroll
        for (int j = 0; j < 4; ++j) { w0[j] = *(const LAS f32x4*)(cwL + (ten * 4 + j) * 128 + 8 * fr); w1[j] = *(const LAS f32x4*)(cwL + (ten * 4 + j) * 128 + 8 * fr + 4); }
#pragma unroll
        for (int hp = 0; hp < 2; ++hp) { const int pos = hp * 32 + 4 * F.wave + fq;
            float accv[8];
#pragma unroll
            for (int i = 0; i < 8; ++i) accv[i] = 0.f;
#pragma unroll
            for (int j = 0; j < 4; ++j) { const u32x4 x = P.xv[ten][hp][j];
                accv[0] += bflo(x[0]) * w0[j][0]; accv[1] += bfhi(x[0]) * w0[j][1]; accv[2] += bflo(x[1]) * w0[j][2]; accv[3] += bfhi(x[1]) * w0[j][3];
                accv[4] += bflo(x[2]) * w1[j][0]; accv[5] += bfhi(x[2]) * w1[j][1]; accv[6] += bflo(x[3]) * w1[j][2]; accv[7] += bfhi(x[3]) * w1[j][3]; }
            float ss = 0.f;
#pragma unroll
            for (int i = 0; i < 8; ++i) { accv[i] = silu_f(accv[i]); ss += accv[i] * accv[i]; }
#pragma unroll
            for (int o = 1; o < 16; o <<= 1) ss += __shfl_xor(ss, o);
            const float bp = __shfl(my_beta, pos), ep = __shfl(my_eg, pos);
            if (ten == 0) { const float sc = rsqrtf(ss + EPS) * 0.08838834764831845f;
#pragma unroll
                for (int i = 0; i < 8; ++i) accv[i] *= sc;
                u32x4 w; w.x = cvt_pk_bf16(accv[0], accv[1]); w.y = cvt_pk_bf16(accv[2], accv[3]); w.z = cvt_pk_bf16(accv[4], accv[5]); w.w = cvt_pk_bf16(accv[6], accv[7]);
                *(LAS u32x4*)(qs + pos * 136 + 8 * fr) = w;
                u32x4 wd; wd.x = cvt_pk_bf16(accv[0] * ep, accv[1] * ep); wd.y = cvt_pk_bf16(accv[2] * ep, accv[3] * ep); wd.z = cvt_pk_bf16(accv[4] * ep, accv[5] * ep); wd.w = cvt_pk_bf16(accv[6] * ep, accv[7] * ep);
                *(u32x4*)(QDg + pos * 128 + 8 * fr) = wd;
            } else if (ten == 1) { const float sc = rsqrtf(ss + EPS);
#pragma unroll
                for (int i = 0; i < 8; ++i) accv[i] *= sc;
                u32x4 w; w.x = cvt_pk_bf16(accv[0], accv[1]); w.y = cvt_pk_bf16(accv[2], accv[3]); w.z = cvt_pk_bf16(accv[4], accv[5]); w.w = cvt_pk_bf16(accv[6], accv[7]);
                *(LAS u32x4*)(ks + pos * 136 + 8 * fr) = w;
                const float rs = bp * ep;
#pragma unroll
                for (int i = 0; i < 8; ++i) { kT[tsw(8 * fr + i, pos)] = f2bf(accv[i]); XT[tsw(128 + 8 * fr + i, pos)] = f2bf(accv[i] * rs); }
            } else {
#pragma unroll
                for (int i = 0; i < 8; ++i) XT[tsw(8 * fr + i, pos)] = f2bf(accv[i] * bp);
            }
        }
    }
    if (next_unit >= 0) dn_prefetch(F, P, next_unit);
    LDS_WAIT(); __syncthreads();
    bf16_t* ATg = (bf16_t*)(F.ws + WS_AT) + (size_t)unit * 64 * 64;
    {
        const int mt = F.wave & 3; const LAS bf16_t* Asrc = (F.wave < 4) ? ks : qs;
        f32x4 acc[4];
#pragma unroll
        for (int nt = 0; nt < 4; ++nt) acc[nt] = (f32x4){0.f, 0.f, 0.f, 0.f};
#pragma unroll
        for (int kk = 0; kk < 4; ++kk) { const bf16x8 af = *(const LAS bf16x8*)(Asrc + (16 * mt + fr) * 136 + 32 * kk + 8 * fq);
#pragma unroll
            for (int nt = 0; nt < 4; ++nt) { const bf16x8 bfr = *(const LAS bf16x8*)(ks + (16 * nt + fr) * 136 + 32 * kk + 8 * fq); acc[nt] = MFMA16(af, bfr, acc[nt]); } }
#pragma unroll
        for (int r = 0; r < 4; ++r) { const int i = 16 * mt + 4 * fq + r; const float gi = gcs[i], bi = bts[i];
#pragma unroll
            for (int nt = 0; nt < 4; ++nt) { const int j = 16 * nt + fr; const float dec = __expf(fminf(gi - gcs[j], 0.f));
                if (F.wave < 4) { const float lv = (j < i) ? bi * acc[nt][r] * dec : 0.f; Ln[i * 72 + j] = f2bf(-lv); if (nt == mt) Ld[(mt * 16 + 4 * fq + r) * 17 + fr] = lv; }
                else ATg[i * 64 + j] = f2bf((j <= i) ? acc[nt][r] * dec : 0.f); } }
    }
    LDS_WAIT(); __syncthreads();
    if (F.wave == 0) {
        const int blk = fq, c = fr;
        float t[16];
#pragma unroll
        for (int i = 0; i < 16; ++i) { float s = (i == c) ? 1.f : 0.f;
#pragma unroll
            for (int j = 0; j < i; ++j) s -= Ld[(blk * 16 + i) * 17 + j] * t[j];
            t[i] = s; }
#pragma unroll
        for (int i = 0; i < 16; ++i) Ti[(16 * blk + i) * 24 + c] = f2bf(t[i]);
    } else {
        bf16_t* KETg = (bf16_t*)(F.ws + WS_KET) + (size_t)unit * 128 * 64;
        const float glast = gcs[63];
        for (int idx = F.tid - 64; idx < 128 * 8; idx += NTHREADS - 64) {
            const int d = idx >> 3, gp = idx & 7;
            const u32x4 v = *(const LAS u32x4*)(kT + tsw(d, 8 * gp)); u32x4 w;
#pragma unroll
            for (int i = 0; i < 4; ++i) w[i] = cvt_pk_bf16(bflo(v[i]) * __expf(glast - gcs[8 * gp + 2 * i]), bfhi(v[i]) * __expf(glast - gcs[8 * gp + 2 * i + 1]));
            *(u32x4*)(KETg + d * 64 + 8 * gp) = w;
        }
        if (F.tid == 64) ((float*)(F.ws + WS_GLAST))[unit] = __expf(glast);
    }
    LDS_WAIT(); __syncthreads();
    {
        bf16_t* Og = (bf16_t*)(F.ws + (F.wave < 4 ? WS_UC : WS_WC)) + (size_t)unit * 64 * 128;
        const int ncol0 = (F.wave & 3) * 32;
        const bf16x8 zf = (bf16x8){0, 0, 0, 0, 0, 0, 0, 0};
#pragma unroll
        for (int bb = 0; bb < 4; ++bb) {
            f32x4 acc[2];
#pragma unroll
            for (int t = 0; t < 2; ++t) { const u32x2 rv = *(const LAS u32x2*)(XT + tsw(32 * F.wave + 16 * t + fr, 16 * bb + 4 * fq));
                acc[t] = (f32x4){bflo(rv.x), bfhi(rv.x), bflo(rv.y), bfhi(rv.y)}; }
            if (bb >= 1) {
#pragma unroll
                for (int kk = 0; kk < 2; ++kk) if (32 * kk < 16 * bb) {
                    bf16x8 af = *(const LAS bf16x8*)(Ln + (16 * bb + fr) * 72 + 32 * kk + 8 * fq);
                    if (32 * kk + 8 * fq >= 16 * bb) af = zf;
#pragma unroll
                    for (int t = 0; t < 2; ++t) { const bf16x8 bfr = *(const LAS bf16x8*)(XT + tsw(32 * F.wave + 16 * t + fr, 32 * kk + 8 * fq)); acc[t] = MFMA16(af, bfr, acc[t]); }
                }
            }
#pragma unroll
            for (int t = 0; t < 2; ++t) { u32x2 w; w.x = cvt_pk_bf16(acc[t][0], acc[t][1]); w.y = cvt_pk_bf16(acc[t][2], acc[t][3]); *(LAS u32x2*)(YT + (16 * t + fr) * 24 + 4 * fq) = w; }
            LDS_WAIT();
            bf16x8 a2 = *(const LAS bf16x8*)(Ti + (16 * bb + fr) * 24 + 8 * (fq & 1));
            if (fq >= 2) a2 = zf;
#pragma unroll
            for (int t = 0; t < 2; ++t) { bf16x8 b2 = *(const LAS bf16x8*)(YT + (16 * t + fr) * 24 + 8 * (fq & 1)); if (fq >= 2) b2 = zf;
                f32x4 x = MFMA16(a2, b2, ((f32x4){0.f, 0.f, 0.f, 0.f}));
                u32x2 w; w.x = cvt_pk_bf16(x[0], x[1]); w.y = cvt_pk_bf16(x[2], x[3]);
                *(LAS u32x2*)(XT + tsw(32 * F.wave + 16 * t + fr, 16 * bb + 4 * fq)) = w;
                if (F.wave < 4) *(u32x2*)(Og + (ncol0 + 16 * t + fr) * 64 + 16 * bb + 4 * fq) = w;
                else {
#pragma unroll
                    for (int r = 0; r < 4; ++r) Og[(16 * bb + 4 * fq + r) * 128 + ncol0 + 16 * t + fr] = f2bf(x[r]); } }
            LDS_WAIT();
        }
    }
    LDS_WAIT(); __syncthreads();
}

constexpr int SC_WC = 0, SC_QD = 17408, SC_AT = 34816, SC_KE = 44032, SC_UC = 62464, SC_GL = 64512, SC_BUF = 64768;
constexpr int SC_ST = 2 * SC_BUF, SC_VT = SC_ST + 4352;
static_assert(SC_VT + 2304 <= RING_BYTES, "scan LDS map");
__device__ __forceinline__ void scan_stage(const Frame& F, LAS unsigned char* buf, size_t cu, int sl, int ltid, int nld) {
    const bf16_t* wc = (const bf16_t*)(F.ws + WS_WC) + cu * 8192; const bf16_t* qd = (const bf16_t*)(F.ws + WS_QD) + cu * 8192; const bf16_t* uc = (const bf16_t*)(F.ws + WS_UC) + cu * 8192 + (size_t)sl * 16 * 64;
    const bf16_t* ke = (const bf16_t*)(F.ws + WS_KET) + cu * 8192; const bf16_t* at = (const bf16_t*)(F.ws + WS_AT) + cu * 4096;
    u32x4 v[9];
#pragma unroll
    for (int i = 0; i < 9; ++i) { const int p = ltid + i * nld;
        const bf16_t* src = wc;
        if (p < 1024) src = wc + (p >> 4) * 128 + (p & 15) * 8;
        else if (p < 2048) src = qd + ((p - 1024) >> 4) * 128 + (p & 15) * 8;
        else if (p < 2560) src = at + (p - 2048) * 8;
        else if (p < 3584) src = ke + (p - 2560) * 8;
        else if (p < 3712) src = uc + (p - 3584) * 8;
        v[i] = (p < 3712) ? *(const u32x4*)src : (u32x4){0u, 0u, 0u, 0u}; }
    if (ltid == 0) *(LAS float*)(buf + SC_GL) = ((const float*)(F.ws + WS_GLAST))[cu];
#pragma unroll
    for (int i = 0; i < 9; ++i) { const int p = ltid + i * nld;
        LAS unsigned char* dst = buf;
        if (p < 1024) dst = buf + SC_WC + ((p >> 4) * 136 + (p & 15) * 8) * 2;
        else if (p < 2048) dst = buf + SC_QD + (((p - 1024) >> 4) * 136 + (p & 15) * 8) * 2;
        else if (p < 2560) dst = buf + SC_AT + (((p - 2048) >> 3) * 72 + (p & 7) * 8) * 2;
        else if (p < 3584) dst = buf + SC_KE + (((p - 2560) >> 3) * 72 + (p & 7) * 8) * 2;
        else dst = buf + SC_UC + (p - 3584) * 16;
        if (p < 3712) *(LAS u32x4*)dst = v[i]; }
}
__device__ __forceinline__ void dn_scan(const Frame& F, int item) {
    const int bh = item >> 3, sl = item & 7, h = bh & 3, b = bh >> 2;
    LAS bf16_t* ST = (LAS bf16_t*)(F.lds + SC_ST); LAS bf16_t* VT = (LAS bf16_t*)(F.lds + SC_VT);
    const int fr = F.lane & 15, fq = F.lane >> 4;
    float* Og = (float*)(F.ws + WS_O);
    f32x4 S[8];
#pragma unroll
    for (int mt = 0; mt < 8; ++mt) S[mt] = (f32x4){0.f, 0.f, 0.f, 0.f};
    if (F.wave == 0) {
#pragma unroll
        for (int mt = 0; mt < 8; ++mt) *(LAS u32x2*)(ST + fr * 136 + 16 * mt + 4 * fq) = (u32x2){0u, 0u};
    }
    scan_stage(F, F.lds, (size_t)bh * NCH, sl, F.tid, NTHREADS);
    LDS_WAIT(); __syncthreads();
#pragma unroll 1
    for (int n = 0; n < NCH; ++n) {
        LAS unsigned char* buf = F.lds + (n & 1) * SC_BUF;
        if (F.wave != 0) {
            if (n + 1 < NCH) scan_stage(F, F.lds + ((n + 1) & 1) * SC_BUF, (size_t)bh * NCH + n + 1, sl, F.tid - 64, NTHREADS - 64);
        } else {
            const LAS bf16_t* wc = (const LAS bf16_t*)(buf + SC_WC); const LAS bf16_t* qd = (const LAS bf16_t*)(buf + SC_QD); const LAS bf16_t* at = (const LAS bf16_t*)(buf + SC_AT);
            const LAS bf16_t* ke = (const LAS bf16_t*)(buf + SC_KE); const LAS bf16_t* uc = (const LAS bf16_t*)(buf + SC_UC);
            bf16x8 sb[4];
#pragma unroll
            for (int kk = 0; kk < 4; ++kk) sb[kk] = *(const LAS bf16x8*)(ST + fr * 136 + 32 * kk + 8 * fq);
            f32x4 vn[4], oo[4];
#pragma unroll
            for (int mt = 0; mt < 4; ++mt) { vn[mt] = (f32x4){0.f, 0.f, 0.f, 0.f}; oo[mt] = (f32x4){0.f, 0.f, 0.f, 0.f};
#pragma unroll
                for (int kk = 0; kk < 4; ++kk) { const bf16x8 aw = *(const LAS bf16x8*)(wc + (16 * mt + fr) * 136 + 32 * kk + 8 * fq), aq = *(const LAS bf16x8*)(qd + (16 * mt + fr) * 136 + 32 * kk + 8 * fq);
                    vn[mt] = MFMA16(aw, sb[kk], vn[mt]); oo[mt] = MFMA16(aq, sb[kk], oo[mt]); } }
#pragma unroll
            for (int mt = 0; mt < 4; ++mt) { const u32x2 uv = *(const LAS u32x2*)(uc + fr * 64 + 16 * mt + 4 * fq);
                vn[mt][0] = bflo(uv.x) - vn[mt][0]; vn[mt][1] = bfhi(uv.x) - vn[mt][1]; vn[mt][2] = bflo(uv.y) - vn[mt][2]; vn[mt][3] = bfhi(uv.y) - vn[mt][3];
                u32x2 w; w.x = cvt_pk_bf16(vn[mt][0], vn[mt][1]); w.y = cvt_pk_bf16(vn[mt][2], vn[mt][3]);
                *(LAS u32x2*)(VT + fr * 72 + 16 * mt + 4 * fq) = w; }
            LDS_WAIT();
            bf16x8 vb[2];
#pragma unroll
            for (int kk = 0; kk < 2; ++kk) vb[kk] = *(const LAS bf16x8*)(VT + fr * 72 + 32 * kk + 8 * fq);
#pragma unroll
            for (int mt = 0; mt < 4; ++mt) {
#pragma unroll
                for (int kk = 0; kk < 2; ++kk) { const bf16x8 aa = *(const LAS bf16x8*)(at + (16 * mt + fr) * 72 + 32 * kk + 8 * fq); oo[mt] = MFMA16(aa, vb[kk], oo[mt]); }
#pragma unroll
                for (int r = 0; r < 4; ++r) Og[((size_t)b * SEQ + (size_t)n * DNC + 16 * mt + 4 * fq + r) * 512 + h * HD + 16 * sl + fr] = oo[mt][r]; }
            const float dec = *(const LAS float*)(buf + SC_GL);
#pragma unroll
            for (int mt = 0; mt < 8; ++mt) { S[mt] = S[mt] * dec;
#pragma unroll
                for (int kk = 0; kk < 2; ++kk) { const bf16x8 ak = *(const LAS bf16x8*)(ke + (16 * mt + fr) * 72 + 32 * kk + 8 * fq); S[mt] = MFMA16(ak, vb[kk], S[mt]); }
                u32x2 w; w.x = cvt_pk_bf16(S[mt][0], S[mt][1]); w.y = cvt_pk_bf16(S[mt][2], S[mt][3]);
                *(LAS u32x2*)(ST + fr * 136 + 16 * mt + 4 * fq) = w; }
        }
        LDS_WAIT(); __syncthreads();
    }
}

__device__ __forceinline__ void dn_out(const Frame& F, const Args& a) {
    const int gw = F.vcu * NWAVES + F.wave, NGW = F.G * NWAVES;
    const float* Og = (const float*)(F.ws + WS_O); const bf16_t* PROJ = (const bf16_t*)(F.ws + WS_R3); bf16_t* MIX = (bf16_t*)(F.ws + WS_MIX);
    const float* ng = a.in[9] + 8 * (F.lane & 15);
    const f32x4 g0 = *(const f32x4*)ng, g1 = *(const f32x4*)(ng + 4);
    for (int m = gw; m < T; m += NGW) {
        const float* op = Og + (size_t)m * 512 + 8 * F.lane;
        f32x4 o0 = *(const f32x4*)op, o1 = *(const f32x4*)(op + 4);
        const u32x4 z = *(const u32x4*)(PROJ + (size_t)m * NPROJ + 2560 + 8 * F.lane);
        float ss = (o0[0] * o0[0] + o0[1] * o0[1]) + (o0[2] * o0[2] + o0[3] * o0[3]) + (o1[0] * o1[0] + o1[1] * o1[1]) + (o1[2] * o1[2] + o1[3] * o1[3]);
#pragma unroll
        for (int o = 1; o < 16; o <<= 1) ss += __shfl_xor(ss, o);
        const float rstd = rsqrtf(ss * (1.0f / HD) + EPS);
        o0 = o0 * rstd * g0; o1 = o1 * rstd * g1;
        u32x4 w; w.x = cvt_pk_bf16(o0[0] * silu_f(bflo(z[0])), o0[1] * silu_f(bfhi(z[0]))); w.y = cvt_pk_bf16(o0[2] * silu_f(bflo(z[1])), o0[3] * silu_f(bfhi(z[1])));
        w.z = cvt_pk_bf16(o1[0] * silu_f(bflo(z[2])), o1[1] * silu_f(bfhi(z[2]))); w.w = cvt_pk_bf16(o1[2] * silu_f(bflo(z[3])), o1[3] * silu_f(bfhi(z[3])));
        *(u32x4*)(MIX + (size_t)m * D + 512 + 8 * F.lane) = w;
    }
}

constexpr int RT_PITCH = 1032;
__device__ __forceinline__ void route(const Frame& F, const Args& a) {
    const int gw = F.vcu * NWAVES + F.wave, NGW = F.G * NWAVES;
    const bf16_t* HB = (const bf16_t*)(F.ws + WS_H); const bf16_t* RWT = (const bf16_t*)(F.ws + WS_RWT); const float* rb = a.in[13]; const float* g2 = a.in[11];
    int* EIDX = (int*)(F.ws + WS_EIDX); float* GATEW = (float*)(F.ws + WS_GATEW); int* EPOS = (int*)(F.ws + WS_EPOS);
    unsigned* cnt = (unsigned*)(F.ws + WS_CTL) + CW_CNT;
    LAS bf16_t* tl = (LAS bf16_t*)(F.lds + F.wave * 18432); LAS float* lg = (LAS float*)(F.lds + F.wave * 18432 + 16512);
    const int fr = F.lane & 15, fq = F.lane >> 4;
    f32x4 gv[4];
#pragma unroll
    for (int j = 0; j < 4; ++j) gv[j] = *(const f32x4*)(g2 + 4 * F.lane + 256 * j);
    for (int batch = gw; batch < T / 8; batch += NGW) {
        const size_t r0 = (size_t)batch * 8;
        u32x2 raw[8][4];
#pragma unroll
        for (int row = 0; row < 8; ++row)
#pragma unroll
            for (int j = 0; j < 4; ++j) raw[row][j] = ((const u32x2*)(HB + (r0 + row) * D))[F.lane + 64 * j];
#pragma unroll
        for (int row = 0; row < 8; ++row) {
            f32x4 v[4]; float ss = 0.f;
#pragma unroll
            for (int j = 0; j < 4; ++j) { v[j] = (f32x4){bflo(raw[row][j].x), bfhi(raw[row][j].x), bflo(raw[row][j].y), bfhi(raw[row][j].y)}; ss += (v[j][0] * v[j][0] + v[j][1] * v[j][1]) + (v[j][2] * v[j][2] + v[j][3] * v[j][3]); }
            const float rstd = rsqrtf(wave_sum(ss) * (1.0f / D) + EPS);
            unsigned* y8 = (unsigned*)(F.ws + WS_HN8 + (r0 + row) * D) + F.lane;
#pragma unroll
            for (int j = 0; j < 4; ++j) { const f32x4 y = v[j] * rstd * gv[j]; y8[64 * j] = cvt4_fp8(y[0], y[1], y[2], y[3]);
                u32x2 w; w.x = cvt_pk_bf16(y[0], y[1]); w.y = cvt_pk_bf16(y[2], y[3]); *(LAS u32x2*)(tl + row * RT_PITCH + 4 * F.lane + 256 * j) = w; }
        }
        LDS_WAIT();
        f32x4 acc0 = (f32x4){0.f, 0.f, 0.f, 0.f}, acc1 = acc0;
#pragma unroll 4
        for (int kk = 0; kk < 32; ++kk) {
            const bf16x8 af = *(const LAS bf16x8*)(tl + (fr & 7) * RT_PITCH + 32 * kk + 8 * fq);
            const bf16x8 b0 = *(const bf16x8*)(RWT + (size_t)fr * D + 32 * kk + 8 * fq), b1 = *(const bf16x8*)(RWT + (size_t)(16 + fr) * D + 32 * kk + 8 * fq);
            acc0 = MFMA16(af, b0, acc0); acc1 = MFMA16(af, b1, acc1);
        }
        const float bb0 = rb[fr], bb1 = rb[16 + fr];
        if (fq < 2) {
#pragma unroll
            for (int r = 0; r < 4; ++r) { lg[(4 * fq + r) * 36 + fr] = acc0[r] + bb0; lg[(4 * fq + r) * 36 + 16 + fr] = acc1[r] + bb1; } }
        LDS_WAIT();
        if (F.lane < 8) {
            const int row = F.lane; const size_t t = r0 + row;
            float v[32];
#pragma unroll
            for (int q = 0; q < 8; ++q) { const f32x4 x = *(const LAS f32x4*)(lg + row * 36 + 4 * q); v[4 * q] = x[0]; v[4 * q + 1] = x[1]; v[4 * q + 2] = x[2]; v[4 * q + 3] = x[3]; }
            float tv[4]; int ti[4];
#pragma unroll
            for (int k = 0; k < 4; ++k) { float best = -3.0e38f; int bi = 0;
#pragma unroll
                for (int e = 0; e < 32; ++e) { if (v[e] > best) { best = v[e]; bi = e; } }
                tv[k] = best; ti[k] = bi;
#pragma unroll
                for (int e = 0; e < 32; ++e) v[e] = (e == bi) ? -3.0e38f : v[e]; }
            const float e1 = __expf(tv[1] - tv[0]), e2 = __expf(tv[2] - tv[0]), e3 = __expf(tv[3] - tv[0]); const float inv = 1.0f / (1.0f + e1 + e2 + e3);
            const float gk[4] = {inv, e1 * inv, e2 * inv, e3 * inv};
#pragma unroll
            for (int k = 0; k < 4; ++k) {
                const unsigned pos = __hip_atomic_fetch_add(cnt + 64 * ti[k], 1u, __ATOMIC_RELAXED, __HIP_MEMORY_SCOPE_AGENT);
                EIDX[t * 4 + k] = ti[k]; GATEW[t * 4 + k] = gk[k]; EPOS[t * 4 + k] = (int)pos;
            }
        }
        LDS_WAIT();
    }
}

constexpr int TB_OFF = 131072;
__device__ __forceinline__ void build_tables(const Frame& F) {
    LAS int* pst = (LAS int*)(F.lds + TB_OFF); LAS int* cn = pst + 40; LAS int* tile_e = pst + 80;
    const unsigned* cnt = (const unsigned*)(F.ws + WS_CTL) + CW_CNT;
    if (F.tid < 64) {
        const int e = F.lane & 31; const int c = (int)__hip_atomic_load(cnt + 64 * e, __ATOMIC_RELAXED, __HIP_MEMORY_SCOPE_AGENT);
        const int padded = (c + 255) & ~255;
        int incl = padded;
#pragma unroll
        for (int o = 1; o < 32; o <<= 1) { const int t = __shfl_up(incl, o); if (e >= o) incl += t; }
        if (F.lane < 32) { pst[e] = incl - padded; cn[e] = c; if (e == 31) pst[32] = incl;
            for (int j = 0; j < padded / 256; ++j) tile_e[(incl - padded) / 256 + j] = e; }
    }
    LDS_WAIT(); __syncthreads();
}

__device__ __forceinline__ void gather_rows(const Frame& F) {
    const int gw = F.vcu * NWAVES + F.wave, NGW = F.G * NWAVES;
    LAS int* pst = (LAS int*)(F.lds + TB_OFF); LAS int* cn = pst + 40; LAS int* tile_e = pst + 80;
    const unsigned char* HN8 = F.ws + WS_HN8; unsigned char* XS = F.ws + WS_R3;
    const int* EIDX = (const int*)(F.ws + WS_EIDX); const int* EPOS = (const int*)(F.ws + WS_EPOS); const float* GATEW = (const float*)(F.ws + WS_GATEW); float* GSORT = (float*)(F.ws + WS_GSORT); int* ROWOF = (int*)(F.ws + WS_ROWOF);
    const int rtot = pst[32];
    for (int tl = gw; tl < (rtot >> 8); tl += NGW) { const int e = tile_e[tl], first = pst[e] + cn[e], lo = tl << 8;
        for (int R = (first > lo ? first : lo); R < lo + 256; ++R) { *((u32x4*)(XS + (size_t)R * D) + F.lane) = (u32x4){0u, 0u, 0u, 0u}; if (F.lane == 0) GSORT[R] = 0.f; } }
    for (int t0 = gw * 4; t0 < T; t0 += NGW * 4) {
        int Rl = 0;
        if (F.lane < 16) { const int a = t0 * 4 + F.lane; const int e = EIDX[a]; Rl = pst[e] + EPOS[a]; ROWOF[a] = Rl; GSORT[Rl] = GATEW[a]; }
        u32x4 v[4];
#pragma unroll
        for (int j = 0; j < 4; ++j) v[j] = *((const u32x4*)(HN8 + (size_t)(t0 + j) * D) + F.lane);
#pragma unroll
        for (int j = 0; j < 4; ++j)
#pragma unroll
            for (int k = 0; k < 4; ++k) { const int R = __builtin_amdgcn_readlane(Rl, 4 * j + k); *((u32x4*)(XS + (size_t)R * D) + F.lane) = v[j]; }
    }
}

__device__ __forceinline__ void combine(const Frame& F, const Args& a) {
    const int gw = F.vcu * NWAVES + F.wave, NGW = F.G * NWAVES;
    const bf16_t* H = (const bf16_t*)(F.ws + WS_H); const unsigned char* YS = F.ws + WS_YS; const int* ROWOF = (const int*)(F.ws + WS_ROWOF); const float* gf = a.in[18];
    f32x4 gv[4];
#pragma unroll
    for (int j = 0; j < 4; ++j) gv[j] = *(const f32x4*)(gf + 4 * F.lane + 256 * j);
    for (int m = gw; m < T; m += NGW) {
        const u32x2* xr = (const u32x2*)(H + (size_t)m * D) + F.lane;
        f32x4 v[4];
#pragma unroll
        for (int j = 0; j < 4; ++j) { const u32x2 hw = xr[64 * j]; v[j] = (f32x4){bflo(hw.x), bfhi(hw.x), bflo(hw.y), bfhi(hw.y)}; }
#if !defined(DBG_SKIP_MOE)
#pragma unroll
        for (int k = 0; k < 4; ++k) { const int R = ROWOF[m * 4 + k]; const int* yr = (const int*)(YS + (size_t)R * D) + F.lane;
#pragma unroll
            for (int j = 0; j < 4; ++j) { const int w = yr[64 * j]; const f32x2 lo = __builtin_amdgcn_cvt_pk_f32_fp8(w, false), hi = __builtin_amdgcn_cvt_pk_f32_fp8(w, true);
                v[j][0] += lo.x; v[j][1] += lo.y; v[j][2] += hi.x; v[j][3] += hi.y; } }
#endif
        float ss = 0.f;
#pragma unroll
        for (int j = 0; j < 4; ++j) ss += (v[j][0] * v[j][0] + v[j][1] * v[j][1]) + (v[j][2] * v[j][2] + v[j][3] * v[j][3]);
        const float rstd = rsqrtf(wave_sum(ss) * (1.0f / D) + EPS);
        f32x4* o = (f32x4*)(a.out + (size_t)m * D) + F.lane;
#pragma unroll
        for (int j = 0; j < 4; ++j) o[64 * j] = v[j] * rstd * gv[j];
    }
}

__device__ __forceinline__ void dbg_dump(const Frame& F, const Args& a, int what) {
    const int gw = F.vcu * NWAVES + F.wave, NGW = F.G * NWAVES;
    for (int m = gw; m < T; m += NGW) {
        for (int c = F.lane; c < D; c += 64) {
            float v = 0.f;
            if (what == 1) v = bf2f(((const bf16_t*)(F.ws + WS_R3))[(size_t)m * NPROJ + c]);
            else if (what == 2) v = bf2f(((const bf16_t*)(F.ws + WS_MIX))[(size_t)m * D + c]);
            else if (what == 3) v = ((const float*)(F.ws + WS_O))[(size_t)m * 512 + (c & 511)];
            else if (what == 4) v = ((const float*)(F.ws + WS_H))[(size_t)m * D + c];
            else if (what == 5) v = bf2f(((const bf16_t*)(F.ws + WS_R3))[(size_t)m * NPROJ + 1024 + c]);
            else if (what == 6) v = bf2f(((const bf16_t*)(F.ws + WS_R3))[(size_t)m * NPROJ + 2048 + c]);
            else if (what == 7) v = bf2f(((const bf16_t*)(F.ws + WS_Y))[(size_t)m * D + c]);
            else if (what == 9) v = bf2f(((const bf16_t*)(F.ws + WS_WC))[((size_t)m * D + c) & 0xFFFFFF]);
            else if (what == 10) v = bf2f(((const bf16_t*)(F.ws + WS_UC))[((size_t)m * D + c) & 0xFFFFFF]);
            else if (what == 11) v = bf2f(((const bf16_t*)(F.ws + WS_QD))[((size_t)m * D + c) & 0xFFFFFF]);
            else if (what == 12) v = bf2f(((const bf16_t*)(F.ws + WS_KET))[((size_t)m * D + c) & 0xFFFFFF]);
            else if (what == 13) v = bf2f(((const bf16_t*)(F.ws + WS_AT))[((size_t)m * D + c) & 0x7FFFFF]);
            else if (what == 14) v = ((const float*)(F.ws + WS_AB))[(size_t)m * 8 + (c & 7)];
            else if (what == 8) v = bf2f(((const bf16_t*)(F.ws + WS_MIX))[(size_t)m * D + (c & 511)]);
            if (!(v - v == 0.f)) v = 12345.f;
            a.out[(size_t)m * D + c] = v;
        }
    }
}

constexpr int NPHASES = 12;
__global__ void __launch_bounds__(NTHREADS, 2) fwd(Args args) {
    __shared__ __attribute__((aligned(16))) unsigned char lds_raw[LDS_BYTES];
    Frame F;
    F.lds = (LAS unsigned char*)lds_raw;
    F.tid = threadIdx.x; F.lane = F.tid & 63; F.wave = __builtin_amdgcn_readfirstlane(F.tid >> 6);
    F.G = gridDim.x; { const int bx = blockIdx.x; F.vcu = (F.G % 8 == 0) ? (bx % 8) * (F.G / 8) + bx / 8 : bx; }
    F.ws = args.ws;
    volatile LAS unsigned* MISC = (volatile LAS unsigned*)(F.lds + LDSCTL_OFF);
    for (int u = F.tid; u < (LDS_BYTES - LDSCTL_OFF) / 4; u += NTHREADS) MISC[u] = 0u;
    __syncthreads();
#if !MK_PER_PHASE
    XcdBarrier bar = xcd_barrier_post((unsigned*)(F.ws + WS_CTL) + CW_BAR, MISC + 8);
#define GRID_BAR() xcd_barrier(bar)
#else
#define GRID_BAR() do { } while (0)
#endif
    const int lo = args.ph_lo, hi = args.ph_hi;
#define IN(k) (lo <= (k) && (k) < hi)
#ifndef PROBE_DOUBLE
#define PROBE_DOUBLE (-1)
#endif
#define REP(k) for (int rep_ = 0; rep_ < ((PROBE_DOUBLE) == (k) ? 2 : 1); ++rep_)
#define SEAM(k) do { if (IN(k) && IN((k) + 1)) GRID_BAR(); } while (0)

    if (IN(0)) REP(0) { p0_prologue(F, args); } SEAM(0);
    if (IN(1)) REP(1) {
        pg8::Gemm g{(const bf16_t*)(F.ws + WS_Y), (const bf16_t*)(F.ws + WS_WIN), T, NPROJ, D}; pg8::StaticOrder S; S.init(T, NPROJ, F.G, (int)blockIdx.x);
        pg8::EpiProj E{(bf16_t*)(F.ws + WS_R3)};
        pg8::gemm_phase<pg8::EpiProj, pg8::StaticOrder>(F.lds, g, S, E);
    } SEAM(1);
    if (IN(2)) REP(2) {
        for (int u = F.vcu; u < NB * 32 * NH; u += F.G) gmlp_unit(F, args, u);
        if (F.vcu < NCHUNKS) {
            const int h0 = (F.vcu >> 6) & 3;
            DnPre P; int hcur = -1;
            dn_prefetch(F, P, F.vcu);
            for (int u = F.vcu; u < NCHUNKS; u += F.G) {
                const int hh = (u >> 6) & 3;
                if (hh != hcur) { __syncthreads(); for (int i = F.tid; i < 3 * 4 * 128; i += NTHREADS) { const int ten = i / 512, j = (i >> 7) & 3, c = i & 127; ((LAS float*)(F.lds + DN_CW))[i] = args.in[6][(size_t)j * 1536 + ten * 512 + hh * HD + c]; } hcur = hh; LDS_WAIT(); __syncthreads(); }
                dn_chunk(F, args, u, P, (u + F.G < NCHUNKS) ? u + F.G : -1);
            }
            (void)h0;
        }
    } SEAM(2);
    if (IN(3)) REP(3) {
        for (int it = F.vcu; it < NB * NH * 8; it += F.G) dn_scan(F, it);
    } SEAM(3);
    if (IN(4)) REP(4) { dn_out(F, args); } SEAM(4);
    if (IN(5)) REP(5) {
        pg8::Gemm g{(const bf16_t*)(F.ws + WS_MIX), (const bf16_t*)(F.ws + WS_WOUT), T, D, D}; pg8::StaticOrder S; S.init(T, D, F.G, (int)blockIdx.x);
        pg8::EpiResid E{args.in[0], (bf16_t*)(F.ws + WS_H)};
        pg8::gemm_phase<pg8::EpiResid, pg8::StaticOrder>(F.lds, g, S, E);
    } SEAM(5);
    if (IN(6)) { route(F, args); } SEAM(6);
    if (IN(8)) { build_tables(F); REP(8) gather_rows(F); } SEAM(8);
    if (IN(9)) {
        if (!IN(8)) build_tables(F);
        const int rtot = ((LAS int*)(F.lds + TB_OFF))[32];
        REP(9) {
        pg8::Gemm g{(const bf16_t*)(F.ws + WS_R3), (const bf16_t*)(F.ws + WS_WGU), rtot, 2048, D / 2}; pg8::MoeOrder S; S.init(rtot, 2048, F.G, (int)blockIdx.x); S.tile_e = (const LAS int*)(F.lds + TB_OFF) + 80;
        pg8::EpiSwiglu E{F.ws + WS_R4, args.in[15]};
        pg8::gemm_phase<pg8::EpiSwiglu, pg8::MoeOrder, true>(F.lds, g, S, E);
        }
    } SEAM(9);
    if (IN(10)) {
        if (!IN(9)) build_tables(F);
        const int rtot = ((LAS int*)(F.lds + TB_OFF))[32];
        REP(10) {
        pg8::Gemm g{(const bf16_t*)(F.ws + WS_R4), (const bf16_t*)(F.ws + WS_WDN), rtot, D, DFF / 2}; pg8::MoeOrder S; S.init(rtot, D, F.G, (int)blockIdx.x); S.tile_e = (const LAS int*)(F.lds + TB_OFF) + 80;
        pg8::EpiDown E{F.ws + WS_YS, args.in[17], (const float*)(F.ws + WS_GSORT)};
        pg8::gemm_phase<pg8::EpiDown, pg8::MoeOrder, true>(F.lds, g, S, E);
        }
    } SEAM(10);
    if (IN(11)) REP(11) { combine(F, args); }
#if defined(DBG_DUMP)
    if (IN(12)) { dbg_dump(F, args, DBG_DUMP); }
#endif
#undef IN
#undef SEAM
}

extern "C" void kernel_launch(void* const* d_in, const int* in_sizes, int n_in, void* d_out, int out_size, void* d_ws, size_t ws_size, hipStream_t stream) {
    static int grid = 0;
    if (grid == 0) {
        if (n_in != 19 || out_size != T * D || ws_size < WS_END) { fprintf(stderr, "kernel_launch: unexpected shapes (n_in %d, out %d, ws %zu)\n", n_in, out_size, ws_size); grid = -1; return; }
        int dev = 0, cus = 0, per_cu = 0;
        if (hipGetDevice(&dev) != hipSuccess || hipDeviceGetAttribute(&cus, hipDeviceAttributeMultiprocessorCount, dev) != hipSuccess) { grid = -1; return; }
        if (hipOccupancyMaxActiveBlocksPerMultiprocessor(&per_cu, (const void*)fwd, NTHREADS, 0) != hipSuccess || per_cu < 1) fprintf(stderr, "kernel_launch: occupancy query reports %d\n", per_cu);
        (void)hipGetLastError();
        grid = cus;
    }
    if (grid < 0) return;
    (void)hipMemsetAsync((char*)d_ws + WS_CTL, 0, CTL_ZERO_BYTES, stream);
    Args a{};
    for (int i = 0; i < 19; ++i) a.in[i] = (const float*)d_in[i];
    a.out = (float*)d_out; a.ws = (unsigned char*)d_ws;
#if MK_PER_PHASE
    for (int p = 0; p < NPHASES; ++p) {
#if defined(DBG_DUMP)
        if (p > DBG_LAST) continue;
#endif
        a.ph_lo = p; a.ph_hi = p + 1; hipLaunchKernelGGL(fwd, dim3(grid), dim3(NTHREADS), 0, stream, a); }
#if defined(DBG_DUMP)
    a.ph_lo = 12; a.ph_hi = 13; hipLaunchKernelGGL(fwd, dim3(grid), dim3(NTHREADS), 0, stream, a);
#endif
#else
    a.ph_lo = 0; a.ph_hi = NPHASES; hipLaunchKernelGGL(fwd, dim3(grid), dim3(NTHREADS), 0, stream, a);
#endif
}
```

```cpp
#include <hip/hip_runtime.h>
#include <cstdio>
#include <cstdint>

#ifndef MK_PER_PHASE
#define MK_PER_PHASE 0
#endif

#define LAS __attribute__((address_space(3)))
#define GAS __attribute__((address_space(1)))
typedef unsigned short bf16_t;
typedef short bf16x8 __attribute__((ext_vector_type(8)));
typedef float f32x4 __attribute__((ext_vector_type(4)));
typedef float f32x2 __attribute__((ext_vector_type(2)));
typedef unsigned u32x4 __attribute__((ext_vector_type(4)));
typedef unsigned u32x2 __attribute__((ext_vector_type(2)));
typedef int i32x4 __attribute__((ext_vector_type(4)));
typedef int i32x8 __attribute__((ext_vector_type(8)));

constexpr int NB = 8, SEQ = 4096, D = 1024, T = NB * SEQ;
constexpr int DIN = 3080, NPROJ = 3072;
constexpr int NE = 32, TOPK = 4, DFF = 1024;
constexpr int NH = 4, HD = 128, GMC = 128, DNC = 64;
constexpr int NCH = SEQ / DNC;
constexpr int NCHUNKS = NB * NH * NCH;
constexpr int RMAX = T * TOPK + NE * 256;
constexpr float EPS = 1e-6f;
constexpr int NWAVES = 8, NTHREADS = 512;

constexpr size_t MiB = 1u << 20;
constexpr size_t WS_CTL = 0, CTL_ZERO_BYTES = 32768;
constexpr size_t WS_AB = 1 * MiB;
constexpr size_t WS_EIDX = 2 * MiB;
constexpr size_t WS_GATEW = 2 * MiB + 512 * 1024;
constexpr size_t WS_ROWOF = 3 * MiB;
constexpr size_t WS_EPOS = 3 * MiB + 512 * 1024;
constexpr size_t WS_GSORT = 4 * MiB;
constexpr size_t WS_LIST = 5 * MiB;
constexpr size_t WS_RWT = 9 * MiB;
constexpr size_t WS_GLAST = 10 * MiB;
constexpr size_t WS_WIN = 16 * MiB;
constexpr size_t WS_WOUT = 22 * MiB;
constexpr size_t WS_WGU = 24 * MiB;
constexpr size_t WS_WDN = 152 * MiB;
constexpr size_t WS_HN8 = 88 * MiB;
constexpr size_t WS_H = 216 * MiB;
constexpr size_t WS_R3 = 344 * MiB;
constexpr size_t WS_R4 = 616 * MiB;
constexpr size_t WS_Y = WS_R4;
constexpr size_t WS_WC = WS_R4;
constexpr size_t WS_UC = WS_R4 + 32 * MiB;
constexpr size_t WS_QD = WS_R4 + 64 * MiB;
constexpr size_t WS_KET = WS_R4 + 96 * MiB;
constexpr size_t WS_AT = WS_R4 + 128 * MiB;
constexpr size_t WS_MIX = WS_R4 + 144 * MiB;
constexpr size_t WS_O = WS_R4 + 208 * MiB;
constexpr size_t WS_HN = 888 * MiB;
constexpr size_t WS_YS = WS_R3 + 136 * MiB;
constexpr size_t WS_END = 952 * MiB;
constexpr int CW_BAR = 0;
constexpr int CW_CNT = 4096;

constexpr int RING_BYTES = 155648;
constexpr int LDSCTL_OFF = RING_BYTES;
constexpr int LDS_BYTES = RING_BYTES + 1024;

#define LDS_WAIT() asm volatile("s_waitcnt lgkmcnt(0)" ::: "memory")
#define VM_WAIT() asm volatile("s_waitcnt vmcnt(0)" ::: "memory")
typedef __bf16 bf16x2_t __attribute__((ext_vector_type(2)));
__device__ __forceinline__ unsigned cvt_pk_bf16(float lo, float hi) { const bf16x2_t r = __builtin_convertvector((f32x2){lo, hi}, bf16x2_t); return __builtin_bit_cast(unsigned, r); }
__device__ __forceinline__ float bf2f(unsigned short b) { return __uint_as_float(((unsigned)b) << 16); }
__device__ __forceinline__ float bflo(unsigned w) { return __uint_as_float(w << 16); }
__device__ __forceinline__ float bfhi(unsigned w) { return __uint_as_float(w & 0xffff0000u); }
__device__ __forceinline__ bf16_t f2bf(float f) { return (bf16_t)(cvt_pk_bf16(f, 0.f) & 0xffffu); }
__device__ __forceinline__ unsigned cvt4_fp8(float a, float b, float c, float d) { int r = __builtin_amdgcn_cvt_pk_fp8_f32(a, b, 0, false); r = __builtin_amdgcn_cvt_pk_fp8_f32(c, d, r, true); return (unsigned)r; }
constexpr float W8_SCALE = 32.0f, W8_INV = 1.0f / 32.0f;
__device__ __forceinline__ float wave_sum(float v) {
#pragma unroll
    for (int o = 1; o < 64; o <<= 1) v += __shfl_xor(v, o);
    return v;
}
__device__ __forceinline__ float silu_f(float v) { return v / (1.0f + __expf(-v)); }
__device__ __forceinline__ float sigmoid_f(float v) { return 1.0f / (1.0f + __expf(-v)); }
__device__ __forceinline__ f32x2 gelu_pk(f32x2 v) {
    const f32x2 av = __builtin_elementwise_abs(v), d = av * 0.2316418882f + 1.0f;
    f32x2 t; t.x = __builtin_amdgcn_rcpf(d.x); t.y = __builtin_amdgcn_rcpf(d.y);
    f32x2 q = t * 0.5307027145f + (-0.7265760135f); q = q * t + 0.7107068705f; q = q * t + (-0.142248368f); q = q * t + 0.127414796f; q = q * t;
    const f32x2 s = (v * v) * (-0.72134752044f);
    f32x2 e; e.x = __builtin_amdgcn_exp2f(s.x); e.y = __builtin_amdgcn_exp2f(s.y);
    const f32x2 m = v * (q * e), r = v - m;
    f32x2 o; o.x = v.x < 0.f ? m.x : r.x; o.y = v.y < 0.f ? m.y : r.y; return o;
}

#define XB_TMO      128
#define XB_XCNT(j)  (256  + 64 * (j))
#define XB_XSUB(j)  (1280 + 64 * (j))
#define XB_XGEN(j)  (2304 + 64 * (j))
#define XB_TOP      3328
#define XB_TOPGEN   3392
#define XCD_BAR_WORDS 3456
#define XB_SPIN_CAP (1u << 18)
__device__ __forceinline__ unsigned xb_ld(unsigned* p)              { return __hip_atomic_load(p, __ATOMIC_RELAXED, __HIP_MEMORY_SCOPE_AGENT); }
__device__ __forceinline__ unsigned xb_add(unsigned* p, unsigned v) { return __hip_atomic_fetch_add(p, v, __ATOMIC_RELAXED, __HIP_MEMORY_SCOPE_AGENT); }
__device__ __forceinline__ unsigned xb_xcc_id() { return (unsigned)__builtin_amdgcn_s_getreg((3 << 11) | 20) & 0xFu; }
#define XB_SPIN(cond, bar) do { unsigned _sp = 0; while (cond) { __builtin_amdgcn_s_sleep(1); \
    if ((++_sp & 255u) == 0u) { if (xb_ld(&(bar)[XB_TMO])) break; if (_sp > XB_SPIN_CAP) { atomicAdd(&(bar)[XB_TMO], 1u); break; } } } } while (0)
struct XcdBarrier { unsigned* bar; unsigned x; volatile LAS unsigned* st; };
__device__ __forceinline__ XcdBarrier xcd_barrier_post(unsigned* bar, volatile LAS unsigned* st) {
    XcdBarrier b; b.bar = bar; b.x = xb_xcc_id(); b.st = st;
    if (threadIdx.x == 0) (void)xb_add(&bar[XB_XCNT(b.x)], 1u);
    return b;
}
__device__ __forceinline__ void xcd_barrier_complete(unsigned* bar, unsigned x, unsigned& nloc, unsigned& nx) {
    const unsigned G = gridDim.x * gridDim.y * gridDim.z;
    unsigned sum, cnt, mine, sp = 0u;
    for (;;) {
        sum = 0u; cnt = 0u; mine = 0u;
#pragma unroll
        for (unsigned j = 0; j < 16; ++j) { const unsigned c = xb_ld(&bar[XB_XCNT(j)]); sum += c; cnt += (c > 0u) ? 1u : 0u; mine = (j == x) ? c : mine; }
        if (sum == G) break;
        __builtin_amdgcn_s_sleep(1);
        if ((++sp & 255u) == 0u) { if (xb_ld(&bar[XB_TMO])) break; if (sp > XB_SPIN_CAP) { atomicAdd(&bar[XB_TMO], 1u); break; } }
    }
    nloc = mine > 0u ? mine : 1u; nx = cnt > 0u ? cnt : 1u;
}
__device__ __forceinline__ void xcd_barrier(const XcdBarrier& b) {
    asm volatile("s_waitcnt vmcnt(0)" ::: "memory");
    __syncthreads();
    if (threadIdx.x == 0) {
        unsigned* bar = b.bar;
        __builtin_amdgcn_s_waitcnt(0);
        unsigned nloc = b.st[0], nx = b.st[1];
        if (nloc == 0u) { xcd_barrier_complete(bar, b.x, nloc, nx); b.st[0] = nloc; b.st[1] = nx; }
        const unsigned old = xb_add(&bar[XB_XSUB(b.x)], 1u);
        const unsigned gen = old / nloc;
        if (old + 1u == (gen + 1u) * nloc) {
            __builtin_amdgcn_fence(__ATOMIC_RELEASE, "agent");
            asm volatile("s_waitcnt vmcnt(0)" ::: "memory");
            const unsigned og = xb_add(&bar[XB_TOP], 1u);
            const unsigned tg = og / nx;
            if (og + 1u == (tg + 1u) * nx) xb_add(&bar[XB_TOPGEN], 1u);
            else XB_SPIN(xb_ld(&bar[XB_TOPGEN]) == tg, bar);
            __builtin_amdgcn_fence(__ATOMIC_ACQUIRE, "agent");
            xb_add(&bar[XB_XGEN(b.x)], 1u);
            asm volatile("s_waitcnt vmcnt(0)" ::: "memory");
        } else {
            XB_SPIN(xb_ld(&bar[XB_XGEN(b.x)]) == gen, bar);
            __builtin_amdgcn_fence(__ATOMIC_ACQUIRE, "agent");
            asm volatile("s_waitcnt vmcnt(0)" ::: "memory");
        }
    }
    __syncthreads();
}

namespace pg8 {
constexpr int BM = 256, BK = 64, HALF = 128, HTB = HALF * BK * 2, STAGE_BYTES = 8 * HTB, NXCD = 8, WGM = 8;
__host__ __device__ __forceinline__ int lds_byte(int r, int c) { const int st = (r >> 4) * 2 + (c >> 5), rr = r & 15, cc = c & 31, ob = rr * 64 + cc * 2; return st * 1024 + (ob ^ (((ob >> 9) & 1) << 5)); }
__host__ __device__ __forceinline__ void stage_rc(int b, int& R, int& C) { const int st = b / 1024, sb = b % 1024, swz = sb ^ (((sb >> 9) & 1) << 5); R = (st >> 1) * 16 + swz / 64; C = (st & 1) * 32 + (swz % 64) / 2; }
__host__ __device__ __forceinline__ int perm32(int rho) { const int n = rho >> 4, i = rho & 15; return 8 * (i >> 2) + 4 * n + (i & 3); }

struct Unit { int pm, pn, pb; };
struct Gemm { const bf16_t* A; const bf16_t* Bt; int M, N, K; };

struct StaticOrder {
    int nM, nN, nwg, G, c;
    __device__ void init(int M, int N, int G_, int c_) { nM = M / BM; nN = N / BM; nwg = nM * nN; G = G_; c = c_; }
    __device__ bool next(int i, Unit& u) const {
        const long L = (long)i * G + c; if (L >= nwg) return false;
        int wgid = (int)L; { const int q = nwg / NXCD, r = nwg % NXCD, xcd = wgid % NXCD, off = wgid / NXCD; wgid = (xcd < r ? xcd * (q + 1) : r * (q + 1) + (xcd - r) * q) + off; }
        const int nig = WGM * nN, gid = wgid / nig, fm = gid * WGM, gsz = (nM - fm) < WGM ? (nM - fm) : WGM;
        u.pm = fm + ((wgid % nig) % gsz); u.pn = (wgid % nig) / gsz; u.pb = u.pn; return true;
    }
};
struct MoeOrder : StaticOrder {
    const LAS int* tile_e;
    __device__ bool next(int i, Unit& u) const { if (!StaticOrder::next(i, u)) return false; u.pb = __builtin_amdgcn_readfirstlane(tile_e[u.pm]) * nN + u.pn; return true; }
};

template <class Epi, class Sched, bool FP8 = false>
__device__ __forceinline__ void gemm_phase(LAS unsigned char* lds, const Gemm g, const Sched& S, const Epi& E) {
    const int tid = threadIdx.x, wid = __builtin_amdgcn_readfirstlane(tid >> 6), lane = tid & 63, wr = wid >> 2, wc = wid & 3, fr = lane & 15, fq = lane >> 4;
    const int K = g.K, nt = K / BK;
    unsigned voffA[2], voffB[2];
#pragma unroll
    for (int i = 0; i < 2; ++i) { int R, C; stage_rc(tid * 16 + i * 8192, R, C); const int Rb = Epi::PERM ? ((R & ~31) + perm32(R & 31)) : R;
        voffA[i] = (unsigned)(R * K + C) * 2u; voffB[i] = (unsigned)(Rb * K + C) * 2u; }
    const size_t kstep = (size_t)(BK * 2);
    const size_t hstep = (size_t)HALF * K * 2;
    const size_t tstep = 2 * hstep;
    const unsigned ldsw = (unsigned)wid * 1024u;
    const int aoff = lds_byte(wr * 64 + fr, fq * 8), boff = lds_byte(wc * 32 + fr, fq * 8);
    LAS unsigned char* ldsA = lds + aoff; LAS unsigned char* ldsB = lds + 4 * HTB + boff;
    asm volatile("" : "+v"(ldsA)); asm volatile("" : "+v"(ldsB));
#define PG8_SA(b, h) (((b) * 2 + (h)) * HTB)
#define PG8_SB(b, h) ((4 + (b) * 2 + (h)) * HTB)
#define PG8_STAGE(bufoff, gbase, voff) do { _Pragma("unroll") for (int _i = 0; _i < 2; ++_i) \
        __builtin_amdgcn_global_load_lds((const unsigned*)((const char*)(gbase) + (voff)[_i]), (LAS unsigned*)(lds + (bufoff) + ldsw + _i * 8192), 16, 0, 0); } while (0)
#define PG8_LD2(dst, addr) do { if constexpr (FP8) { const i32x4 lo_ = *(const LAS i32x4*)(addr), hi_ = *(const LAS i32x4*)((addr) + 1024); (dst).w = __builtin_shufflevector(lo_, hi_, 0, 1, 2, 3, 4, 5, 6, 7); } \
        else { (dst).h[0] = *(const LAS bf16x8*)(addr); (dst).h[1] = *(const LAS bf16x8*)((addr) + 1024); } } while (0)
#define PG8_LDA(dst, b, h) do { _Pragma("unroll") for (int m = 0; m < 4; ++m) PG8_LD2(dst[m], ldsA + PG8_SA(b, h) + m * 2048); } while (0)
#define PG8_LDB(dst, b, h) do { _Pragma("unroll") for (int n = 0; n < 2; ++n) PG8_LD2(dst[n], ldsB + PG8_SA(b, h) + n * 2048); } while (0)
#define PG8_MMA(ai, bj, At, Bt) do { __builtin_amdgcn_s_setprio(1); \
        if constexpr (FP8) { _Pragma("unroll") for (int m = 0; m < 4; ++m) _Pragma("unroll") for (int n = 0; n < 2; ++n) \
            asm volatile("v_mfma_f32_16x16x128_f8f6f4 %0, %1, %2, %0" : "+v"(acc[ai][bj][m][n]) : "v"(Bt[n].w), "v"(At[m].w)); } \
        else { _Pragma("unroll") for (int m = 0; m < 4; ++m) _Pragma("unroll") for (int n = 0; n < 2; ++n) _Pragma("unroll") for (int k = 0; k < 2; ++k) \
            acc[ai][bj][m][n] = __builtin_amdgcn_mfma_f32_16x16x32_bf16(Bt[n].h[k], At[m].h[k], acc[ai][bj][m][n], 0, 0, 0); } \
        __builtin_amdgcn_s_setprio(0); } while (0)
#define PG8_WAIT_V(n) asm volatile("s_waitcnt vmcnt(" #n ")" ::: "memory")
#define PG8_WAIT_L(n) asm volatile("s_waitcnt lgkmcnt(" #n ")" ::: "memory")
#define PG8_BAR __builtin_amdgcn_s_barrier()
#define PG8_SCHED __builtin_amdgcn_sched_barrier(0)
    Unit cur, nxt; int ui = 0;
    if (!S.next(0, cur)) return;
    f32x4 acc[2][2][4][2];
#pragma unroll
    for (int a = 0; a < 2; ++a)
#pragma unroll
        for (int b = 0; b < 2; ++b)
#pragma unroll
            for (int m = 0; m < 4; ++m)
#pragma unroll
                for (int n = 0; n < 2; ++n) acc[a][b][m][n] = (f32x4){0.f, 0.f, 0.f, 0.f};
    union Frag { bf16x8 h[2]; i32x8 w; };
    Frag At[4], B0[2], B1[2];
    const char* cA = (const char*)g.A + (size_t)cur.pm * tstep; const char* cB = (const char*)g.Bt + (size_t)cur.pb * tstep;
    PG8_STAGE(PG8_SB(0, 0), cB, voffB); PG8_STAGE(PG8_SB(0, 1), cB + hstep, voffB); PG8_STAGE(PG8_SA(0, 0), cA, voffA); PG8_STAGE(PG8_SA(0, 1), cA + hstep, voffA);
    if (wr == 1) PG8_BAR;
    PG8_WAIT_V(2); PG8_BAR;
    PG8_STAGE(PG8_SB(1, 0), cB + kstep, voffB); PG8_STAGE(PG8_SA(1, 0), cA + kstep, voffA); PG8_STAGE(PG8_SB(1, 1), cB + hstep + kstep, voffB);
    PG8_WAIT_V(6); PG8_BAR;
    for (;;) {
        const bool has_next = S.next(ui + 1, nxt);
        const char* nA = has_next ? (const char*)g.A + (size_t)nxt.pm * tstep : cA; const char* nB = has_next ? (const char*)g.Bt + (size_t)nxt.pb * tstep : cB;
        for (int t = 0; t < nt; t += 2) {
            const bool last = (t == nt - 2);
            const char* a1 = cA + (size_t)(t + 1) * kstep;
            const char* a2 = last ? nA : cA + (size_t)(t + 2) * kstep; const char* b2 = last ? nB : cB + (size_t)(t + 2) * kstep;
            const char* a3 = a2 + kstep; const char* b3 = b2 + kstep;
            PG8_LDB(B0, 0, 0); PG8_LDB(B1, 0, 1); PG8_SCHED; PG8_LDA(At, 0, 0); PG8_STAGE(PG8_SA(1, 1), a1 + hstep, voffA);
            PG8_WAIT_V(8); PG8_WAIT_L(0); PG8_BAR; PG8_MMA(0, 0, At, B0); PG8_MMA(0, 1, At, B1); PG8_BAR; PG8_SCHED;
            PG8_LDA(At, 0, 1); PG8_STAGE(PG8_SB(0, 0), b2, voffB); PG8_STAGE(PG8_SB(0, 1), b2 + hstep, voffB); PG8_STAGE(PG8_SA(0, 0), a2, voffA);
            PG8_WAIT_V(8); PG8_WAIT_L(0); PG8_BAR; PG8_MMA(1, 0, At, B0); PG8_MMA(1, 1, At, B1); PG8_BAR; PG8_SCHED;
            PG8_LDB(B0, 1, 0); PG8_LDB(B1, 1, 1); PG8_SCHED; PG8_LDA(At, 1, 0); PG8_STAGE(PG8_SA(0, 1), a2 + hstep, voffA);
            PG8_WAIT_V(8); PG8_WAIT_L(0); PG8_BAR; PG8_MMA(0, 0, At, B0); PG8_MMA(0, 1, At, B1); PG8_BAR; PG8_SCHED;
            PG8_LDA(At, 1, 1); PG8_STAGE(PG8_SB(1, 0), b3, voffB); PG8_STAGE(PG8_SB(1, 1), b3 + hstep, voffB); PG8_STAGE(PG8_SA(1, 0), a3, voffA);
            PG8_WAIT_V(8); PG8_WAIT_L(0); PG8_BAR; PG8_MMA(1, 0, At, B0); PG8_MMA(1, 1, At, B1); PG8_BAR; PG8_SCHED;
        }
        if (wr == 0) PG8_BAR;
        if constexpr (FP8) asm volatile("s_nop 15\n\ts_nop 15" ::: "memory");
        { int fr_ = fr, fq_ = fq; asm volatile("" : "+v"(fr_), "+v"(fq_));
          E(acc, cur, wr, wc, fr_, fq_); }
        if (!has_next) break;
#pragma unroll
        for (int a = 0; a < 2; ++a)
#pragma unroll
            for (int b = 0; b < 2; ++b)
#pragma unroll
                for (int m = 0; m < 4; ++m)
#pragma unroll
                    for (int n = 0; n < 2; ++n) { acc[a][b][m][n] = (f32x4){0.f, 0.f, 0.f, 0.f}; if constexpr (FP8) asm volatile("" : "+v"(acc[a][b][m][n])); }
        cur = nxt; cA = nA; cB = nB; ++ui;
        if (wr == 1) PG8_BAR;
    }
    PG8_WAIT_V(0);
    PG8_BAR;
#undef PG8_SA
#undef PG8_SB
#undef PG8_STAGE
#undef PG8_LDA
#undef PG8_LDB
#undef PG8_MMA
#undef PG8_LD2
#undef PG8_WAIT_V
#undef PG8_WAIT_L
#undef PG8_BAR
#undef PG8_SCHED
}

struct EpiProj {
    static constexpr bool PERM = true;
    bf16_t* O;
    __device__ __forceinline__ void operator()(const f32x4 (&acc)[2][2][4][2], const Unit& u, int wr, int wc, int fr, int fq) const {
        const int row0 = u.pm * BM + wr * 64 + fr, col0 = u.pn * BM + wc * 32 + 8 * fq;
#pragma unroll
        for (int ai = 0; ai < 2; ++ai)
#pragma unroll
            for (int m = 0; m < 4; ++m) { bf16_t* rowp = O + (size_t)(row0 + ai * HALF + m * 16) * NPROJ + col0;
#pragma unroll
                for (int bj = 0; bj < 2; ++bj) { const f32x4 v0 = acc[ai][bj][m][0], v1 = acc[ai][bj][m][1];
                    u32x4 w; w.x = cvt_pk_bf16(v0[0], v0[1]); w.y = cvt_pk_bf16(v0[2], v0[3]); w.z = cvt_pk_bf16(v1[0], v1[1]); w.w = cvt_pk_bf16(v1[2], v1[3]);
                    *(u32x4*)(rowp + bj * HALF) = w; } }
    }
};
struct EpiResid {
    static constexpr bool PERM = true;
    const float* X; bf16_t* H;
    __device__ __forceinline__ void operator()(const f32x4 (&acc)[2][2][4][2], const Unit& u, int wr, int wc, int fr, int fq) const {
        const int row0 = u.pm * BM + wr * 64 + fr, col0 = u.pn * BM + wc * 32 + 8 * fq;
#pragma unroll
        for (int ai = 0; ai < 2; ++ai)
#pragma unroll
            for (int m = 0; m < 4; ++m) { const size_t off = (size_t)(row0 + ai * HALF + m * 16) * D + col0;
#pragma unroll
                for (int bj = 0; bj < 2; ++bj) { const f32x4 v0 = acc[ai][bj][m][0] + *(const f32x4*)(X + off + bj * HALF), v1 = acc[ai][bj][m][1] + *(const f32x4*)(X + off + bj * HALF + 4);
                    u32x4 w; w.x = cvt_pk_bf16(v0[0], v0[1]); w.y = cvt_pk_bf16(v0[2], v0[3]); w.z = cvt_pk_bf16(v1[0], v1[1]); w.w = cvt_pk_bf16(v1[2], v1[3]);
                    *(u32x4*)(H + off + bj * HALF) = w; } }
    }
};
struct EpiSwiglu {
    static constexpr bool PERM = true;
    unsigned char* O; const float* bgu;
    __device__ __forceinline__ void operator()(const f32x4 (&acc)[2][2][4][2], const Unit& u, int wr, int wc, int fr, int fq) const {
        const int row0 = u.pm * BM + wr * 64 + fr, j0 = u.pn * HALF + wc * 32 + 8 * fq, e = u.pb >> 3;
        const float* bg = bgu + (size_t)e * 2048 + j0;
        f32x4 bgv[2], buv[2];
#pragma unroll
        for (int n = 0; n < 2; ++n) { bgv[n] = *(const f32x4*)(bg + 4 * n); buv[n] = *(const f32x4*)(bg + 1024 + 4 * n); }
#pragma unroll
        for (int ai = 0; ai < 2; ++ai)
#pragma unroll
            for (int m = 0; m < 4; ++m) { unsigned char* rowp = O + (size_t)(row0 + ai * HALF + m * 16) * DFF + j0;
                u32x2 w;
#pragma unroll
                for (int n = 0; n < 2; ++n) { const f32x4 g4 = acc[ai][0][m][n] * W8_INV + bgv[n], u4 = acc[ai][1][m][n] * W8_INV + buv[n]; f32x4 r;
#pragma unroll
                    for (int j = 0; j < 4; ++j) { const float ga = fminf(g4[j], 7.0f), ua = fminf(fmaxf(u4[j], -7.0f), 7.0f);
                        r[j] = (ua + 1.0f) * ga * __builtin_amdgcn_rcpf(1.0f + __builtin_amdgcn_exp2f(-2.4554669f * ga)); }
                    w[n] = cvt4_fp8(r[0], r[1], r[2], r[3]); }
                *(u32x2*)rowp = w; }
    }
};
struct EpiDown {
    static constexpr bool PERM = true;
    unsigned char* O; const float* bdn; const float* gsort;
    __device__ __forceinline__ void operator()(const f32x4 (&acc)[2][2][4][2], const Unit& u, int wr, int wc, int fr, int fq) const {
        const int row0 = u.pm * BM + wr * 64 + fr, col0 = u.pn * BM + wc * 32 + 8 * fq, e = u.pb >> 2;
        const float* bp = bdn + (size_t)e * D + col0;
        f32x4 bv[2][2]; float gw[2][4];
#pragma unroll
        for (int bj = 0; bj < 2; ++bj) { bv[bj][0] = *(const f32x4*)(bp + bj * HALF); bv[bj][1] = *(const f32x4*)(bp + bj * HALF + 4); }
#pragma unroll
        for (int ai = 0; ai < 2; ++ai)
#pragma unroll
            for (int m = 0; m < 4; ++m) gw[ai][m] = gsort[row0 + ai * HALF + m * 16];
#pragma unroll
        for (int ai = 0; ai < 2; ++ai)
#pragma unroll
            for (int m = 0; m < 4; ++m) { const int r = row0 + ai * HALF + m * 16; const float g = gw[ai][m] * W8_INV; unsigned char* rowp = O + (size_t)r * D + col0;
#pragma unroll
                for (int bj = 0; bj < 2; ++bj) { const f32x4 v0 = acc[ai][bj][m][0] * g + bv[bj][0] * gw[ai][m], v1 = acc[ai][bj][m][1] * g + bv[bj][1] * gw[ai][m];
                    u32x2 w; w.x = cvt4_fp8(v0[0], v0[1], v0[2], v0[3]); w.y = cvt4_fp8(v1[0], v1[1], v1[2], v1[3]);
                    *(u32x2*)(rowp + bj * HALF) = w; } }
    }
};
}

struct Args {
    const float* in[19]; float* out; unsigned char* ws; int ph_lo, ph_hi;
};
struct Frame {
    LAS unsigned char* lds;
    int tid, lane, wave, G, vcu;
    unsigned char* ws;
};
#define MFMA16(a, b, c) __builtin_amdgcn_mfma_f32_16x16x32_bf16((a), (b), (c), 0, 0, 0)

__device__ __forceinline__ void tr_item(const float* src, size_t ldw, bf16_t* dst, LAS float* scr, int lane) {
    f32x4 v[16];
    const int kq = lane >> 4, n4 = 4 * (lane & 15);
#pragma unroll
    for (int i = 0; i < 16; ++i) v[i] = *(const f32x4*)(src + (size_t)(4 * i + kq) * ldw + n4);
#pragma unroll
    for (int i = 0; i < 16; ++i) { LAS float* s = scr + (4 * i + kq) * 65 + n4; s[0] = v[i][0]; s[1] = v[i][1]; s[2] = v[i][2]; s[3] = v[i][3]; }
    LDS_WAIT();
    const int c = lane & 7;
#pragma unroll
    for (int r = 0; r < 8; ++r) { const int n = 8 * r + (lane >> 3); const LAS float* s = scr + (8 * c) * 65 + n;
        u32x4 o; o.x = cvt_pk_bf16(s[0 * 65], s[1 * 65]); o.y = cvt_pk_bf16(s[2 * 65], s[3 * 65]); o.z = cvt_pk_bf16(s[4 * 65], s[5 * 65]); o.w = cvt_pk_bf16(s[6 * 65], s[7 * 65]);
        *(u32x4*)(dst + (size_t)n * 1024 + 8 * c) = o; }
    LDS_WAIT();
}
__device__ __forceinline__ void tr_item8(const float* src, size_t ldw, unsigned char* dst, LAS float* scr, int lane) {
    f32x4 v[16];
    const int kq = lane >> 3, n4 = 4 * (lane & 7);
#pragma unroll
    for (int i = 0; i < 16; ++i) v[i] = *(const f32x4*)(src + (size_t)(8 * i + kq) * ldw + n4);
#pragma unroll
    for (int i = 0; i < 16; ++i) { LAS float* s = scr + (8 * i + kq) * 33 + n4; s[0] = v[i][0]; s[1] = v[i][1]; s[2] = v[i][2]; s[3] = v[i][3]; }
    LDS_WAIT();
    const int c = lane >> 3, nn = lane & 7;
#pragma unroll
    for (int r = 0; r < 4; ++r) { const int n = 8 * r + nn; const LAS float* s = scr + (16 * c) * 33 + n;
        u32x4 o;
#pragma unroll
        for (int q = 0; q < 4; ++q) o[q] = cvt4_fp8(s[(4 * q) * 33] * W8_SCALE, s[(4 * q + 1) * 33] * W8_SCALE, s[(4 * q + 2) * 33] * W8_SCALE, s[(4 * q + 3) * 33] * W8_SCALE);
        *(u32x4*)(dst + (size_t)n * 1024 + 16 * c) = o; }
    LDS_WAIT();
}
__device__ __forceinline__ void p0_prologue(const Frame& F, const Args& a) {
    LAS float* scr = (LAS float*)(F.lds + F.wave * 16896);
    const int gw = F.vcu * NWAVES + F.wave, NGW = F.G * NWAVES;
    const float* w_in = a.in[2]; const float* w_out = a.in[10]; const float* w_gu = a.in[14]; const float* w_dn = a.in[16]; const float* rw = a.in[12];
    bf16_t* WIN = (bf16_t*)(F.ws + WS_WIN); bf16_t* WOUT = (bf16_t*)(F.ws + WS_WOUT); unsigned char* WGU = F.ws + WS_WGU; unsigned char* WDN = F.ws + WS_WDN; bf16_t* RWT = (bf16_t*)(F.ws + WS_RWT);
    constexpr int I_IN = 16 * 48, I_OUT = 16 * 16, NITEMS = I_IN + I_OUT;
    for (int it = gw; it < NITEMS; it += NGW) {
        int r = it;
        if (r < I_IN) { const int kb = r / 48, nb = r % 48; tr_item(w_in + (size_t)(64 * kb) * DIN + 64 * nb, DIN, WIN + (size_t)(64 * nb) * 1024 + 64 * kb, scr, F.lane); continue; } r -= I_IN;
        { const int kb = r / 16, nb = r % 16; tr_item(w_out + (size_t)(64 * kb) * D + 64 * nb, D, WOUT + (size_t)(64 * nb) * 1024 + 64 * kb, scr, F.lane); }
    }
    for (int i = gw * 64 + F.lane; i < 32 * 1024; i += NGW * 64) { const int e = i >> 10, k = i & 1023; RWT[i] = f2bf(rw[(size_t)k * 32 + e]); }
    const float* x = a.in[0]; const float* g1 = a.in[1];
    bf16_t* Y = (bf16_t*)(F.ws + WS_Y); float* AB = (float*)(F.ws + WS_AB);
    f32x4 gv[4]; f32x4 wab[4][4][2];
#pragma unroll
    for (int j = 0; j < 4; ++j) { gv[j] = *(const f32x4*)(g1 + 4 * F.lane + 256 * j);
#pragma unroll
        for (int i = 0; i < 4; ++i) { const float* p = w_in + (size_t)(4 * F.lane + 256 * j + i) * DIN + NPROJ; wab[j][i][0] = *(const f32x4*)p; wab[j][i][1] = *(const f32x4*)(p + 4); } }
    for (int m = gw; m < T; m += NGW) {
        const f32x4* xr = (const f32x4*)(x + (size_t)m * D) + F.lane;
        f32x4 v[4]; float ss = 0.f;
#pragma unroll
        for (int j = 0; j < 4; ++j) { v[j] = xr[64 * j]; ss += (v[j][0] * v[j][0] + v[j][1] * v[j][1]) + (v[j][2] * v[j][2] + v[j][3] * v[j][3]); }
        const float rstd = rsqrtf(wave_sum(ss) * (1.0f / D) + EPS);
        f32x4 p0 = (f32x4){0.f, 0.f, 0.f, 0.f}, p1 = p0;
        u32x2* yo = (u32x2*)(Y + (size_t)m * D) + F.lane;
#pragma unroll
        for (int j = 0; j < 4; ++j) { const f32x4 y = v[j] * rstd * gv[j];
#pragma unroll
            for (int i = 0; i < 4; ++i) { p0 += wab[j][i][0] * y[i]; p1 += wab[j][i][1] * y[i]; }
            u32x2 w; w.x = cvt_pk_bf16(y[0], y[1]); w.y = cvt_pk_bf16(y[2], y[3]); yo[64 * j] = w; }
#pragma unroll
        for (int i = 0; i < 4; ++i) { p0[i] = wave_sum(p0[i]); p1[i] = wave_sum(p1[i]); }
        if (F.lane == 0) { *(f32x4*)(AB + (size_t)m * 8) = p0; *(f32x4*)(AB + (size_t)m * 8 + 4) = p1; }
    }
}

constexpr int GM_LDT = 136;
__device__ __forceinline__ void gmlp_unit(const Frame& F, const Args& a, int unit) {
    const int h = unit & 3, bn = unit >> 2;
    const bf16_t* PROJ = (const bf16_t*)(F.ws + WS_R3); bf16_t* MIX = (bf16_t*)(F.ws + WS_MIX);
    const float* gmg = a.in[3] + h * HD; const float* Wh = a.in[4] + (size_t)h * GMC * GMC; const float* bs = a.in[5] + h * GMC;
    LAS bf16_t* vnT = (LAS bf16_t*)F.lds;
    const size_t row0 = (size_t)bn * GMC;
    {
        const int sp = F.tid >> 3, seg = F.tid & 7;
        const bf16_t* p0 = PROJ + (row0 + 2 * sp) * NPROJ + 512 + h * HD + 16 * seg; const bf16_t* p1 = p0 + NPROJ;
        const u32x4 a0 = *(const u32x4*)p0, a1 = *(const u32x4*)(p0 + 8), b0 = *(const u32x4*)p1, b1 = *(const u32x4*)(p1 + 8);
        float x0[16], x1[16];
#pragma unroll
        for (int i = 0; i < 4; ++i) { x0[2 * i] = bflo(a0[i]); x0[2 * i + 1] = bfhi(a0[i]); x0[8 + 2 * i] = bflo(a1[i]); x0[9 + 2 * i] = bfhi(a1[i]);
                                      x1[2 * i] = bflo(b0[i]); x1[2 * i + 1] = bfhi(b0[i]); x1[8 + 2 * i] = bflo(b1[i]); x1[9 + 2 * i] = bfhi(b1[i]); }
#pragma unroll
        for (int i = 0; i < 16; ++i) { const f32x2 gg2 = gelu_pk((f32x2){x0[i], x1[i]}); x0[i] = gg2.x; x1[i] = gg2.y; }
        float s0 = 0.f, s1 = 0.f;
#pragma unroll
        for (int i = 0; i < 16; ++i) { s0 += x0[i] * x0[i]; s1 += x1[i] * x1[i]; }
#pragma unroll
        for (int o = 1; o < 8; o <<= 1) { s0 += __shfl_xor(s0, o); s1 += __shfl_xor(s1, o); }
        const float r0 = rsqrtf(s0 * (1.0f / HD) + EPS), r1 = rsqrtf(s1 * (1.0f / HD) + EPS);
#pragma unroll
        for (int i = 0; i < 16; ++i) { const float gg = gmg[16 * seg + i];
            *(LAS unsigned*)(vnT + (16 * seg + i) * GM_LDT + (((((sp >> 2) ^ seg) & 7) | ((sp >> 2) & 8)) << 3) + ((2 * sp) & 7)) = cvt_pk_bf16(x0[i] * r0 * gg, x1[i] * r1 * gg); }
    }
    const int fr = F.lane & 15, fq = F.lane >> 4, trow = 16 * F.wave + fr;
    bf16x8 af[4];
#pragma unroll
    for (int kk = 0; kk < 4; ++kk) { const int s0 = 32 * kk + 8 * fq; const float* wp = Wh + (size_t)trow * GMC + s0;
        const f32x4 w0 = *(const f32x4*)wp, w1 = *(const f32x4*)(wp + 4); float wv[8] = {w0[0], w0[1], w0[2], w0[3], w1[0], w1[1], w1[2], w1[3]};
#pragma unroll
        for (int j = 0; j < 8; ++j) if (s0 + j > trow) wv[j] = 0.f;
        u32x4 pk; pk.x = cvt_pk_bf16(wv[0], wv[1]); pk.y = cvt_pk_bf16(wv[2], wv[3]); pk.z = cvt_pk_bf16(wv[4], wv[5]); pk.w = cvt_pk_bf16(wv[6], wv[7]);
        af[kk] = __builtin_bit_cast(bf16x8, pk); }
    LDS_WAIT(); __syncthreads();
    f32x4 acc[8];
#pragma unroll
    for (int nt = 0; nt < 8; ++nt) { acc[nt] = (f32x4){0.f, 0.f, 0.f, 0.f};
#pragma unroll
        for (int kk = 0; kk < 4; ++kk) { const int ch = 4 * kk + fq; const bf16x8 bfr = *(const LAS bf16x8*)(vnT + (16 * nt + fr) * GM_LDT + ((((ch ^ nt) & 7) | (ch & 8)) << 3)); acc[nt] = MFMA16(af[kk], bfr, acc[nt]); } }
#pragma unroll
    for (int r = 0; r < 4; ++r) { const int t = 16 * F.wave + 4 * fq + r; const float bias = bs[t];
        const bf16_t* up = PROJ + (row0 + t) * NPROJ + h * HD + fr; bf16_t* op = MIX + (row0 + t) * D + h * HD + fr;
#pragma unroll
        for (int nt = 0; nt < 8; nt += 2) { const f32x2 ug = gelu_pk((f32x2){bf2f(up[16 * nt]), bf2f(up[16 * nt + 16])});
            op[16 * nt] = f2bf(ug.x * (acc[nt][r] + bias)); op[16 * nt + 16] = f2bf(ug.y * (acc[nt + 1][r] + bias)); } }
    __syncthreads();
}

constexpr int DN_QS = 0;
constexpr int DN_KS = 17408;
constexpr int DN_KT = 34816;
constexpr int DN_XT = 53248;
constexpr int DN_LN = 90112;
constexpr int DN_LD = 99328;
constexpr int DN_TI = 103680;
constexpr int DN_YT = 106752;
constexpr int DN_GC = 119040;
constexpr int DN_CW = 120064;
static_assert(DN_CW + 6144 <= RING_BYTES, "DeltaNet chunk LDS map");
__device__ __forceinline__ int tsw(int r, int pos) { return r * 72 + ((((pos >> 3) ^ (r >> 3)) & 7) << 3) + (pos & 7); }
__device__ __forceinline__ int dn_slot(int bh, int n) { return bh * NCH + ((n + 7 * bh) & (NCH - 1)); }
struct DnPre { u32x4 xv[3][2][4]; float av, bv; };
__device__ __forceinline__ void dn_prefetch(const Frame& F, DnPre& P, int unit) {
    const int n = unit & 63, bh = unit >> 6, h = bh & 3, b = bh >> 2, fr = F.lane & 15, fq = F.lane >> 4;
    const bf16_t* PROJ = (const bf16_t*)(F.ws + WS_R3); const float* AB = (const float*)(F.ws + WS_AB);
    const size_t trow0 = (size_t)b * SEQ + (size_t)n * DNC;
    P.av = AB[(trow0 + F.lane) * 8 + h]; P.bv = AB[(trow0 + F.lane) * 8 + 4 + h];
#pragma unroll
    for (int ten = 0; ten < 3; ++ten) { const int ch = ten * 512 + h * HD + 8 * fr;
#pragma unroll
        for (int hp = 0; hp < 2; ++hp) { const int pos = hp * 32 + 4 * F.wave + fq;
#pragma unroll
            for (int j = 0; j < 4; ++j) { const int sp = n * DNC + pos - 3 + j;
                P.xv[ten][hp][j] = (sp >= 0) ? *(const u32x4*)(PROJ + ((size_t)b * SEQ + sp) * NPROJ + 1024 + ch) : (u32x4){0u, 0u, 0u, 0u}; } } }
}
__device__ __forceinline__ void dn_chunk(const Frame& F, const Args& a, int unit, DnPre& P, int next_unit) {
    const int n = unit & 63, bh = unit >> 6, h = bh & 3, b = bh >> 2;
    const LAS float* cwL = (const LAS float*)(F.lds + DN_CW);
    LAS unsigned char* L = F.lds;
    LAS bf16_t* qs = (LAS bf16_t*)(L + DN_QS); LAS bf16_t* ks = (LAS bf16_t*)(L + DN_KS); LAS bf16_t* kT = (LAS bf16_t*)(L + DN_KT); LAS bf16_t* XT = (LAS bf16_t*)(L + DN_XT);
    LAS bf16_t* Ln = (LAS bf16_t*)(L + DN_LN); LAS float* Ld = (LAS float*)(L + DN_LD); LAS bf16_t* Ti = (LAS bf16_t*)(L + DN_TI); LAS bf16_t* YT = (LAS bf16_t*)(L + DN_YT + F.wave * 1536);
    LAS float* gcs = (LAS float*)(L + DN_GC); LAS float* bts = gcs + 64; LAS float* egs = gcs + 128;
    const size_t trow0 = (size_t)b * SEQ + (size_t)n * DNC;
    int fr = F.lane & 15, fq = F.lane >> 4;
    asm volatile("" : "+v"(fr), "+v"(fq));
    float my_gc, my_beta, my_eg;
    {
        const float av = P.av, bv = P.bv;
        const float xg = av + a.in[8][h];
        const float sp = xg > 20.f ? xg : log1pf(__expf(xg));
        float g = -__expf(a.in[7][h]) * sp;
#pragma unroll
        for (int o = 1; o < 64; o <<= 1) { const float t = __shfl_up(g, o); if (F.lane >= o) g += t; }
        my_gc = g; my_beta = sigmoid_f(bv); my_eg = __expf(g);
        if (F.wave == 0) { gcs[F.lane] = my_gc; bts[F.lane] = my_beta; egs[F.lane] = my_eg; }
    }
    const int slot = dn_slot(bh, n);
    bf16_t* QDg = (bf16_t*)(F.ws + WS_QD) + (size_t)slot * 64 * 128;
#pragma unroll
    for (int ten = 0; ten < 3; ++ten) {
        f32x4 w0[4], w1[4];
#pragma unroll
        for (int j = 0; j < 4; ++j) { w0[j] = *(const LAS f32x4*)(cwL + (ten * 4 + j) * 128 + 8 * fr); w1[j] = *(const LAS f32x4*)(cwL + (ten * 4 + j) * 128 + 8 * fr + 4); }
#pragma unroll
        for (int hp = 0; hp < 2; ++hp) { const int pos = hp * 32 + 4 * F.wave + fq;
            float accv[8];
#pragma unroll
            for (int i = 0; i < 8; ++i) accv[i] = 0.f;
#pragma unroll
            for (int j = 0; j < 4; ++j) { const u32x4 x = P.xv[ten][hp][j];
                accv[0] += bflo(x[0]) * w0[j][0]; accv[1] += bfhi(x[0]) * w0[j][1]; accv[2] += bflo(x[1]) * w0[j][2]; accv[3] += bfhi(x[1]) * w0[j][3];
                accv[4] += bflo(x[2]) * w1[j][0]; accv[5] += bfhi(x[2]) * w1[j][1]; accv[6] += bflo(x[3]) * w1[j][2]; accv[7] += bfhi(x[3]) * w1[j][3]; }
            float ss = 0.f;
#pragma unroll
            for (int i = 0; i < 8; ++i) { accv[i] = silu_f(accv[i]); ss += accv[i] * accv[i]; }
#pragma unroll
            for (int o = 1; o < 16; o <<= 1) ss += __shfl_xor(ss, o);
            const float bp = __shfl(my_beta, pos), ep = __shfl(my_eg, pos);
            if (ten == 0) { const float sc = rsqrtf(ss + EPS) * 0.08838834764831845f;
#pragma unroll
                for (int i = 0; i < 8; ++i) accv[i] *= sc;
                u32x4 w; w.x = cvt_pk_bf16(accv[0], accv[1]); w.y = cvt_pk_bf16(accv[2], accv[3]); w.z = cvt_pk_bf16(accv[4], accv[5]); w.w = cvt_pk_bf16(accv[6], accv[7]);
                *(LAS u32x4*)(qs + pos * 136 + 8 * fr) = w;
                u32x4 wd; wd.x = cvt_pk_bf16(accv[0] * ep, accv[1] * ep); wd.y = cvt_pk_bf16(accv[2] * ep, accv[3] * ep); wd.z = cvt_pk_bf16(accv[4] * ep, accv[5] * ep); wd.w = cvt_pk_bf16(accv[6] * ep, accv[7] * ep);
                *(u32x4*)(QDg + pos * 128 + 8 * fr) = wd;
            } else if (ten == 1) { const float sc = rsqrtf(ss + EPS);
#pragma unroll
                for (int i = 0; i < 8; ++i) accv[i] *= sc;
                u32x4 w; w.x = cvt_pk_bf16(accv[0], accv[1]); w.y = cvt_pk_bf16(accv[2], accv[3]); w.z = cvt_pk_bf16(accv[4], accv[5]); w.w = cvt_pk_bf16(accv[6], accv[7]);
                *(LAS u32x4*)(ks + pos * 136 + 8 * fr) = w;
                const float rs = bp * ep;
#pragma unroll
                for (int i = 0; i < 8; ++i) { kT[tsw(8 * fr + i, pos)] = f2bf(accv[i]); XT[tsw(128 + 8 * fr + i, pos)] = f2bf(accv[i] * rs); }
            } else {
#pragma unroll
                for (int i = 0; i < 8; ++i) XT[tsw(8 * fr + i, pos)] = f2bf(accv[i] * bp);
            }
        }
    }
    if (next_unit >= 0) dn_prefetch(F, P, next_unit);
    LDS_WAIT(); __syncthreads();
    bf16_t* ATg = (bf16_t*)(F.ws + WS_AT) + (size_t)slot * 64 * 64;
    {
        const int mt = F.wave & 3; const LAS bf16_t* Asrc = (F.wave < 4) ? ks : qs;
        f32x4 acc[4];
#pragma unroll
        for (int nt = 0; nt < 4; ++nt) acc[nt] = (f32x4){0.f, 0.f, 0.f, 0.f};
#pragma unroll
        for (int kk = 0; kk < 4; ++kk) { const bf16x8 af = *(const LAS bf16x8*)(Asrc + (16 * mt + fr) * 136 + 32 * kk + 8 * fq);
#pragma unroll
            for (int nt = 0; nt < 4; ++nt) { const bf16x8 bfr = *(const LAS bf16x8*)(ks + (16 * nt + fr) * 136 + 32 * kk + 8 * fq); acc[nt] = MFMA16(af, bfr, acc[nt]); } }
#pragma unroll
        for (int r = 0; r < 4; ++r) { const int i = 16 * mt + 4 * fq + r; const float gi = gcs[i], bi = bts[i];
#pragma unroll
            for (int nt = 0; nt < 4; ++nt) { const int j = 16 * nt + fr; const float dec = __expf(fminf(gi - gcs[j], 0.f));
                if (F.wave < 4) { const float lv = (j < i) ? bi * acc[nt][r] * dec : 0.f; Ln[i * 72 + j] = f2bf(-lv); if (nt == mt) Ld[(mt * 16 + 4 * fq + r) * 17 + fr] = lv; }
                else ATg[i * 64 + j] = f2bf((j <= i) ? acc[nt][r] * dec : 0.f); } }
    }
    LDS_WAIT(); __syncthreads();
    if (F.wave == 0) {
        const int blk = fq, c = fr;
        float t[16];
#pragma unroll
        for (int i = 0; i < 16; ++i) { float s = (i == c) ? 1.f : 0.f;
#pragma unroll
            for (int j = 0; j < i; ++j) s -= Ld[(blk * 16 + i) * 17 + j] * t[j];
            t[i] = s; }
#pragma unroll
        for (int i = 0; i < 16; ++i) Ti[(16 * blk + i) * 24 + c] = f2bf(t[i]);
    } else {
        bf16_t* KETg = (bf16_t*)(F.ws + WS_KET) + (size_t)slot * 128 * 64;
        const float glast = gcs[63];
        for (int idx = F.tid - 64; idx < 128 * 8; idx += NTHREADS - 64) {
            const int d = idx >> 3, gp = idx & 7;
            const u32x4 v = *(const LAS u32x4*)(kT + tsw(d, 8 * gp)); u32x4 w;
#pragma unroll
            for (int i = 0; i < 4; ++i) w[i] = cvt_pk_bf16(bflo(v[i]) * __expf(glast - gcs[8 * gp + 2 * i]), bfhi(v[i]) * __expf(glast - gcs[8 * gp + 2 * i + 1]));
            *(u32x4*)(KETg + d * 64 + 8 * gp) = w;
        }
        if (F.tid == 64) ((float*)(F.ws + WS_GLAST))[slot] = __expf(glast);
    }
    LDS_WAIT(); __syncthreads();
    {
        bf16_t* Og = (bf16_t*)(F.ws + (F.wave < 4 ? WS_UC : WS_WC)) + (size_t)slot * 64 * 128;
        const int ncol0 = (F.wave & 3) * 32;
        const bf16x8 zf = (bf16x8){0, 0, 0, 0, 0, 0, 0, 0};
#pragma unroll
        for (int bb = 0; bb < 4; ++bb) {
            f32x4 acc[2];
#pragma unroll
            for (int t = 0; t < 2; ++t) { const u32x2 rv = *(const LAS u32x2*)(XT + tsw(32 * F.wave + 16 * t + fr, 16 * bb + 4 * fq));
                acc[t] = (f32x4){bflo(rv.x), bfhi(rv.x), bflo(rv.y), bfhi(rv.y)}; }
            if (bb >= 1) {
#pragma unroll
                for (int kk = 0; kk < 2; ++kk) if (32 * kk < 16 * bb) {
                    bf16x8 af = *(const LAS bf16x8*)(Ln + (16 * bb + fr) * 72 + 32 * kk + 8 * fq);
                    if (32 * kk + 8 * fq >= 16 * bb) af = zf;
#pragma unroll
                    for (int t = 0; t < 2; ++t) { const bf16x8 bfr = *(const LAS bf16x8*)(XT + tsw(32 * F.wave + 16 * t + fr, 32 * kk + 8 * fq)); acc[t] = MFMA16(af, bfr, acc[t]); }
                }
            }
#pragma unroll
            for (int t = 0; t < 2; ++t) { u32x2 w; w.x = cvt_pk_bf16(acc[t][0], acc[t][1]); w.y = cvt_pk_bf16(acc[t][2], acc[t][3]); *(LAS u32x2*)(YT + (16 * t + fr) * 24 + 4 * fq) = w; }
            LDS_WAIT();
            bf16x8 a2 = *(const LAS bf16x8*)(Ti + (16 * bb + fr) * 24 + 8 * (fq & 1));
            if (fq >= 2) a2 = zf;
#pragma unroll
            for (int t = 0; t < 2; ++t) { bf16x8 b2 = *(const LAS bf16x8*)(YT + (16 * t + fr) * 24 + 8 * (fq & 1)); if (fq >= 2) b2 = zf;
                f32x4 x = MFMA16(a2, b2, ((f32x4){0.f, 0.f, 0.f, 0.f}));
                u32x2 w; w.x = cvt_pk_bf16(x[0], x[1]); w.y = cvt_pk_bf16(x[2], x[3]);
                *(LAS u32x2*)(XT + tsw(32 * F.wave + 16 * t + fr, 16 * bb + 4 * fq)) = w;
                if (F.wave < 4) *(u32x2*)(Og + (ncol0 + 16 * t + fr) * 64 + 16 * bb + 4 * fq) = w;
                else {
#pragma unroll
                    for (int r = 0; r < 4; ++r) Og[(16 * bb + 4 * fq + r) * 128 + ncol0 + 16 * t + fr] = f2bf(x[r]); } }
            LDS_WAIT();
        }
    }
    LDS_WAIT(); __syncthreads();
}

constexpr int SC_WC = 0, SC_QD = 17408, SC_AT = 34816, SC_KE = 44032, SC_UC = 62464, SC_GL = 66560, SC_BUF = 66816;
constexpr int SC_ST = 2 * SC_BUF, SC_SLICE = 6656  , SC_OT = SC_ST + 2 * SC_SLICE;
static_assert(SC_OT + 8192 <= RING_BYTES, "scan LDS map");
constexpr int SC_NLD = 384;
struct ScanRegs { u32x4 w[3], q[3], k[3], a[2], u; float gl; };
__device__ __forceinline__ void scan_load(const Frame& F, ScanRegs& R, size_t cu, int sp, int lt) {
    const unsigned char* wc = F.ws + WS_WC + cu * 16384; const unsigned char* qd = F.ws + WS_QD + cu * 16384; const unsigned char* ke = F.ws + WS_KET + cu * 16384;
    const unsigned char* at = F.ws + WS_AT + cu * 8192; const unsigned char* uc = F.ws + WS_UC + cu * 16384 + (size_t)sp * 4096;
    const unsigned o = (unsigned)lt * 16u;
#pragma unroll
    for (int i = 0; i < 3; ++i) if (i < 2 || lt < 256) { R.w[i] = *(const u32x4*)(wc + o + i * (SC_NLD * 16)); R.q[i] = *(const u32x4*)(qd + o + i * (SC_NLD * 16)); R.k[i] = *(const u32x4*)(ke + o + i * (SC_NLD * 16)); }
    R.a[0] = *(const u32x4*)(at + o); if (lt < 128) R.a[1] = *(const u32x4*)(at + o + SC_NLD * 16);
    if (lt < 256) R.u = *(const u32x4*)(uc + o);
    R.gl = ((const float*)(F.ws + WS_GLAST))[cu];
}
__device__ __forceinline__ void scan_store(LAS unsigned char* buf, const ScanRegs& R, int lt) {
    if (lt == 0) *(LAS float*)(buf + SC_GL) = R.gl;
    const int d16 = ((lt >> 4) * 136 + (lt & 15) * 8) * 2;
    const int d8 = ((lt >> 3) * 72 + (lt & 7) * 8) * 2;
#pragma unroll
    for (int i = 0; i < 3; ++i) if (i < 2 || lt < 256) { *(LAS u32x4*)(buf + SC_WC + d16 + i * (24 * 136 * 2)) = R.w[i]; *(LAS u32x4*)(buf + SC_QD + d16 + i * (24 * 136 * 2)) = R.q[i]; *(LAS u32x4*)(buf + SC_KE + d8 + i * (48 * 72 * 2)) = R.k[i]; }
    *(LAS u32x4*)(buf + SC_AT + d8) = R.a[0]; if (lt < 128) *(LAS u32x4*)(buf + SC_AT + d8 + 48 * 72 * 2) = R.a[1];
    if (lt < 256) *(LAS u32x4*)(buf + SC_UC + lt * 16) = R.u;
}
__device__ __forceinline__ void scan_out(const Frame& F, int b, int h, int sp, int nn, int lt) {
    bf16_t* Og = (bf16_t*)(F.ws + WS_O);
    const int pos = lt >> 2, e4 = (lt & 3) * 4;
#pragma unroll
    for (int j = 0; j < 2; ++j) { const LAS bf16_t* OT = (const LAS bf16_t*)(F.lds + SC_OT + ((nn & 1) * 2 + j) * 2048);
        u32x2 w; w.x = (unsigned)OT[e4 * 64 + pos] | ((unsigned)OT[(e4 + 1) * 64 + pos] << 16); w.y = (unsigned)OT[(e4 + 2) * 64 + pos] | ((unsigned)OT[(e4 + 3) * 64 + pos] << 16);
        *(u32x2*)(Og + ((size_t)b * SEQ + (size_t)nn * DNC + pos) * 512 + h * HD + 16 * (2 * sp + j) + e4) = w; }
}
__device__ __forceinline__ void dn_scan(const Frame& F, int item) {
    const int bh = item >> 2, sp = item & 3, h = bh & 3, b = bh >> 2;
    const int cj = F.wave & 1;
    LAS bf16_t* ST = (LAS bf16_t*)(F.lds + SC_ST + cj * SC_SLICE); LAS bf16_t* VT = (LAS bf16_t*)(F.lds + SC_ST + cj * SC_SLICE + 4352);
    const int fr = F.lane & 15, fq = F.lane >> 4;
    f32x4 S[8];
#pragma unroll
    for (int mt = 0; mt < 8; ++mt) S[mt] = (f32x4){0.f, 0.f, 0.f, 0.f};
    if (F.wave < 2) {
#pragma unroll
        for (int mt = 0; mt < 8; ++mt) *(LAS u32x2*)(ST + fr * 136 + 16 * mt + 4 * fq) = (u32x2){0u, 0u};
    }
    ScanRegs R;
    if (F.wave >= 2) { scan_load(F, R, (size_t)dn_slot(bh, 0), sp, F.tid - 128); scan_store(F.lds, R, F.tid - 128);
                       scan_load(F, R, (size_t)dn_slot(bh, 1), sp, F.tid - 128); }
    LDS_WAIT(); __syncthreads();
#pragma unroll 1
    for (int n = 0; n < NCH; ++n) {
        LAS unsigned char* buf = F.lds + (n & 1) * SC_BUF;
        if (F.wave >= 2) {
            if (n + 1 < NCH) scan_store(F.lds + ((n + 1) & 1) * SC_BUF, R, F.tid - 128);
            if (n + 2 < NCH) scan_load(F, R, (size_t)dn_slot(bh, n + 2), sp, F.tid - 128);
            if (n >= 1 && F.tid < 384) scan_out(F, b, h, sp, n - 1, F.tid - 128);
        } else {
            const LAS bf16_t* wc = (const LAS bf16_t*)(buf + SC_WC); const LAS bf16_t* qd = (const LAS bf16_t*)(buf + SC_QD); const LAS bf16_t* at = (const LAS bf16_t*)(buf + SC_AT);
            const LAS bf16_t* ke = (const LAS bf16_t*)(buf + SC_KE); const LAS bf16_t* uc = (const LAS bf16_t*)(buf + SC_UC) + cj * 1024;
            bf16x8 sb[4];
#pragma unroll
            for (int kk = 0; kk < 4; ++kk) sb[kk] = *(const LAS bf16x8*)(ST + fr * 136 + 32 * kk + 8 * fq);
            f32x4 vn[4], oo[4];
#pragma unroll
            for (int hf = 0; hf < 2; ++hf) {
                bf16x8 aw[2][4], aq[2][4];
#pragma unroll
                for (int m2 = 0; m2 < 2; ++m2)
#pragma unroll
                    for (int kk = 0; kk < 4; ++kk) { aw[m2][kk] = *(const LAS bf16x8*)(wc + (16 * (2 * hf + m2) + fr) * 136 + 32 * kk + 8 * fq); aq[m2][kk] = *(const LAS bf16x8*)(qd + (16 * (2 * hf + m2) + fr) * 136 + 32 * kk + 8 * fq); }
                __builtin_amdgcn_sched_barrier(0);
#pragma unroll
                for (int m2 = 0; m2 < 2; ++m2) { const int mt = 2 * hf + m2; vn[mt] = (f32x4){0.f, 0.f, 0.f, 0.f}; oo[mt] = (f32x4){0.f, 0.f, 0.f, 0.f}; }
#pragma unroll
                for (int kk = 0; kk < 4; ++kk)
#pragma unroll
                    for (int m2 = 0; m2 < 2; ++m2) { const int mt = 2 * hf + m2; vn[mt] = MFMA16(aw[m2][kk], sb[kk], vn[mt]); oo[mt] = MFMA16(aq[m2][kk], sb[kk], oo[mt]); }
                __builtin_amdgcn_sched_barrier(0);
            }
            u32x2 uvv[4];
#pragma unroll
            for (int mt = 0; mt < 4; ++mt) uvv[mt] = *(const LAS u32x2*)(uc + fr * 64 + 16 * mt + 4 * fq);
            __builtin_amdgcn_sched_barrier(0);
#pragma unroll
            for (int mt = 0; mt < 4; ++mt) { const u32x2 uv = uvv[mt];
                vn[mt][0] = bflo(uv.x) - vn[mt][0]; vn[mt][1] = bfhi(uv.x) - vn[mt][1]; vn[mt][2] = bflo(uv.y) - vn[mt][2]; vn[mt][3] = bfhi(uv.y) - vn[mt][3];
                u32x2 w; w.x = cvt_pk_bf16(vn[mt][0], vn[mt][1]); w.y = cvt_pk_bf16(vn[mt][2], vn[mt][3]);
                *(LAS u32x2*)(VT + fr * 72 + 16 * mt + 4 * fq) = w; }
            LDS_WAIT();
            bf16x8 vb[2];
#pragma unroll
            for (int kk = 0; kk < 2; ++kk) vb[kk] = *(const LAS bf16x8*)(VT + fr * 72 + 32 * kk + 8 * fq);
            bf16x8 aa[4][2];
#pragma unroll
            for (int mt = 0; mt < 4; ++mt)
#pragma unroll
                for (int kk = 0; kk < 2; ++kk) aa[mt][kk] = *(const LAS bf16x8*)(at + (16 * mt + fr) * 72 + 32 * kk + 8 * fq);
            bf16x8 ak[8][2];
#pragma unroll
            for (int mt = 0; mt < 4; ++mt)
#pragma unroll
                for (int kk = 0; kk < 2; ++kk) ak[mt][kk] = *(const LAS bf16x8*)(ke + (16 * mt + fr) * 72 + 32 * kk + 8 * fq);
            const float dec = *(const LAS float*)(buf + SC_GL);
            __builtin_amdgcn_sched_barrier(0);
#pragma unroll
            for (int mt = 0; mt < 4; ++mt) {
#pragma unroll
                for (int kk = 0; kk < 2; ++kk) oo[mt] = MFMA16(aa[mt][kk], vb[kk], oo[mt]); }
#pragma unroll
            for (int mt = 4; mt < 8; ++mt)
#pragma unroll
                for (int kk = 0; kk < 2; ++kk) ak[mt][kk] = *(const LAS bf16x8*)(ke + (16 * mt + fr) * 72 + 32 * kk + 8 * fq);
            __builtin_amdgcn_sched_barrier(0);
#pragma unroll
            for (int mt = 0; mt < 8; ++mt) { S[mt] = S[mt] * dec;
#pragma unroll
                for (int kk = 0; kk < 2; ++kk) S[mt] = MFMA16(ak[mt][kk], vb[kk], S[mt]); }
            __builtin_amdgcn_sched_barrier(0);
#pragma unroll
            for (int mt = 0; mt < 8; ++mt) { u32x2 w; w.x = cvt_pk_bf16(S[mt][0], S[mt][1]); w.y = cvt_pk_bf16(S[mt][2], S[mt][3]);
                *(LAS u32x2*)(ST + fr * 136 + 16 * mt + 4 * fq) = w; }
            LAS bf16_t* OT = (LAS bf16_t*)(F.lds + SC_OT + ((n & 1) * 2 + cj) * 2048);
#pragma unroll
            for (int mt = 0; mt < 4; ++mt) { u32x2 w; w.x = cvt_pk_bf16(oo[mt][0], oo[mt][1]); w.y = cvt_pk_bf16(oo[mt][2], oo[mt][3]); *(LAS u32x2*)(OT + fr * 64 + 16 * mt + 4 * fq) = w; }
        }
        LDS_WAIT(); __builtin_amdgcn_s_barrier(); asm volatile("" ::: "memory");
    }
    if (F.tid >= 128 && F.tid < 384) scan_out(F, b, h, sp, NCH - 1, F.tid - 128);
    LDS_WAIT(); __syncthreads();
}
__device__ __forceinline__ void convert_experts(const Frame& F, const Args& a, int cw, int nw) {
    LAS float* scr = (LAS float*)(F.lds + F.wave * 16896);
    const float* w_gu = a.in[14]; const float* w_dn = a.in[16]; unsigned char* WGU = F.ws + WS_WGU; unsigned char* WDN = F.ws + WS_WDN;
    constexpr int I_GU = NE * 8 * 64, I_DN = NE * 8 * 32;
    for (int it = cw; it < I_GU + I_DN; it += nw) {
        int r = it;
        if (r < I_GU) { const int e = r / 512, q = r % 512, kb = q / 64, nb = q % 64; const int c0 = 32 * nb, j = c0 & 1023, drow = (j >> 7) * 256 + (c0 >= 1024 ? 128 : 0) + (j & 127);
            tr_item8(w_gu + (size_t)e * 1024 * 2048 + (size_t)(128 * kb) * 2048 + c0, 2048, WGU + (size_t)e * 2048 * 1024 + (size_t)drow * 1024 + 128 * kb, scr, F.lane); continue; } r -= I_GU;
        { const int e = r / 256, q = r % 256, kb = q / 32, nb = q % 32;
            tr_item8(w_dn + (size_t)e * 1024 * 1024 + (size_t)(128 * kb) * 1024 + 32 * nb, 1024, WDN + (size_t)e * 1024 * 1024 + (size_t)(32 * nb) * 1024 + 128 * kb, scr, F.lane); }
    }
}

__device__ __forceinline__ void dn_out(const Frame& F, const Args& a) {
    const int gw = F.vcu * NWAVES + F.wave, NGW = F.G * NWAVES;
    const bf16_t* Og = (const bf16_t*)(F.ws + WS_O); const bf16_t* PROJ = (const bf16_t*)(F.ws + WS_R3); bf16_t* MIX = (bf16_t*)(F.ws + WS_MIX);
    const float* ng = a.in[9] + 8 * (F.lane & 15);
    const f32x4 g0 = *(const f32x4*)ng, g1 = *(const f32x4*)(ng + 4);
    for (int m = gw; m < T; m += NGW) {
        const u32x4 ow = *(const u32x4*)(Og + (size_t)m * 512 + 8 * F.lane);
        f32x4 o0 = (f32x4){bflo(ow[0]), bfhi(ow[0]), bflo(ow[1]), bfhi(ow[1])}, o1 = (f32x4){bflo(ow[2]), bfhi(ow[2]), bflo(ow[3]), bfhi(ow[3])};
        const u32x4 z = *(const u32x4*)(PROJ + (size_t)m * NPROJ + 2560 + 8 * F.lane);
        float ss = (o0[0] * o0[0] + o0[1] * o0[1]) + (o0[2] * o0[2] + o0[3] * o0[3]) + (o1[0] * o1[0] + o1[1] * o1[1]) + (o1[2] * o1[2] + o1[3] * o1[3]);
#pragma unroll
        for (int o = 1; o < 16; o <<= 1) ss += __shfl_xor(ss, o);
        const float rstd = rsqrtf(ss * (1.0f / HD) + EPS);
        o0 = o0 * rstd * g0; o1 = o1 * rstd * g1;
        u32x4 w; w.x = cvt_pk_bf16(o0[0] * silu_f(bflo(z[0])), o0[1] * silu_f(bfhi(z[0]))); w.y = cvt_pk_bf16(o0[2] * silu_f(bflo(z[1])), o0[3] * silu_f(bfhi(z[1])));
        w.z = cvt_pk_bf16(o1[0] * silu_f(bflo(z[2])), o1[1] * silu_f(bfhi(z[2]))); w.w = cvt_pk_bf16(o1[2] * silu_f(bflo(z[3])), o1[3] * silu_f(bfhi(z[3])));
        *(u32x4*)(MIX + (size_t)m * D + 512 + 8 * F.lane) = w;
    }
}

constexpr int RT_PITCH = 1032;
__device__ __forceinline__ void route(const Frame& F, const Args& a) {
    const int gw = F.vcu * NWAVES + F.wave, NGW = F.G * NWAVES;
    const bf16_t* HB = (const bf16_t*)(F.ws + WS_H); const bf16_t* RWT = (const bf16_t*)(F.ws + WS_RWT); const float* rb = a.in[13]; const float* g2 = a.in[11];
    int* EIDX = (int*)(F.ws + WS_EIDX); float* GATEW = (float*)(F.ws + WS_GATEW); int* EPOS = (int*)(F.ws + WS_EPOS);
    unsigned* cnt = (unsigned*)(F.ws + WS_CTL) + CW_CNT;
    LAS bf16_t* tl = (LAS bf16_t*)(F.lds + F.wave * 17664); LAS float* lg = (LAS float*)(F.lds + F.wave * 17664 + 16512);
    LAS unsigned* lcnt = (LAS unsigned*)(F.lds + 8 * 17664);
    if (F.tid < 64) lcnt[F.tid] = 0u;
    LDS_WAIT(); __syncthreads();
    const int fr = F.lane & 15, fq = F.lane >> 4;
    f32x4 gv[4];
#pragma unroll
    for (int j = 0; j < 4; ++j) gv[j] = *(const f32x4*)(g2 + 4 * F.lane + 256 * j);
    for (int batch = gw; batch < T / 8; batch += NGW) {
        const size_t r0 = (size_t)batch * 8;
        u32x2 raw[8][4];
#pragma unroll
        for (int row = 0; row < 8; ++row)
#pragma unroll
            for (int j = 0; j < 4; ++j) raw[row][j] = ((const u32x2*)(HB + (r0 + row) * D))[F.lane + 64 * j];
#pragma unroll
        for (int row = 0; row < 8; ++row) {
            f32x4 v[4]; float ss = 0.f;
#pragma unroll
            for (int j = 0; j < 4; ++j) { v[j] = (f32x4){bflo(raw[row][j].x), bfhi(raw[row][j].x), bflo(raw[row][j].y), bfhi(raw[row][j].y)}; ss += (v[j][0] * v[j][0] + v[j][1] * v[j][1]) + (v[j][2] * v[j][2] + v[j][3] * v[j][3]); }
            const float rstd = rsqrtf(wave_sum(ss) * (1.0f / D) + EPS);
            unsigned* y8 = (unsigned*)(F.ws + WS_HN8 + (r0 + row) * D) + F.lane;
#pragma unroll
            for (int j = 0; j < 4; ++j) { const f32x4 y = v[j] * rstd * gv[j]; y8[64 * j] = cvt4_fp8(y[0], y[1], y[2], y[3]);
                u32x2 w; w.x = cvt_pk_bf16(y[0], y[1]); w.y = cvt_pk_bf16(y[2], y[3]); *(LAS u32x2*)(tl + row * RT_PITCH + 4 * F.lane + 256 * j) = w; }
        }
        LDS_WAIT();
        f32x4 acc0 = (f32x4){0.f, 0.f, 0.f, 0.f}, acc1 = acc0;
#pragma unroll 4
        for (int kk = 0; kk < 32; ++kk) {
            const bf16x8 af = *(const LAS bf16x8*)(tl + (fr & 7) * RT_PITCH + 32 * kk + 8 * fq);
            const bf16x8 b0 = *(const bf16x8*)(RWT + (size_t)fr * D + 32 * kk + 8 * fq), b1 = *(const bf16x8*)(RWT + (size_t)(16 + fr) * D + 32 * kk + 8 * fq);
            acc0 = MFMA16(af, b0, acc0); acc1 = MFMA16(af, b1, acc1);
        }
        const float bb0 = rb[fr], bb1 = rb[16 + fr];
        if (fq < 2) {
#pragma unroll
            for (int r = 0; r < 4; ++r) { lg[(4 * fq + r) * 36 + fr] = acc0[r] + bb0; lg[(4 * fq + r) * 36 + 16 + fr] = acc1[r] + bb1; } }
        LDS_WAIT();
        if (F.lane < 8) {
            const int row = F.lane; const size_t t = r0 + row;
            float v[32];
#pragma unroll
            for (int q = 0; q < 8; ++q) { const f32x4 x = *(const LAS f32x4*)(lg + row * 36 + 4 * q); v[4 * q] = x[0]; v[4 * q + 1] = x[1]; v[4 * q + 2] = x[2]; v[4 * q + 3] = x[3]; }
            float tv[4]; int ti[4];
#pragma unroll
            for (int k = 0; k < 4; ++k) { float best = -3.0e38f; int bi = 0;
#pragma unroll
                for (int e = 0; e < 32; ++e) { if (v[e] > best) { best = v[e]; bi = e; } }
                tv[k] = best; ti[k] = bi;
#pragma unroll
                for (int e = 0; e < 32; ++e) v[e] = (e == bi) ? -3.0e38f : v[e]; }
            const float e1 = __expf(tv[1] - tv[0]), e2 = __expf(tv[2] - tv[0]), e3 = __expf(tv[3] - tv[0]); const float inv = 1.0f / (1.0f + e1 + e2 + e3);
            const float gk[4] = {inv, e1 * inv, e2 * inv, e3 * inv};
#pragma unroll
            for (int k = 0; k < 4; ++k) {
                const unsigned pos = __hip_atomic_fetch_add(lcnt + ti[k], 1u, __ATOMIC_RELAXED, __HIP_MEMORY_SCOPE_WORKGROUP);
                EIDX[t * 4 + k] = ti[k]; GATEW[t * 4 + k] = gk[k]; EPOS[t * 4 + k] = (int)pos;
            }
        }
        LDS_WAIT();
    }
    VM_WAIT(); LDS_WAIT(); __syncthreads();
    if (F.tid < NE) { const unsigned c = lcnt[F.tid]; lcnt[32 + F.tid] = c ? __hip_atomic_fetch_add(cnt + 64 * F.tid, c, __ATOMIC_RELAXED, __HIP_MEMORY_SCOPE_AGENT) : 0u; }
    LDS_WAIT(); __syncthreads();
    for (int batch = gw; batch < T / 8; batch += NGW) if (F.lane < 32) { const size_t a0 = (size_t)batch * 32 + F.lane; EPOS[a0] += (int)lcnt[32 + EIDX[a0]]; }
}

constexpr int TB_OFF = 131072;
__device__ __forceinline__ void build_tables(const Frame& F) {
    LAS int* pst = (LAS int*)(F.lds + TB_OFF); LAS int* cn = pst + 40; LAS int* tile_e = pst + 80;
    const unsigned* cnt = (const unsigned*)(F.ws + WS_CTL) + CW_CNT;
    if (F.tid < 64) {
        const int e = F.lane & 31; const int c = (int)__hip_atomic_load(cnt + 64 * e, __ATOMIC_RELAXED, __HIP_MEMORY_SCOPE_AGENT);
        const int padded = (c + 255) & ~255;
        int incl = padded;
#pragma unroll
        for (int o = 1; o < 32; o <<= 1) { const int t = __shfl_up(incl, o); if (e >= o) incl += t; }
        if (F.lane < 32) { pst[e] = incl - padded; cn[e] = c; if (e == 31) pst[32] = incl;
            for (int j = 0; j < padded / 256; ++j) tile_e[(incl - padded) / 256 + j] = e; }
    }
    LDS_WAIT(); __syncthreads();
}

__device__ __forceinline__ void gather_rows(const Frame& F) {
    const int gw = F.vcu * NWAVES + F.wave, NGW = F.G * NWAVES;
    LAS int* pst = (LAS int*)(F.lds + TB_OFF); LAS int* cn = pst + 40; LAS int* tile_e = pst + 80;
    const unsigned char* HN8 = F.ws + WS_HN8; unsigned char* XS = F.ws + WS_R3;
    const int* EIDX = (const int*)(F.ws + WS_EIDX); const int* EPOS = (const int*)(F.ws + WS_EPOS); const float* GATEW = (const float*)(F.ws + WS_GATEW); float* GSORT = (float*)(F.ws + WS_GSORT); int* ROWOF = (int*)(F.ws + WS_ROWOF);
    const int rtot = pst[32];
    for (int tl = gw; tl < (rtot >> 8); tl += NGW) { const int e = tile_e[tl], first = pst[e] + cn[e], lo = tl << 8;
        for (int R = (first > lo ? first : lo); R < lo + 256; ++R) { *((u32x4*)(XS + (size_t)R * D) + F.lane) = (u32x4){0u, 0u, 0u, 0u}; if (F.lane == 0) GSORT[R] = 0.f; } }
    for (int t0 = gw * 4; t0 < T; t0 += NGW * 4) {
        int Rl = 0;
        if (F.lane < 16) { const int a = t0 * 4 + F.lane; const int e = EIDX[a]; Rl = pst[e] + EPOS[a]; ROWOF[a] = Rl; GSORT[Rl] = GATEW[a]; }
        u32x4 v[4];
#pragma unroll
        for (int j = 0; j < 4; ++j) v[j] = *((const u32x4*)(HN8 + (size_t)(t0 + j) * D) + F.lane);
#pragma unroll
        for (int j = 0; j < 4; ++j)
#pragma unroll
            for (int k = 0; k < 4; ++k) { const int R = __builtin_amdgcn_readlane(Rl, 4 * j + k); *((u32x4*)(XS + (size_t)R * D) + F.lane) = v[j]; }
    }
}

__device__ __forceinline__ void combine(const Frame& F, const Args& a) {
    const int gw = F.vcu * NWAVES + F.wave, NGW = F.G * NWAVES;
    const bf16_t* H = (const bf16_t*)(F.ws + WS_H); const unsigned char* YS = F.ws + WS_YS; const int* ROWOF = (const int*)(F.ws + WS_ROWOF); const float* gf = a.in[18];
    f32x4 gv[4];
#pragma unroll
    for (int j = 0; j < 4; ++j) gv[j] = *(const f32x4*)(gf + 4 * F.lane + 256 * j);
    for (int m = gw; m < T; m += NGW) {
        const u32x2* xr = (const u32x2*)(H + (size_t)m * D) + F.lane;
        f32x4 v[4];
#pragma unroll
        for (int j = 0; j < 4; ++j) { const u32x2 hw = xr[64 * j]; v[j] = (f32x4){bflo(hw.x), bfhi(hw.x), bflo(hw.y), bfhi(hw.y)}; }
#if !defined(DBG_SKIP_MOE)
#pragma unroll
        for (int k = 0; k < 4; ++k) { const int R = ROWOF[m * 4 + k]; const int* yr = (const int*)(YS + (size_t)R * D) + F.lane;
#pragma unroll
            for (int j = 0; j < 4; ++j) { const int w = yr[64 * j]; const f32x2 lo = __builtin_amdgcn_cvt_pk_f32_fp8(w, false), hi = __builtin_amdgcn_cvt_pk_f32_fp8(w, true);
                v[j][0] += lo.x; v[j][1] += lo.y; v[j][2] += hi.x; v[j][3] += hi.y; } }
#endif
        float ss = 0.f;
#pragma unroll
        for (int j = 0; j < 4; ++j) ss += (v[j][0] * v[j][0] + v[j][1] * v[j][1]) + (v[j][2] * v[j][2] + v[j][3] * v[j][3]);
        const float rstd = rsqrtf(wave_sum(ss) * (1.0f / D) + EPS);
        f32x4* o = (f32x4*)(a.out + (size_t)m * D) + F.lane;
#pragma unroll
        for (int j = 0; j < 4; ++j) o[64 * j] = v[j] * rstd * gv[j];
    }
}

__device__ __forceinline__ void dbg_dump(const Frame& F, const Args& a, int what) {
    const int gw = F.vcu * NWAVES + F.wave, NGW = F.G * NWAVES;
    for (int m = gw; m < T; m += NGW) {
        for (int c = F.lane; c < D; c += 64) {
            float v = 0.f;
            if (what == 1) v = bf2f(((const bf16_t*)(F.ws + WS_R3))[(size_t)m * NPROJ + c]);
            else if (what == 2) v = bf2f(((const bf16_t*)(F.ws + WS_MIX))[(size_t)m * D + c]);
            else if (what == 3) v = ((const float*)(F.ws + WS_O))[(size_t)m * 512 + (c & 511)];
            else if (what == 4) v = ((const float*)(F.ws + WS_H))[(size_t)m * D + c];
            else if (what == 5) v = bf2f(((const bf16_t*)(F.ws + WS_R3))[(size_t)m * NPROJ + 1024 + c]);
            else if (what == 6) v = bf2f(((const bf16_t*)(F.ws + WS_R3))[(size_t)m * NPROJ + 2048 + c]);
            else if (what == 7) v = bf2f(((const bf16_t*)(F.ws + WS_Y))[(size_t)m * D + c]);
            else if (what == 9) v = bf2f(((const bf16_t*)(F.ws + WS_WC))[((size_t)m * D + c) & 0xFFFFFF]);
            else if (what == 10) v = bf2f(((const bf16_t*)(F.ws + WS_UC))[((size_t)m * D + c) & 0xFFFFFF]);
            else if (what == 11) v = bf2f(((const bf16_t*)(F.ws + WS_QD))[((size_t)m * D + c) & 0xFFFFFF]);
            else if (what == 12) v = bf2f(((const bf16_t*)(F.ws + WS_KET))[((size_t)m * D + c) & 0xFFFFFF]);
            else if (what == 13) v = bf2f(((const bf16_t*)(F.ws + WS_AT))[((size_t)m * D + c) & 0x7FFFFF]);
            else if (what == 14) v = ((const float*)(F.ws + WS_AB))[(size_t)m * 8 + (c & 7)];
            else if (what == 8) v = bf2f(((const bf16_t*)(F.ws + WS_MIX))[(size_t)m * D + (c & 511)]);
            if (!(v - v == 0.f)) v = 12345.f;
            a.out[(size_t)m * D + c] = v;
        }
    }
}

constexpr int NPHASES = 12;
__global__ void __launch_bounds__(NTHREADS, 2) fwd(Args args) {
    __shared__ __attribute__((aligned(16))) unsigned char lds_raw[LDS_BYTES];
    Frame F;
    F.lds = (LAS unsigned char*)lds_raw;
    F.tid = threadIdx.x; F.lane = F.tid & 63; F.wave = __builtin_amdgcn_readfirstlane(F.tid >> 6);
    F.G = gridDim.x; { const int bx = blockIdx.x; F.vcu = (F.G % 8 == 0) ? (bx % 8) * (F.G / 8) + bx / 8 : bx; }
    F.ws = args.ws;
    volatile LAS unsigned* MISC = (volatile LAS unsigned*)(F.lds + LDSCTL_OFF);
    for (int u = F.tid; u < (LDS_BYTES - LDSCTL_OFF) / 4; u += NTHREADS) MISC[u] = 0u;
    __syncthreads();
#if !MK_PER_PHASE
    XcdBarrier bar = xcd_barrier_post((unsigned*)(F.ws + WS_CTL) + CW_BAR, MISC + 8);
#define GRID_BAR() xcd_barrier(bar)
#else
#define GRID_BAR() do { } while (0)
#endif
    const int lo = args.ph_lo, hi = args.ph_hi;
#define IN(k) (lo <= (k) && (k) < hi)
#ifndef PROBE_DOUBLE
#define PROBE_DOUBLE (-1)
#endif
#define REP(k) for (int rep_ = 0; rep_ < ((PROBE_DOUBLE) == (k) ? 2 : 1); ++rep_)
#define SEAM(k) do { if (IN(k) && IN((k) + 1)) GRID_BAR(); } while (0)

    if (IN(0)) REP(0) { p0_prologue(F, args); } SEAM(0);
    if (IN(1)) REP(1) {
        pg8::Gemm g{(const bf16_t*)(F.ws + WS_Y), (const bf16_t*)(F.ws + WS_WIN), T, NPROJ, D}; pg8::StaticOrder S; S.init(T, NPROJ, F.G, (int)blockIdx.x);
        pg8::EpiProj E{(bf16_t*)(F.ws + WS_R3)};
        pg8::gemm_phase<pg8::EpiProj, pg8::StaticOrder>(F.lds, g, S, E);
    } SEAM(1);
    if (IN(2)) REP(2) {
        for (int u = F.vcu; u < NB * 32 * NH; u += F.G) gmlp_unit(F, args, u);
        if (F.vcu < NCHUNKS) {
            const int h0 = (F.vcu >> 6) & 3;
            DnPre P; int hcur = -1;
            dn_prefetch(F, P, F.vcu);
            for (int u = F.vcu; u < NCHUNKS; u += F.G) {
                const int hh = (u >> 6) & 3;
                if (hh != hcur) { __syncthreads(); for (int i = F.tid; i < 3 * 4 * 128; i += NTHREADS) { const int ten = i / 512, j = (i >> 7) & 3, c = i & 127; ((LAS float*)(F.lds + DN_CW))[i] = args.in[6][(size_t)j * 1536 + ten * 512 + hh * HD + c]; } hcur = hh; LDS_WAIT(); __syncthreads(); }
                dn_chunk(F, args, u, P, (u + F.G < NCHUNKS) ? u + F.G : -1);
            }
            (void)h0;
        }
    } SEAM(2);
    if (IN(3)) {
        const int bx = (int)blockIdx.x, nscan = F.G >= 2 ? F.G / 2 : 1;
        if (bx < nscan) {
            const int sid = (nscan % 8 == 0) ? (bx % 8) * (nscan / 8) + bx / 8 : bx;
            for (int it = sid; it < NB * NH * 4; it += nscan) dn_scan(F, it);
            if (F.G < 2) convert_experts(F, args, F.wave, NWAVES);
        } else convert_experts(F, args, (bx - nscan) * NWAVES + F.wave, (F.G - nscan) * NWAVES);
    } SEAM(3);
    if (IN(4)) REP(4) { dn_out(F, args); } SEAM(4);
    if (IN(5)) REP(5) {
        pg8::Gemm g{(const bf16_t*)(F.ws + WS_MIX), (const bf16_t*)(F.ws + WS_WOUT), T, D, D}; pg8::StaticOrder S; S.init(T, D, F.G, (int)blockIdx.x);
        pg8::EpiResid E{args.in[0], (bf16_t*)(F.ws + WS_H)};
        pg8::gemm_phase<pg8::EpiResid, pg8::StaticOrder>(F.lds, g, S, E);
    } SEAM(5);
    if (IN(6)) { route(F, args); } SEAM(6);
    if (IN(8)) { build_tables(F); REP(8) gather_rows(F); } SEAM(8);
    if (IN(9)) {
        if (!IN(8)) build_tables(F);
        const int rtot = ((LAS int*)(F.lds + TB_OFF))[32];
        REP(9) {
        pg8::Gemm g{(const bf16_t*)(F.ws + WS_R3), (const bf16_t*)(F.ws + WS_WGU), rtot, 2048, D / 2}; pg8::MoeOrder S; S.init(rtot, 2048, F.G, (int)blockIdx.x); S.tile_e = (const LAS int*)(F.lds + TB_OFF) + 80;
        pg8::EpiSwiglu E{F.ws + WS_R4, args.in[15]};
        pg8::gemm_phase<pg8::EpiSwiglu, pg8::MoeOrder, true>(F.lds, g, S, E);
        }
    } SEAM(9);
    if (IN(10)) {
        if (!IN(9)) build_tables(F);
        const int rtot = ((LAS int*)(F.lds + TB_OFF))[32];
        REP(10) {
        pg8::Gemm g{(const bf16_t*)(F.ws + WS_R4), (const bf16_t*)(F.ws + WS_WDN), rtot, D, DFF / 2}; pg8::MoeOrder S; S.init(rtot, D, F.G, (int)blockIdx.x); S.tile_e = (const LAS int*)(F.lds + TB_OFF) + 80;
        pg8::EpiDown E{F.ws + WS_YS, args.in[17], (const float*)(F.ws + WS_GSORT)};
        pg8::gemm_phase<pg8::EpiDown, pg8::MoeOrder, true>(F.lds, g, S, E);
        }
    } SEAM(10);
    if (IN(11)) REP(11) { combine(F, args); }
#if defined(DBG_DUMP)
    if (IN(12)) { dbg_dump(F, args, DBG_DUMP); }
#endif
#undef IN
#undef SEAM
}

extern "C" void kernel_launch(void* const* d_in, const int* in_sizes, int n_in, void* d_out, int out_size, void* d_ws, size_t ws_size, hipStream_t stream) {
    static int grid = 0;
    if (grid == 0) {
        if (n_in != 19 || out_size != T * D || ws_size < WS_END) { fprintf(stderr, "kernel_launch: unexpected shapes (n_in %d, out %d, ws %zu)\n", n_in, out_size, ws_size); grid = -1; return; }
        int dev = 0, cus = 0, per_cu = 0;
        if (hipGetDevice(&dev) != hipSuccess || hipDeviceGetAttribute(&cus, hipDeviceAttributeMultiprocessorCount, dev) != hipSuccess) { grid = -1; return; }
        if (hipOccupancyMaxActiveBlocksPerMultiprocessor(&per_cu, (const void*)fwd, NTHREADS, 0) != hipSuccess || per_cu < 1) fprintf(stderr, "kernel_launch: occupancy query reports %d\n", per_cu);
        (void)hipGetLastError();
        grid = cus;
    }
    if (grid < 0) return;
    (void)hipMemsetAsync((char*)d_ws + WS_CTL, 0, CTL_ZERO_BYTES, stream);
    Args a{};
    for (int i = 0; i < 19; ++i) a.in[i] = (const float*)d_in[i];
    a.out = (float*)d_out; a.ws = (unsigned char*)d_ws;
#if MK_PER_PHASE
    for (int p = 0; p < NPHASES; ++p) {
#if defined(DBG_DUMP)
        if (p > DBG_LAST) continue;
#endif
        a.ph_lo = p; a.ph_hi = p + 1; hipLaunchKernelGGL(fwd, dim3(grid), dim3(NTHREADS), 0, stream, a); }
#if defined(DBG_DUMP)
    a.ph_lo = 12; a.ph_hi = 13; hipLaunchKernelGGL(fwd, dim3(grid), dim3(NTHREADS), 0, stream, a);
#endif
#else
    a.ph_lo = 0; a.ph_hi = NPHASES; hipLaunchKernelGGL(fwd, dim3(grid), dim3(NTHREADS), 0, stream, a);
#endif
}
```

```cpp
#include <hip/hip_runtime.h>
#include <cstdio>
#include <cstdint>

#ifndef MK_PER_PHASE
#define MK_PER_PHASE 0
#endif

#define LAS __attribute__((address_space(3)))
#define GAS __attribute__((address_space(1)))
typedef unsigned short bf16_t;
typedef short bf16x8 __attribute__((ext_vector_type(8)));
typedef float f32x4 __attribute__((ext_vector_type(4)));
typedef float f32x2 __attribute__((ext_vector_type(2)));
typedef unsigned u32x4 __attribute__((ext_vector_type(4)));
typedef unsigned u32x2 __attribute__((ext_vector_type(2)));
typedef int i32x4 __attribute__((ext_vector_type(4)));
typedef int i32x8 __attribute__((ext_vector_type(8)));

constexpr int NB = 8, SEQ = 4096, D = 1024, T = NB * SEQ;
constexpr int DIN = 3080, NPROJ = 3072;
constexpr int NE = 32, TOPK = 4, DFF = 1024;
constexpr int NH = 4, HD = 128, GMC = 128, DNC = 64;
constexpr int NCH = SEQ / DNC;
constexpr int NCHUNKS = NB * NH * NCH;
constexpr int RMAX = T * TOPK + NE * 256;
constexpr float EPS = 1e-6f;
constexpr int NWAVES = 8, NTHREADS = 512;

constexpr size_t MiB = 1u << 20;
constexpr size_t WS_CTL = 0, CTL_ZERO_BYTES = 32768;
constexpr size_t WS_AB = 1 * MiB;
constexpr size_t WS_EIDX = 2 * MiB;
constexpr size_t WS_GATEW = 2 * MiB + 512 * 1024;
constexpr size_t WS_ROWOF = 3 * MiB;
constexpr size_t WS_EPOS = 3 * MiB + 512 * 1024;
constexpr size_t WS_GSORT = 4 * MiB;
constexpr size_t WS_LIST = 5 * MiB;
constexpr size_t WS_RWT = 9 * MiB;
constexpr size_t WS_GLAST = 10 * MiB;
constexpr size_t WS_WIN = 16 * MiB;
constexpr size_t WS_WOUT = 22 * MiB;
constexpr size_t WS_WGU = 24 * MiB;
constexpr size_t WS_WDN = 152 * MiB;
constexpr size_t WS_HN8 = 88 * MiB;
constexpr size_t WS_H = 216 * MiB;
constexpr size_t WS_R3 = 344 * MiB;
constexpr size_t WS_R4 = 616 * MiB;
constexpr size_t WS_Y = WS_R4;
constexpr size_t WS_WC = WS_R4;
constexpr size_t WS_UC = WS_R4 + 32 * MiB;
constexpr size_t WS_QD = WS_R4 + 64 * MiB;
constexpr size_t WS_KET = WS_R4 + 96 * MiB;
constexpr size_t WS_AT = WS_R4 + 128 * MiB;
constexpr size_t WS_MIX = WS_R4 + 144 * MiB;
constexpr size_t WS_O = WS_R4 + 208 * MiB;
constexpr size_t WS_HN = 888 * MiB;
constexpr size_t WS_YS = WS_R3 + 136 * MiB;
constexpr size_t WS_END = 952 * MiB;
constexpr int CW_BAR = 0;
constexpr int CW_CNT = 4096;

constexpr int RING_BYTES = 155648;
constexpr int LDSCTL_OFF = RING_BYTES;
constexpr int LDS_BYTES = RING_BYTES + 1024;

#define LDS_WAIT() asm volatile("s_waitcnt lgkmcnt(0)" ::: "memory")
#define VM_WAIT() asm volatile("s_waitcnt vmcnt(0)" ::: "memory")
typedef __bf16 bf16x2_t __attribute__((ext_vector_type(2)));
__device__ __forceinline__ unsigned cvt_pk_bf16(float lo, float hi) { const bf16x2_t r = __builtin_convertvector((f32x2){lo, hi}, bf16x2_t); return __builtin_bit_cast(unsigned, r); }
__device__ __forceinline__ float bf2f(unsigned short b) { return __uint_as_float(((unsigned)b) << 16); }
__device__ __forceinline__ float bflo(unsigned w) { return __uint_as_float(w << 16); }
__device__ __forceinline__ float bfhi(unsigned w) { return __uint_as_float(w & 0xffff0000u); }
__device__ __forceinline__ bf16_t f2bf(float f) { return (bf16_t)(cvt_pk_bf16(f, 0.f) & 0xffffu); }
__device__ __forceinline__ unsigned cvt4_fp8(float a, float b, float c, float d) { int r = __builtin_amdgcn_cvt_pk_fp8_f32(a, b, 0, false); r = __builtin_amdgcn_cvt_pk_fp8_f32(c, d, r, true); return (unsigned)r; }
constexpr float W8_SCALE = 32.0f, W8_INV = 1.0f / 32.0f;
__device__ __forceinline__ float wave_sum(float v) {
#pragma unroll
    for (int o = 1; o < 64; o <<= 1) v += __shfl_xor(v, o);
    return v;
}
__device__ __forceinline__ float sigmoid_f(float v) { return __builtin_amdgcn_rcpf(1.0f + __builtin_amdgcn_exp2f(-1.44269504f * v)); }
__device__ __forceinline__ float silu_f(float v) { return v * sigmoid_f(v); }
__device__ __forceinline__ f32x2 gelu_pk(f32x2 v) {
    const f32x2 av = __builtin_elementwise_abs(v), d = av * 0.2316418882f + 1.0f;
    f32x2 t; t.x = __builtin_amdgcn_rcpf(d.x); t.y = __builtin_amdgcn_rcpf(d.y);
    f32x2 q = t * 0.5307027145f + (-0.7265760135f); q = q * t + 0.7107068705f; q = q * t + (-0.142248368f); q = q * t + 0.127414796f; q = q * t;
    const f32x2 s = (v * v) * (-0.72134752044f);
    f32x2 e; e.x = __builtin_amdgcn_exp2f(s.x); e.y = __builtin_amdgcn_exp2f(s.y);
    const f32x2 m = v * (q * e), r = v - m;
    f32x2 o; o.x = v.x < 0.f ? m.x : r.x; o.y = v.y < 0.f ? m.y : r.y; return o;
}

#define XB_TMO      128
#define XB_XCNT(j)  (256  + 64 * (j))
#define XB_XSUB(j)  (1280 + 64 * (j))
#define XB_XGEN(j)  (2304 + 64 * (j))
#define XB_TOP      3328
#define XB_TOPGEN   3392
#define XCD_BAR_WORDS 3456
#define XB_SPIN_CAP (1u << 18)
__device__ __forceinline__ unsigned xb_ld(unsigned* p)              { return __hip_atomic_load(p, __ATOMIC_RELAXED, __HIP_MEMORY_SCOPE_AGENT); }
__device__ __forceinline__ unsigned xb_add(unsigned* p, unsigned v) { return __hip_atomic_fetch_add(p, v, __ATOMIC_RELAXED, __HIP_MEMORY_SCOPE_AGENT); }
__device__ __forceinline__ unsigned xb_xcc_id() { return (unsigned)__builtin_amdgcn_s_getreg((3 << 11) | 20) & 0xFu; }
#define XB_SPIN(cond, bar) do { unsigned _sp = 0; while (cond) { __builtin_amdgcn_s_sleep(1); \
    if ((++_sp & 255u) == 0u) { if (xb_ld(&(bar)[XB_TMO])) break; if (_sp > XB_SPIN_CAP) { atomicAdd(&(bar)[XB_TMO], 1u); break; } } } } while (0)
struct XcdBarrier { unsigned* bar; unsigned x; volatile LAS unsigned* st; };
__device__ __forceinline__ XcdBarrier xcd_barrier_post(unsigned* bar, volatile LAS unsigned* st) {
    XcdBarrier b; b.bar = bar; b.x = xb_xcc_id(); b.st = st;
    if (threadIdx.x == 0) (void)xb_add(&bar[XB_XCNT(b.x)], 1u);
    return b;
}
__device__ __forceinline__ void xcd_barrier_complete(unsigned* bar, unsigned x, unsigned& nloc, unsigned& nx) {
    const unsigned G = gridDim.x * gridDim.y * gridDim.z;
    unsigned sum, cnt, mine, sp = 0u;
    for (;;) {
        sum = 0u; cnt = 0u; mine = 0u;
#pragma unroll
        for (unsigned j = 0; j < 16; ++j) { const unsigned c = xb_ld(&bar[XB_XCNT(j)]); sum += c; cnt += (c > 0u) ? 1u : 0u; mine = (j == x) ? c : mine; }
        if (sum == G) break;
        __builtin_amdgcn_s_sleep(1);
        if ((++sp & 255u) == 0u) { if (xb_ld(&bar[XB_TMO])) break; if (sp > XB_SPIN_CAP) { atomicAdd(&bar[XB_TMO], 1u); break; } }
    }
    nloc = mine > 0u ? mine : 1u; nx = cnt > 0u ? cnt : 1u;
}
__device__ __forceinline__ void xcd_barrier(const XcdBarrier& b) {
    asm volatile("s_waitcnt vmcnt(0)" ::: "memory");
    __syncthreads();
    if (threadIdx.x == 0) {
        unsigned* bar = b.bar;
        __builtin_amdgcn_s_waitcnt(0);
        unsigned nloc = b.st[0], nx = b.st[1];
        if (nloc == 0u) { xcd_barrier_complete(bar, b.x, nloc, nx); b.st[0] = nloc; b.st[1] = nx; }
        const unsigned old = xb_add(&bar[XB_XSUB(b.x)], 1u);
        const unsigned gen = old / nloc;
        if (old + 1u == (gen + 1u) * nloc) {
            __builtin_amdgcn_fence(__ATOMIC_RELEASE, "agent");
            asm volatile("s_waitcnt vmcnt(0)" ::: "memory");
            const unsigned og = xb_add(&bar[XB_TOP], 1u);
            const unsigned tg = og / nx;
            if (og + 1u == (tg + 1u) * nx) xb_add(&bar[XB_TOPGEN], 1u);
            else XB_SPIN(xb_ld(&bar[XB_TOPGEN]) == tg, bar);
            __builtin_amdgcn_fence(__ATOMIC_ACQUIRE, "agent");
            xb_add(&bar[XB_XGEN(b.x)], 1u);
            asm volatile("s_waitcnt vmcnt(0)" ::: "memory");
        } else {
            XB_SPIN(xb_ld(&bar[XB_XGEN(b.x)]) == gen, bar);
            __builtin_amdgcn_fence(__ATOMIC_ACQUIRE, "agent");
            asm volatile("s_waitcnt vmcnt(0)" ::: "memory");
        }
    }
    __syncthreads();
}

namespace pg8 {
constexpr int BM = 256, BK = 64, HALF = 128, HTB = HALF * BK * 2, STAGE_BYTES = 8 * HTB, NXCD = 8, WGM = 8;
__host__ __device__ __forceinline__ int lds_byte(int r, int c) { const int st = (r >> 4) * 2 + (c >> 5), rr = r & 15, cc = c & 31, ob = rr * 64 + cc * 2; return st * 1024 + (ob ^ (((ob >> 9) & 1) << 5)); }
__host__ __device__ __forceinline__ void stage_rc(int b, int& R, int& C) { const int st = b / 1024, sb = b % 1024, swz = sb ^ (((sb >> 9) & 1) << 5); R = (st >> 1) * 16 + swz / 64; C = (st & 1) * 32 + (swz % 64) / 2; }
__host__ __device__ __forceinline__ int perm32(int rho) { const int n = rho >> 4, i = rho & 15; return 8 * (i >> 2) + 4 * n + (i & 3); }

constexpr int EPI_LDS = 135168;
struct Unit { int pm, pn, pb; };
struct Gemm { const bf16_t* A; const bf16_t* Bt; int M, N, K; };

struct StaticOrder {
    int nM, nN, nwg, G, c;
    __device__ void init(int M, int N, int G_, int c_) { nM = M / BM; nN = N / BM; nwg = nM * nN; G = G_; c = c_; }
    __device__ bool next(int i, Unit& u) const {
        const long L = (long)i * G + c; if (L >= nwg) return false;
        int wgid = (int)L; { const int q = nwg / NXCD, r = nwg % NXCD, xcd = wgid % NXCD, off = wgid / NXCD; wgid = (xcd < r ? xcd * (q + 1) : r * (q + 1) + (xcd - r) * q) + off; }
        const int nig = WGM * nN, gid = wgid / nig, fm = gid * WGM, gsz = (nM - fm) < WGM ? (nM - fm) : WGM;
        u.pm = fm + ((wgid % nig) % gsz); u.pn = (wgid % nig) / gsz; u.pb = u.pn; return true;
    }
};
struct MoeOrder : StaticOrder {
    const LAS int* tile_e;
    __device__ bool next(int i, Unit& u) const { if (!StaticOrder::next(i, u)) return false; u.pb = __builtin_amdgcn_readfirstlane(tile_e[u.pm]) * nN + u.pn; return true; }
};

template <class Epi, class Sched, bool FP8 = false>
__device__ __forceinline__ void gemm_phase(LAS unsigned char* lds, const Gemm g, const Sched& S, const Epi& E) {
    const int tid = threadIdx.x, wid = __builtin_amdgcn_readfirstlane(tid >> 6), lane = tid & 63, wr = wid >> 2, wc = wid & 3, fr = lane & 15, fq = lane >> 4;
    const int K = g.K, nt = K / BK;
    unsigned voffA[2], voffB[2];
#pragma unroll
    for (int i = 0; i < 2; ++i) { int R, C; stage_rc(tid * 16 + i * 8192, R, C); const int Rb = Epi::PERM ? ((R & ~31) + perm32(R & 31)) : R;
        voffA[i] = (unsigned)(R * K + C) * 2u; voffB[i] = (unsigned)(Rb * K + C) * 2u; }
    const size_t kstep = (size_t)(BK * 2);
    const size_t hstep = (size_t)HALF * K * 2;
    const size_t tstep = 2 * hstep;
    const unsigned ldsw = (unsigned)wid * 1024u;
    const int aoff = lds_byte(wr * 64 + fr, fq * 8), boff = lds_byte(wc * 32 + fr, fq * 8);
    LAS unsigned char* ldsA = lds + aoff; LAS unsigned char* ldsB = lds + 4 * HTB + boff;
    asm volatile("" : "+v"(ldsA)); asm volatile("" : "+v"(ldsB));
#define PG8_SA(b, h) (((b) * 2 + (h)) * HTB)
#define PG8_SB(b, h) ((4 + (b) * 2 + (h)) * HTB)
#define PG8_STAGE(bufoff, gbase, voff) do { _Pragma("unroll") for (int _i = 0; _i < 2; ++_i) \
        __builtin_amdgcn_global_load_lds((const unsigned*)((const char*)(gbase) + (voff)[_i]), (LAS unsigned*)(lds + (bufoff) + ldsw + _i * 8192), 16, 0, 0); } while (0)
#define PG8_LD2(dst, addr) do { if constexpr (FP8) { const i32x4 lo_ = *(const LAS i32x4*)(addr), hi_ = *(const LAS i32x4*)((addr) + 1024); (dst).w = __builtin_shufflevector(lo_, hi_, 0, 1, 2, 3, 4, 5, 6, 7); } \
        else { (dst).h[0] = *(const LAS bf16x8*)(addr); (dst).h[1] = *(const LAS bf16x8*)((addr) + 1024); } } while (0)
#define PG8_LDA(dst, b, h) do { _Pragma("unroll") for (int m = 0; m < 4; ++m) PG8_LD2(dst[m], ldsA + PG8_SA(b, h) + m * 2048); } while (0)
#define PG8_LDB(dst, b, h) do { _Pragma("unroll") for (int n = 0; n < 2; ++n) PG8_LD2(dst[n], ldsB + PG8_SA(b, h) + n * 2048); } while (0)
#define PG8_MMA(ai, bj, At, Bt) do { __builtin_amdgcn_s_setprio(1); \
        if constexpr (FP8) { _Pragma("unroll") for (int m = 0; m < 4; ++m) _Pragma("unroll") for (int n = 0; n < 2; ++n) \
            asm volatile("v_mfma_f32_16x16x128_f8f6f4 %0, %1, %2, %0" : "+v"(acc[ai][bj][m][n]) : "v"(Bt[n].w), "v"(At[m].w)); } \
        else { _Pragma("unroll") for (int m = 0; m < 4; ++m) _Pragma("unroll") for (int n = 0; n < 2; ++n) _Pragma("unroll") for (int k = 0; k < 2; ++k) \
            acc[ai][bj][m][n] = __builtin_amdgcn_mfma_f32_16x16x32_bf16(Bt[n].h[k], At[m].h[k], acc[ai][bj][m][n], 0, 0, 0); } \
        __builtin_amdgcn_s_setprio(0); } while (0)
#define PG8_WAIT_V(n) asm volatile("s_waitcnt vmcnt(" #n ")" ::: "memory")
#define PG8_WAIT_L(n) asm volatile("s_waitcnt lgkmcnt(" #n ")" ::: "memory")
#define PG8_BAR __builtin_amdgcn_s_barrier()
#define PG8_SCHED __builtin_amdgcn_sched_barrier(0)
    Unit cur, nxt; int ui = 0;
    if (!S.next(0, cur)) return;
    f32x4 acc[2][2][4][2];
#pragma unroll
    for (int a = 0; a < 2; ++a)
#pragma unroll
        for (int b = 0; b < 2; ++b)
#pragma unroll
            for (int m = 0; m < 4; ++m)
#pragma unroll
                for (int n = 0; n < 2; ++n) acc[a][b][m][n] = (f32x4){0.f, 0.f, 0.f, 0.f};
    union Frag { bf16x8 h[2]; i32x8 w; };
    Frag At[4], B0[2], B1[2];
    const char* cA = (const char*)g.A + (size_t)cur.pm * tstep; const char* cB = (const char*)g.Bt + (size_t)cur.pb * tstep;
    PG8_STAGE(PG8_SB(0, 0), cB, voffB); PG8_STAGE(PG8_SB(0, 1), cB + hstep, voffB); PG8_STAGE(PG8_SA(0, 0), cA, voffA); PG8_STAGE(PG8_SA(0, 1), cA + hstep, voffA);
    if (wr == 1) PG8_BAR;
    PG8_WAIT_V(2); PG8_BAR;
    PG8_STAGE(PG8_SB(1, 0), cB + kstep, voffB); PG8_STAGE(PG8_SA(1, 0), cA + kstep, voffA); PG8_STAGE(PG8_SB(1, 1), cB + hstep + kstep, voffB);
    PG8_WAIT_V(6); PG8_BAR;
    for (;;) {
        const bool has_next = S.next(ui + 1, nxt);
        const char* nA = has_next ? (const char*)g.A + (size_t)nxt.pm * tstep : cA; const char* nB = has_next ? (const char*)g.Bt + (size_t)nxt.pb * tstep : cB;
        for (int t = 0; t < nt; t += 2) {
            const bool last = (t == nt - 2);
            if constexpr (Epi::HAS_PREFETCH) { if (t == 0 && wid == 0) E.prefetch(lds + EPI_LDS + (ui & 1) * 2048, cur, lane); }
            const char* a1 = cA + (size_t)(t + 1) * kstep;
            const char* a2 = last ? nA : cA + (size_t)(t + 2) * kstep; const char* b2 = last ? nB : cB + (size_t)(t + 2) * kstep;
            const char* a3 = a2 + kstep; const char* b3 = b2 + kstep;
            PG8_LDB(B0, 0, 0); PG8_LDB(B1, 0, 1); PG8_SCHED; PG8_LDA(At, 0, 0); PG8_STAGE(PG8_SA(1, 1), a1 + hstep, voffA);
            PG8_WAIT_V(8); PG8_WAIT_L(0); PG8_BAR; PG8_MMA(0, 0, At, B0); PG8_MMA(0, 1, At, B1); PG8_BAR; PG8_SCHED;
            PG8_LDA(At, 0, 1); PG8_STAGE(PG8_SB(0, 0), b2, voffB); PG8_STAGE(PG8_SB(0, 1), b2 + hstep, voffB); PG8_STAGE(PG8_SA(0, 0), a2, voffA);
            PG8_WAIT_V(8); PG8_WAIT_L(0); PG8_BAR; PG8_MMA(1, 0, At, B0); PG8_MMA(1, 1, At, B1); PG8_BAR; PG8_SCHED;
            PG8_LDB(B0, 1, 0); PG8_LDB(B1, 1, 1); PG8_SCHED; PG8_LDA(At, 1, 0); PG8_STAGE(PG8_SA(0, 1), a2 + hstep, voffA);
            PG8_WAIT_V(8); PG8_WAIT_L(0); PG8_BAR; PG8_MMA(0, 0, At, B0); PG8_MMA(0, 1, At, B1); PG8_BAR; PG8_SCHED;
            PG8_LDA(At, 1, 1); PG8_STAGE(PG8_SB(1, 0), b3, voffB); PG8_STAGE(PG8_SB(1, 1), b3 + hstep, voffB); PG8_STAGE(PG8_SA(1, 0), a3, voffA);
            PG8_WAIT_V(8); PG8_WAIT_L(0); PG8_BAR; PG8_MMA(1, 0, At, B0); PG8_MMA(1, 1, At, B1); PG8_BAR; PG8_SCHED;
        }
        if (wr == 0) PG8_BAR;
        if constexpr (FP8) asm volatile("s_nop 15\n\ts_nop 15" ::: "memory");
        { int fr_ = fr, fq_ = fq; asm volatile("" : "+v"(fr_), "+v"(fq_));
          E(acc, cur, wr, wc, fr_, fq_, (const LAS float*)(lds + EPI_LDS + (ui & 1) * 2048)); }
        if (!has_next) break;
#pragma unroll
        for (int a = 0; a < 2; ++a)
#pragma unroll
            for (int b = 0; b < 2; ++b)
#pragma unroll
                for (int m = 0; m < 4; ++m)
#pragma unroll
                    for (int n = 0; n < 2; ++n) { acc[a][b][m][n] = (f32x4){0.f, 0.f, 0.f, 0.f}; if constexpr (FP8) asm volatile("" : "+v"(acc[a][b][m][n])); }
        cur = nxt; cA = nA; cB = nB; ++ui;
        if (wr == 1) PG8_BAR;
    }
    PG8_WAIT_V(0);
    PG8_BAR;
#undef PG8_SA
#undef PG8_SB
#undef PG8_STAGE
#undef PG8_LDA
#undef PG8_LDB
#undef PG8_MMA
#undef PG8_LD2
#undef PG8_WAIT_V
#undef PG8_WAIT_L
#undef PG8_BAR
#undef PG8_SCHED
}

struct EpiProj {
    static constexpr bool PERM = true, HAS_PREFETCH = false;
    bf16_t* O;
    __device__ __forceinline__ void operator()(const f32x4 (&acc)[2][2][4][2], const Unit& u, int wr, int wc, int fr, int fq, const LAS float*) const {
        const int row0 = u.pm * BM + wr * 64 + fr, col0 = u.pn * BM + wc * 32 + 8 * fq;
#pragma unroll
        for (int ai = 0; ai < 2; ++ai)
#pragma unroll
            for (int m = 0; m < 4; ++m) { bf16_t* rowp = O + (size_t)(row0 + ai * HALF + m * 16) * NPROJ + col0;
#pragma unroll
                for (int bj = 0; bj < 2; ++bj) { const f32x4 v0 = acc[ai][bj][m][0], v1 = acc[ai][bj][m][1];
                    u32x4 w; w.x = cvt_pk_bf16(v0[0], v0[1]); w.y = cvt_pk_bf16(v0[2], v0[3]); w.z = cvt_pk_bf16(v1[0], v1[1]); w.w = cvt_pk_bf16(v1[2], v1[3]);
                    *(u32x4*)(rowp + bj * HALF) = w; } }
    }
};
struct EpiResid {
    static constexpr bool PERM = true, HAS_PREFETCH = false;
    const float* X; bf16_t* H;
    __device__ __forceinline__ void operator()(const f32x4 (&acc)[2][2][4][2], const Unit& u, int wr, int wc, int fr, int fq, const LAS float*) const {
        const int row0 = u.pm * BM + wr * 64 + fr, col0 = u.pn * BM + wc * 32 + 8 * fq;
#pragma unroll
        for (int ai = 0; ai < 2; ++ai)
#pragma unroll
            for (int m = 0; m < 4; ++m) { const size_t off = (size_t)(row0 + ai * HALF + m * 16) * D + col0;
#pragma unroll
                for (int bj = 0; bj < 2; ++bj) { const f32x4 v0 = acc[ai][bj][m][0] + *(const f32x4*)(X + off + bj * HALF), v1 = acc[ai][bj][m][1] + *(const f32x4*)(X + off + bj * HALF + 4);
                    u32x4 w; w.x = cvt_pk_bf16(v0[0], v0[1]); w.y = cvt_pk_bf16(v0[2], v0[3]); w.z = cvt_pk_bf16(v1[0], v1[1]); w.w = cvt_pk_bf16(v1[2], v1[3]);
                    *(u32x4*)(H + off + bj * HALF) = w; } }
    }
};
struct EpiSwiglu {
    static constexpr bool PERM = true, HAS_PREFETCH = true;
    unsigned char* O; const float* bgu;
    __device__ __forceinline__ void prefetch(LAS unsigned char* area, const Unit& u, int lane) const {
        const float* src = bgu + (size_t)(u.pb >> 3) * 2048 + u.pn * HALF + (lane < 32 ? 4 * lane : 1024 + 4 * (lane - 32));
        __builtin_amdgcn_global_load_lds((const unsigned*)src, (LAS unsigned*)area, 16, 0, 0);
    }
    __device__ __forceinline__ void operator()(const f32x4 (&acc)[2][2][4][2], const Unit& u, int wr, int wc, int fr, int fq, const LAS float* bl) const {
        const int row0 = u.pm * BM + wr * 64 + fr, jl = wc * 32 + 8 * fq, j0 = u.pn * HALF + jl;
        f32x4 bgv[2], buv[2];
#pragma unroll
        for (int n = 0; n < 2; ++n) { bgv[n] = *(const LAS f32x4*)(bl + jl + 4 * n); buv[n] = *(const LAS f32x4*)(bl + 128 + jl + 4 * n); }
#pragma unroll
        for (int ai = 0; ai < 2; ++ai)
#pragma unroll
            for (int m = 0; m < 4; ++m) { unsigned char* rowp = O + (size_t)(row0 + ai * HALF + m * 16) * DFF + j0;
                u32x2 w;
#pragma unroll
                for (int n = 0; n < 2; ++n) { const f32x4 g4 = acc[ai][0][m][n] * W8_INV + bgv[n], u4 = acc[ai][1][m][n] * W8_INV + buv[n]; f32x4 r;
#pragma unroll
                    for (int j = 0; j < 4; ++j) { const float ga = fminf(g4[j], 7.0f), ua = fminf(fmaxf(u4[j], -7.0f), 7.0f);
                        r[j] = (ua + 1.0f) * ga * __builtin_amdgcn_rcpf(1.0f + __builtin_amdgcn_exp2f(-2.4554669f * ga)); }
                    w[n] = cvt4_fp8(r[0], r[1], r[2], r[3]); }
                *(u32x2*)rowp = w; }
    }
};
struct EpiDown {
    static constexpr bool PERM = true, HAS_PREFETCH = true;
    unsigned char* O; const float* bdn; const float* gsort;
    __device__ __forceinline__ void prefetch(LAS unsigned char* area, const Unit& u, int lane) const {
        __builtin_amdgcn_global_load_lds((const unsigned*)(bdn + (size_t)(u.pb >> 2) * D + u.pn * BM + 4 * lane), (LAS unsigned*)area, 16, 0, 0);
        __builtin_amdgcn_global_load_lds((const unsigned*)(gsort + (size_t)u.pm * BM + 4 * lane), (LAS unsigned*)(area + 1024), 16, 0, 0);
    }
    __device__ __forceinline__ void operator()(const f32x4 (&acc)[2][2][4][2], const Unit& u, int wr, int wc, int fr, int fq, const LAS float* bl) const {
        const int rl = wr * 64 + fr, cl = wc * 32 + 8 * fq, row0 = u.pm * BM + rl, col0 = u.pn * BM + cl;
        f32x4 bv[2][2]; float gw[2][4];
#pragma unroll
        for (int bj = 0; bj < 2; ++bj) { bv[bj][0] = *(const LAS f32x4*)(bl + cl + bj * HALF); bv[bj][1] = *(const LAS f32x4*)(bl + cl + bj * HALF + 4); }
#pragma unroll
        for (int ai = 0; ai < 2; ++ai)
#pragma unroll
            for (int m = 0; m < 4; ++m) gw[ai][m] = bl[256 + rl + ai * HALF + m * 16];
#pragma unroll
        for (int ai = 0; ai < 2; ++ai)
#pragma unroll
            for (int m = 0; m < 4; ++m) { const int r = row0 + ai * HALF + m * 16; const float g = gw[ai][m] * W8_INV; unsigned char* rowp = O + (size_t)r * D + col0;
#pragma unroll
                for (int bj = 0; bj < 2; ++bj) { const f32x4 v0 = acc[ai][bj][m][0] * g + bv[bj][0] * gw[ai][m], v1 = acc[ai][bj][m][1] * g + bv[bj][1] * gw[ai][m];
                    u32x2 w; w.x = cvt4_fp8(v0[0], v0[1], v0[2], v0[3]); w.y = cvt4_fp8(v1[0], v1[1], v1[2], v1[3]);
                    *(u32x2*)(rowp + bj * HALF) = w; } }
    }
};
}

struct Args {
    const float* in[19]; float* out; unsigned char* ws; int ph_lo, ph_hi;
};
struct Frame {
    LAS unsigned char* lds;
    int tid, lane, wave, G, vcu;
    unsigned char* ws;
};
#define MFMA16(a, b, c) __builtin_amdgcn_mfma_f32_16x16x32_bf16((a), (b), (c), 0, 0, 0)

__device__ __forceinline__ void tr_item(const float* src, size_t ldw, bf16_t* dst, LAS float* scr, int lane) {
    f32x4 v[16];
    const int kq = lane >> 4, n4 = 4 * (lane & 15);
#pragma unroll
    for (int i = 0; i < 16; ++i) v[i] = *(const f32x4*)(src + (size_t)(4 * i + kq) * ldw + n4);
#pragma unroll
    for (int i = 0; i < 16; ++i) { LAS float* s = scr + (4 * i + kq) * 65 + n4; s[0] = v[i][0]; s[1] = v[i][1]; s[2] = v[i][2]; s[3] = v[i][3]; }
    LDS_WAIT();
    const int c = lane & 7;
#pragma unroll
    for (int r = 0; r < 8; ++r) { const int n = 8 * r + (lane >> 3); const LAS float* s = scr + (8 * c) * 65 + n;
        u32x4 o; o.x = cvt_pk_bf16(s[0 * 65], s[1 * 65]); o.y = cvt_pk_bf16(s[2 * 65], s[3 * 65]); o.z = cvt_pk_bf16(s[4 * 65], s[5 * 65]); o.w = cvt_pk_bf16(s[6 * 65], s[7 * 65]);
        *(u32x4*)(dst + (size_t)n * 1024 + 8 * c) = o; }
    LDS_WAIT();
}
__device__ __forceinline__ void tr_item8(const float* src, size_t ldw, unsigned char* dst, LAS float* scr, int lane) {
    f32x4 v[16];
    const int kq = lane >> 3, n4 = 4 * (lane & 7);
#pragma unroll
    for (int i = 0; i < 16; ++i) v[i] = *(const f32x4*)(src + (size_t)(8 * i + kq) * ldw + n4);
#pragma unroll
    for (int i = 0; i < 16; ++i) { LAS float* s = scr + (8 * i + kq) * 33 + n4; s[0] = v[i][0]; s[1] = v[i][1]; s[2] = v[i][2]; s[3] = v[i][3]; }
    LDS_WAIT();
    const int c = lane >> 3, nn = lane & 7;
#pragma unroll
    for (int r = 0; r < 4; ++r) { const int n = 8 * r + nn; const LAS float* s = scr + (16 * c) * 33 + n;
        u32x4 o;
#pragma unroll
        for (int q = 0; q < 4; ++q) o[q] = cvt4_fp8(s[(4 * q) * 33] * W8_SCALE, s[(4 * q + 1) * 33] * W8_SCALE, s[(4 * q + 2) * 33] * W8_SCALE, s[(4 * q + 3) * 33] * W8_SCALE);
        *(u32x4*)(dst + (size_t)n * 1024 + 16 * c) = o; }
    LDS_WAIT();
}
__device__ __forceinline__ void p0_prologue(const Frame& F, const Args& a) {
    LAS float* scr = (LAS float*)(F.lds + F.wave * 16896);
    const int gw = F.vcu * NWAVES + F.wave, NGW = F.G * NWAVES;
    const float* w_in = a.in[2]; const float* w_out = a.in[10]; const float* w_gu = a.in[14]; const float* w_dn = a.in[16]; const float* rw = a.in[12];
    bf16_t* WIN = (bf16_t*)(F.ws + WS_WIN); bf16_t* WOUT = (bf16_t*)(F.ws + WS_WOUT); unsigned char* WGU = F.ws + WS_WGU; unsigned char* WDN = F.ws + WS_WDN; bf16_t* RWT = (bf16_t*)(F.ws + WS_RWT);
    constexpr int I_IN = 16 * 48, I_OUT = 16 * 16, NITEMS = I_IN + I_OUT;
    for (int it = gw; it < NITEMS; it += NGW) {
        int r = it;
        if (r < I_IN) { const int kb = r / 48, nb = r % 48; tr_item(w_in + (size_t)(64 * kb) * DIN + 64 * nb, DIN, WIN + (size_t)(64 * nb) * 1024 + 64 * kb, scr, F.lane); continue; } r -= I_IN;
        { const int kb = r / 16, nb = r % 16; tr_item(w_out + (size_t)(64 * kb) * D + 64 * nb, D, WOUT + (size_t)(64 * nb) * 1024 + 64 * kb, scr, F.lane); }
    }
    for (int i = gw * 64 + F.lane; i < 32 * 1024; i += NGW * 64) { const int e = i >> 10, k = i & 1023; RWT[i] = f2bf(rw[(size_t)k * 32 + e]); }
    const float* x = a.in[0]; const float* g1 = a.in[1];
    bf16_t* Y = (bf16_t*)(F.ws + WS_Y); float* AB = (float*)(F.ws + WS_AB);
    f32x4 gv[4]; f32x4 wab[4][4][2];
#pragma unroll
    for (int j = 0; j < 4; ++j) { gv[j] = *(const f32x4*)(g1 + 4 * F.lane + 256 * j);
#pragma unroll
        for (int i = 0; i < 4; ++i) { const float* p = w_in + (size_t)(4 * F.lane + 256 * j + i) * DIN + NPROJ; wab[j][i][0] = *(const f32x4*)p; wab[j][i][1] = *(const f32x4*)(p + 4); } }
    f32x4 v[4];
    if (gw < T) {
#pragma unroll
        for (int j = 0; j < 4; ++j) v[j] = ((const f32x4*)(x + (size_t)gw * D) + F.lane)[64 * j];
    }
    for (int m = gw; m < T; m += NGW) {
        f32x4 vn[4];
        if (m + NGW < T) {
#pragma unroll
            for (int j = 0; j < 4; ++j) vn[j] = ((const f32x4*)(x + (size_t)(m + NGW) * D) + F.lane)[64 * j];
        }
        float ss = 0.f;
#pragma unroll
        for (int j = 0; j < 4; ++j) ss += (v[j][0] * v[j][0] + v[j][1] * v[j][1]) + (v[j][2] * v[j][2] + v[j][3] * v[j][3]);
        const float rstd = rsqrtf(wave_sum(ss) * (1.0f / D) + EPS);
        f32x4 p0 = (f32x4){0.f, 0.f, 0.f, 0.f}, p1 = p0;
        u32x2* yo = (u32x2*)(Y + (size_t)m * D) + F.lane;
#pragma unroll
        for (int j = 0; j < 4; ++j) { const f32x4 y = v[j] * rstd * gv[j];
#pragma unroll
            for (int i = 0; i < 4; ++i) { p0 += wab[j][i][0] * y[i]; p1 += wab[j][i][1] * y[i]; }
            u32x2 w; w.x = cvt_pk_bf16(y[0], y[1]); w.y = cvt_pk_bf16(y[2], y[3]); yo[64 * j] = w; }
        const bool b0 = F.lane & 1, b1 = F.lane & 2, b2 = F.lane & 4;
        f32x4 k4 = b0 ? p1 : p0, s4 = b0 ? p0 : p1;
#pragma unroll
        for (int i = 0; i < 4; ++i) k4[i] += __shfl_xor(s4[i], 1);
        f32x2 k2 = b1 ? (f32x2){k4[2], k4[3]} : (f32x2){k4[0], k4[1]}, s2 = b1 ? (f32x2){k4[0], k4[1]} : (f32x2){k4[2], k4[3]};
        k2.x += __shfl_xor(s2.x, 2); k2.y += __shfl_xor(s2.y, 2);
        float k1 = b2 ? k2.y : k2.x; const float s1 = b2 ? k2.x : k2.y;
        k1 += __shfl_xor(s1, 4);
        k1 += __shfl_xor(k1, 8); k1 += __shfl_xor(k1, 16); k1 += __shfl_xor(k1, 32);
        if (F.lane < 8) AB[(size_t)m * 8 + (b0 ? 4 : 0) + (b1 ? 2 : 0) + (b2 ? 1 : 0)] = k1;
#pragma unroll
        for (int j = 0; j < 4; ++j) v[j] = vn[j];
    }
}

constexpr int GM_LDT = 136;
constexpr int GM_U = 34816;
struct GmPre { u32x4 v[4], u[4]; };
__device__ __forceinline__ void gmlp_prefetch(const Frame& F, GmPre& P, int unit) {
    const int h = unit & 3, bn = unit >> 2, sp = F.tid >> 3, seg = F.tid & 7;
    const bf16_t* pv = (const bf16_t*)(F.ws + WS_R3) + ((size_t)bn * GMC + 2 * sp) * NPROJ + 512 + h * HD + 16 * seg; const bf16_t* pu = pv - 512;
    P.v[0] = *(const u32x4*)pv; P.v[1] = *(const u32x4*)(pv + 8); P.v[2] = *(const u32x4*)(pv + NPROJ); P.v[3] = *(const u32x4*)(pv + NPROJ + 8);
    P.u[0] = *(const u32x4*)pu; P.u[1] = *(const u32x4*)(pu + 8); P.u[2] = *(const u32x4*)(pu + NPROJ); P.u[3] = *(const u32x4*)(pu + NPROJ + 8);
}
__device__ __forceinline__ void gmlp_unit(const Frame& F, const Args& a, int unit, const bf16x8 (&af)[4], GmPre& P, int next_unit) {
    const int h = unit & 3, bn = unit >> 2;
    bf16_t* MIX = (bf16_t*)(F.ws + WS_MIX);
    const float* gmg = a.in[3] + h * HD; const float* bs = a.in[5] + h * GMC;
    LAS bf16_t* vnT = (LAS bf16_t*)F.lds;
    LAS bf16_t* uI = (LAS bf16_t*)(F.lds + GM_U);
    const size_t row0 = (size_t)bn * GMC;
    const int sp = F.tid >> 3, seg = F.tid & 7;
    {
        float x0[16], x1[16];
#pragma unroll
        for (int i = 0; i < 4; ++i) { x0[2 * i] = bflo(P.v[0][i]); x0[2 * i + 1] = bfhi(P.v[0][i]); x0[8 + 2 * i] = bflo(P.v[1][i]); x0[9 + 2 * i] = bfhi(P.v[1][i]);
                                      x1[2 * i] = bflo(P.v[2][i]); x1[2 * i + 1] = bfhi(P.v[2][i]); x1[8 + 2 * i] = bflo(P.v[3][i]); x1[9 + 2 * i] = bfhi(P.v[3][i]); }
#pragma unroll
        for (int i = 0; i < 16; ++i) { const f32x2 gg2 = gelu_pk((f32x2){x0[i], x1[i]}); x0[i] = gg2.x; x1[i] = gg2.y; }
        float s0 = 0.f, s1 = 0.f;
#pragma unroll
        for (int i = 0; i < 16; ++i) { s0 += x0[i] * x0[i]; s1 += x1[i] * x1[i]; }
#pragma unroll
        for (int o = 1; o < 8; o <<= 1) { s0 += __shfl_xor(s0, o); s1 += __shfl_xor(s1, o); }
        const float r0 = rsqrtf(s0 * (1.0f / HD) + EPS), r1 = rsqrtf(s1 * (1.0f / HD) + EPS);
#pragma unroll
        for (int i = 0; i < 16; ++i) { const float gg = gmg[16 * seg + i];
            *(LAS unsigned*)(vnT + (16 * seg + i) * GM_LDT + (((((sp >> 2) ^ seg) & 7) | ((sp >> 2) & 8)) << 3) + ((2 * sp) & 7)) = cvt_pk_bf16(x0[i] * r0 * gg, x1[i] * r1 * gg); }
#pragma unroll
        for (int rr = 0; rr < 2; ++rr)
#pragma unroll
            for (int hh = 0; hh < 2; ++hh) { const u32x4 uw = P.u[2 * rr + hh]; u32x4 o;
#pragma unroll
                for (int i = 0; i < 4; ++i) { const f32x2 g2 = gelu_pk((f32x2){bflo(uw[i]), bfhi(uw[i])}); o[i] = cvt_pk_bf16(g2.x, g2.y); }
                *(LAS u32x4*)(uI + (2 * sp + rr) * GM_LDT + 16 * seg + 8 * hh) = o; }
    }
    if (next_unit >= 0) gmlp_prefetch(F, P, next_unit);
    LDS_WAIT(); __syncthreads();
    const int fr = F.lane & 15, fq = F.lane >> 4;
    f32x4 acc[8];
#pragma unroll
    for (int nt = 0; nt < 8; ++nt) { acc[nt] = (f32x4){0.f, 0.f, 0.f, 0.f};
#pragma unroll
        for (int kk = 0; kk < 4; ++kk) { const int ch = 4 * kk + fq; const bf16x8 bfr = *(const LAS bf16x8*)(vnT + (16 * nt + fr) * GM_LDT + ((((ch ^ nt) & 7) | (ch & 8)) << 3)); acc[nt] = MFMA16(af[kk], bfr, acc[nt]); } }
#pragma unroll
    for (int r = 0; r < 4; ++r) { const int t = 16 * F.wave + 4 * fq + r; const float bias = bs[t];
#pragma unroll
        for (int nt = 0; nt < 8; ++nt) { LAS bf16_t* q = uI + t * GM_LDT + 16 * nt + fr; *q = f2bf(bf2f(*q) * (acc[nt][r] + bias)); } }
    LDS_WAIT(); __syncthreads();
#pragma unroll
    for (int rr = 0; rr < 2; ++rr)
#pragma unroll
        for (int hh = 0; hh < 2; ++hh) *(u32x4*)(MIX + (row0 + 2 * sp + rr) * D + h * HD + 16 * seg + 8 * hh) = *(const LAS u32x4*)(uI + (2 * sp + rr) * GM_LDT + 16 * seg + 8 * hh);
    LDS_WAIT(); __syncthreads();
}
__device__ __forceinline__ void gmlp_wfrags(const Frame& F, const Args& a, int h, bf16x8 (&af)[4]) {
    const float* Wh = a.in[4] + (size_t)h * GMC * GMC;
    const int fr = F.lane & 15, fq = F.lane >> 4, trow = 16 * F.wave + fr;
#pragma unroll
    for (int kk = 0; kk < 4; ++kk) { const int s0 = 32 * kk + 8 * fq; const float* wp = Wh + (size_t)trow * GMC + s0;
        const f32x4 w0 = *(const f32x4*)wp, w1 = *(const f32x4*)(wp + 4); float wv[8] = {w0[0], w0[1], w0[2], w0[3], w1[0], w1[1], w1[2], w1[3]};
#pragma unroll
        for (int j = 0; j < 8; ++j) if (s0 + j > trow) wv[j] = 0.f;
        u32x4 pk; pk.x = cvt_pk_bf16(wv[0], wv[1]); pk.y = cvt_pk_bf16(wv[2], wv[3]); pk.z = cvt_pk_bf16(wv[4], wv[5]); pk.w = cvt_pk_bf16(wv[6], wv[7]);
        af[kk] = __builtin_bit_cast(bf16x8, pk); }
}

constexpr int DN_QS = 0;
constexpr int DN_KS = 17408;
constexpr int DN_KT = 34816;
constexpr int DN_XT = 53248;
constexpr int DN_LN = 90112;
constexpr int DN_LD = 99328;
constexpr int DN_TI = 103680;
constexpr int DN_YT = 106752;
constexpr int DN_GC = 119040;
constexpr int DN_CW = 120064;
static_assert(DN_CW + 6144 <= RING_BYTES, "DeltaNet chunk LDS map");
__device__ __forceinline__ int tsw(int r, int pos) { return r * 72 + ((((pos >> 3) ^ (r >> 3)) & 7) << 3) + (pos & 7); }
__device__ __forceinline__ int dn_slot(int bh, int n) { return bh * NCH + ((n + 7 * bh) & (NCH - 1)); }
struct DnPre { u32x4 xv[3][2][4]; float av, bv; };
__device__ __forceinline__ void dn_prefetch(const Frame& F, DnPre& P, int unit) {
    const int n = unit & 63, bh = unit >> 6, h = bh & 3, b = bh >> 2, fr = F.lane & 15, fq = F.lane >> 4;
    const bf16_t* PROJ = (const bf16_t*)(F.ws + WS_R3); const float* AB = (const float*)(F.ws + WS_AB);
    const size_t trow0 = (size_t)b * SEQ + (size_t)n * DNC;
    P.av = AB[(trow0 + F.lane) * 8 + h]; P.bv = AB[(trow0 + F.lane) * 8 + 4 + h];
#pragma unroll
    for (int ten = 0; ten < 3; ++ten) { const int ch = ten * 512 + h * HD + 8 * fr;
#pragma unroll
        for (int hp = 0; hp < 2; ++hp) { const int pos = hp * 32 + 4 * F.wave + fq;
#pragma unroll
            for (int j = 0; j < 4; ++j) { const int sp = n * DNC + pos - 3 + j;
                P.xv[ten][hp][j] = (sp >= 0) ? *(const u32x4*)(PROJ + ((size_t)b * SEQ + sp) * NPROJ + 1024 + ch) : (u32x4){0u, 0u, 0u, 0u}; } } }
}
__device__ __forceinline__ void dn_chunk(const Frame& F, const Args& a, int unit, DnPre& P, int next_unit) {
    const int n = unit & 63, bh = unit >> 6, h = bh & 3, b = bh >> 2;
    const LAS float* cwL = (const LAS float*)(F.lds + DN_CW);
    LAS unsigned char* L = F.lds;
    LAS bf16_t* qs = (LAS bf16_t*)(L + DN_QS); LAS bf16_t* ks = (LAS bf16_t*)(L + DN_KS); LAS bf16_t* kT = (LAS bf16_t*)(L + DN_KT); LAS bf16_t* XT = (LAS bf16_t*)(L + DN_XT);
    LAS bf16_t* Ln = (LAS bf16_t*)(L + DN_LN); LAS float* Ld = (LAS float*)(L + DN_LD); LAS bf16_t* Ti = (LAS bf16_t*)(L + DN_TI); LAS bf16_t* YT = (LAS bf16_t*)(L + DN_YT + F.wave * 1536);
    LAS float* gcs = (LAS float*)(L + DN_GC); LAS float* bts = gcs + 64; LAS float* egs = gcs + 128;
    const size_t trow0 = (size_t)b * SEQ + (size_t)n * DNC;
    int fr = F.lane & 15, fq = F.lane >> 4;
    asm volatile("" : "+v"(fr), "+v"(fq));
    float my_gc, my_beta, my_eg;
    {
        const float av = P.av, bv = P.bv;
        const float xg = av + a.in[8][h];
        const float sp = xg > 20.f ? xg : log1pf(__expf(xg));
        float g = -__expf(a.in[7][h]) * sp;
#pragma unroll
        for (int o = 1; o < 64; o <<= 1) { const float t = __shfl_up(g, o); if (F.lane >= o) g += t; }
        my_gc = g; my_beta = sigmoid_f(bv); my_eg = __expf(g);
        if (F.wave == 0) { gcs[F.lane] = my_gc; bts[F.lane] = my_beta; egs[F.lane] = my_eg; }
    }
    const int slot = dn_slot(bh, n);
    bf16_t* QDg = (bf16_t*)(F.ws + WS_QD) + (size_t)slot * 64 * 128;
#pragma unroll
    for (int ten = 0; ten < 3; ++ten) {
        f32x4 w0[4], w1[4];
#pragma unroll
        for (int j = 0; j < 4; ++j) { w0[j] = *(const LAS f32x4*)(cwL + (ten * 4 + j) * 128 + 8 * fr); w1[j] = *(const LAS f32x4*)(cwL + (ten * 4 + j) * 128 + 8 * fr + 4); }
#pragma unroll
        for (int hp = 0; hp < 2; ++hp) { const int pos = hp * 32 + 4 * F.wave + fq;
            float accv[8];
#pragma unroll
            for (int i = 0; i < 8; ++i) accv[i] = 0.f;
#pragma unroll
            for (int j = 0; j < 4; ++j) { const u32x4 x = P.xv[ten][hp][j];
                accv[0] += bflo(x[0]) * w0[j][0]; accv[1] += bfhi(x[0]) * w0[j][1]; accv[2] += bflo(x[1]) * w0[j][2]; accv[3] += bfhi(x[1]) * w0[j][3];
                accv[4] += bflo(x[2]) * w1[j][0]; accv[5] += bfhi(x[2]) * w1[j][1]; accv[6] += bflo(x[3]) * w1[j][2]; accv[7] += bfhi(x[3]) * w1[j][3]; }
            float ss = 0.f;
#pragma unroll
            for (int i = 0; i < 8; ++i) { accv[i] = silu_f(accv[i]); ss += accv[i] * accv[i]; }
#pragma unroll
            for (int o = 1; o < 16; o <<= 1) ss += __shfl_xor(ss, o);
            const float bp = __shfl(my_beta, pos), ep = __shfl(my_eg, pos);
            if (ten == 0) { const float sc = rsqrtf(ss + EPS) * 0.08838834764831845f;
#pragma unroll
                for (int i = 0; i < 8; ++i) accv[i] *= sc;
                u32x4 w; w.x = cvt_pk_bf16(accv[0], accv[1]); w.y = cvt_pk_bf16(accv[2], accv[3]); w.z = cvt_pk_bf16(accv[4], accv[5]); w.w = cvt_pk_bf16(accv[6], accv[7]);
                *(LAS u32x4*)(qs + pos * 136 + 8 * fr) = w;
                u32x4 wd; wd.x = cvt_pk_bf16(accv[0] * ep, accv[1] * ep); wd.y = cvt_pk_bf16(accv[2] * ep, accv[3] * ep); wd.z = cvt_pk_bf16(accv[4] * ep, accv[5] * ep); wd.w = cvt_pk_bf16(accv[6] * ep, accv[7] * ep);
                *(u32x4*)(QDg + pos * 128 + 8 * fr) = wd;
            } else if (ten == 1) { const float sc = rsqrtf(ss + EPS);
#pragma unroll
                for (int i = 0; i < 8; ++i) accv[i] *= sc;
                u32x4 w; w.x = cvt_pk_bf16(accv[0], accv[1]); w.y = cvt_pk_bf16(accv[2], accv[3]); w.z = cvt_pk_bf16(accv[4], accv[5]); w.w = cvt_pk_bf16(accv[6], accv[7]);
                *(LAS u32x4*)(ks + pos * 136 + 8 * fr) = w;
                const float rs = bp * ep;
#pragma unroll
                for (int i = 0; i < 8; ++i) { kT[tsw(8 * fr + i, pos)] = f2bf(accv[i]); XT[tsw(128 + 8 * fr + i, pos)] = f2bf(accv[i] * rs); }
            } else {
#pragma unroll
                for (int i = 0; i < 8; ++i) XT[tsw(8 * fr + i, pos)] = f2bf(accv[i] * bp);
            }
        }
    }
    if (next_unit >= 0) dn_prefetch(F, P, next_unit);
    LDS_WAIT(); __syncthreads();
    bf16_t* ATg = (bf16_t*)(F.ws + WS_AT) + (size_t)slot * 64 * 64;
    {
        const int mt = F.wave & 3; const LAS bf16_t* Asrc = (F.wave < 4) ? ks : qs;
        f32x4 acc[4];
#pragma unroll
        for (int nt = 0; nt < 4; ++nt) acc[nt] = (f32x4){0.f, 0.f, 0.f, 0.f};
#pragma unroll
        for (int kk = 0; kk < 4; ++kk) { const bf16x8 af = *(const LAS bf16x8*)(Asrc + (16 * mt + fr) * 136 + 32 * kk + 8 * fq);
#pragma unroll
            for (int nt = 0; nt < 4; ++nt) { const bf16x8 bfr = *(const LAS bf16x8*)(ks + (16 * nt + fr) * 136 + 32 * kk + 8 * fq); acc[nt] = MFMA16(af, bfr, acc[nt]); } }
#pragma unroll
        for (int r = 0; r < 4; ++r) { const int i = 16 * mt + 4 * fq + r; const float gi = gcs[i], bi = bts[i];
#pragma unroll
            for (int nt = 0; nt < 4; ++nt) { const int j = 16 * nt + fr; const float dec = __expf(fminf(gi - gcs[j], 0.f));
                if (F.wave < 4) { const float lv = (j < i) ? bi * acc[nt][r] * dec : 0.f; Ln[i * 72 + j] = f2bf(-lv); if (nt == mt) Ld[(mt * 16 + 4 * fq + r) * 17 + fr] = lv; }
                else ATg[i * 64 + j] = f2bf((j <= i) ? acc[nt][r] * dec : 0.f); } }
    }
    LDS_WAIT(); __syncthreads();
    if (F.wave == 0) {
        const int blk = fq, c = fr;
        float t[16];
#pragma unroll
        for (int i = 0; i < 16; ++i) { float s = (i == c) ? 1.f : 0.f;
#pragma unroll
            for (int j = 0; j < i; ++j) s -= Ld[(blk * 16 + i) * 17 + j] * t[j];
            t[i] = s; }
#pragma unroll
        for (int i = 0; i < 16; ++i) Ti[(16 * blk + i) * 24 + c] = f2bf(t[i]);
    } else {
        bf16_t* KETg = (bf16_t*)(F.ws + WS_KET) + (size_t)slot * 128 * 64;
        const float glast = gcs[63];
        for (int idx = F.tid - 64; idx < 128 * 8; idx += NTHREADS - 64) {
            const int d = idx >> 3, gp = idx & 7;
            const u32x4 v = *(const LAS u32x4*)(kT + tsw(d, 8 * gp)); u32x4 w;
#pragma unroll
            for (int i = 0; i < 4; ++i) w[i] = cvt_pk_bf16(bflo(v[i]) * __expf(glast - gcs[8 * gp + 2 * i]), bfhi(v[i]) * __expf(glast - gcs[8 * gp + 2 * i + 1]));
            *(u32x4*)(KETg + d * 64 + 8 * gp) = w;
        }
        if (F.tid == 64) ((float*)(F.ws + WS_GLAST))[slot] = __expf(glast);
    }
    LDS_WAIT(); __syncthreads();
    {
        bf16_t* Og = (bf16_t*)(F.ws + (F.wave < 4 ? WS_UC : WS_WC)) + (size_t)slot * 64 * 128;
        const int ncol0 = (F.wave & 3) * 32;
        const bf16x8 zf = (bf16x8){0, 0, 0, 0, 0, 0, 0, 0};
#pragma unroll
        for (int bb = 0; bb < 4; ++bb) {
            f32x4 acc[2];
#pragma unroll
            for (int t = 0; t < 2; ++t) { const u32x2 rv = *(const LAS u32x2*)(XT + tsw(32 * F.wave + 16 * t + fr, 16 * bb + 4 * fq));
                acc[t] = (f32x4){bflo(rv.x), bfhi(rv.x), bflo(rv.y), bfhi(rv.y)}; }
            if (bb >= 1) {
#pragma unroll
                for (int kk = 0; kk < 2; ++kk) if (32 * kk < 16 * bb) {
                    bf16x8 af = *(const LAS bf16x8*)(Ln + (16 * bb + fr) * 72 + 32 * kk + 8 * fq);
                    if (32 * kk + 8 * fq >= 16 * bb) af = zf;
#pragma unroll
                    for (int t = 0; t < 2; ++t) { const bf16x8 bfr = *(const LAS bf16x8*)(XT + tsw(32 * F.wave + 16 * t + fr, 32 * kk + 8 * fq)); acc[t] = MFMA16(af, bfr, acc[t]); }
                }
            }
#pragma unroll
            for (int t = 0; t < 2; ++t) { u32x2 w; w.x = cvt_pk_bf16(acc[t][0], acc[t][1]); w.y = cvt_pk_bf16(acc[t][2], acc[t][3]); *(LAS u32x2*)(YT + (16 * t + fr) * 24 + 4 * fq) = w; }
            LDS_WAIT();
            bf16x8 a2 = *(const LAS bf16x8*)(Ti + (16 * bb + fr) * 24 + 8 * (fq & 1));
            if (fq >= 2) a2 = zf;
#pragma unroll
            for (int t = 0; t < 2; ++t) { bf16x8 b2 = *(const LAS bf16x8*)(YT + (16 * t + fr) * 24 + 8 * (fq & 1)); if (fq >= 2) b2 = zf;
                f32x4 x = MFMA16(a2, b2, ((f32x4){0.f, 0.f, 0.f, 0.f}));
                u32x2 w; w.x = cvt_pk_bf16(x[0], x[1]); w.y = cvt_pk_bf16(x[2], x[3]);
                *(LAS u32x2*)(XT + tsw(32 * F.wave + 16 * t + fr, 16 * bb + 4 * fq)) = w;
                if (F.wave < 4) *(u32x2*)(Og + (ncol0 + 16 * t + fr) * 64 + 16 * bb + 4 * fq) = w;
                else {
#pragma unroll
                    for (int r = 0; r < 4; ++r) Og[(16 * bb + 4 * fq + r) * 128 + ncol0 + 16 * t + fr] = f2bf(x[r]); } }
            LDS_WAIT();
        }
    }
    LDS_WAIT(); __syncthreads();
}

constexpr int SC_WC = 0, SC_QD = 17408, SC_AT = 34816, SC_KE = 44032, SC_UC = 62464, SC_GL = 66560, SC_BUF = 66816;
constexpr int SC_ST = 2 * SC_BUF, SC_SLICE = 6656  , SC_OT = SC_ST + 2 * SC_SLICE;
static_assert(SC_OT + 8192 <= RING_BYTES, "scan LDS map");
constexpr int SC_NLD = 384;
struct ScanRegs { u32x4 w[3], q[3], k[3], a[2], u; float gl; };
__device__ __forceinline__ void scan_load(const Frame& F, ScanRegs& R, size_t cu, int sp, int lt) {
    const unsigned char* wc = F.ws + WS_WC + cu * 16384; const unsigned char* qd = F.ws + WS_QD + cu * 16384; const unsigned char* ke = F.ws + WS_KET + cu * 16384;
    const unsigned char* at = F.ws + WS_AT + cu * 8192; const unsigned char* uc = F.ws + WS_UC + cu * 16384 + (size_t)sp * 4096;
    const unsigned o = (unsigned)lt * 16u;
#pragma unroll
    for (int i = 0; i < 3; ++i) if (i < 2 || lt < 256) { R.w[i] = *(const u32x4*)(wc + o + i * (SC_NLD * 16)); R.q[i] = *(const u32x4*)(qd + o + i * (SC_NLD * 16)); R.k[i] = *(const u32x4*)(ke + o + i * (SC_NLD * 16)); }
    R.a[0] = *(const u32x4*)(at + o); if (lt < 128) R.a[1] = *(const u32x4*)(at + o + SC_NLD * 16);
    if (lt < 256) R.u = *(const u32x4*)(uc + o);
    R.gl = ((const float*)(F.ws + WS_GLAST))[cu];
}
__device__ __forceinline__ void scan_store(LAS unsigned char* buf, const ScanRegs& R, int lt) {
    if (lt == 0) *(LAS float*)(buf + SC_GL) = R.gl;
    const int d16 = ((lt >> 4) * 136 + (lt & 15) * 8) * 2;
    const int d8 = ((lt >> 3) * 72 + (lt & 7) * 8) * 2;
#pragma unroll
    for (int i = 0; i < 3; ++i) if (i < 2 || lt < 256) { *(LAS u32x4*)(buf + SC_WC + d16 + i * (24 * 136 * 2)) = R.w[i]; *(LAS u32x4*)(buf + SC_QD + d16 + i * (24 * 136 * 2)) = R.q[i]; *(LAS u32x4*)(buf + SC_KE + d8 + i * (48 * 72 * 2)) = R.k[i]; }
    *(LAS u32x4*)(buf + SC_AT + d8) = R.a[0]; if (lt < 128) *(LAS u32x4*)(buf + SC_AT + d8 + 48 * 72 * 2) = R.a[1];
    if (lt < 256) *(LAS u32x4*)(buf + SC_UC + lt * 16) = R.u;
}
__device__ __forceinline__ void scan_out(const Frame& F, int b, int h, int sp, int nn, int lt) {
    bf16_t* Og = (bf16_t*)(F.ws + WS_O);
    const int pos = lt >> 2, e4 = (lt & 3) * 4;
#pragma unroll
    for (int j = 0; j < 2; ++j) { const LAS bf16_t* OT = (const LAS bf16_t*)(F.lds + SC_OT + ((nn & 1) * 2 + j) * 2048);
        u32x2 w; w.x = (unsigned)OT[e4 * 64 + pos] | ((unsigned)OT[(e4 + 1) * 64 + pos] << 16); w.y = (unsigned)OT[(e4 + 2) * 64 + pos] | ((unsigned)OT[(e4 + 3) * 64 + pos] << 16);
        *(u32x2*)(Og + ((size_t)b * SEQ + (size_t)nn * DNC + pos) * 512 + h * HD + 16 * (2 * sp + j) + e4) = w; }
}
__device__ __forceinline__ void dn_scan(const Frame& F, int item) {
    const int bh = item >> 2, sp = item & 3, h = bh & 3, b = bh >> 2;
    const int cj = F.wave & 1;
    LAS bf16_t* ST = (LAS bf16_t*)(F.lds + SC_ST + cj * SC_SLICE); LAS bf16_t* VT = (LAS bf16_t*)(F.lds + SC_ST + cj * SC_SLICE + 4352);
    const int fr = F.lane & 15, fq = F.lane >> 4;
    f32x4 S[8];
#pragma unroll
    for (int mt = 0; mt < 8; ++mt) S[mt] = (f32x4){0.f, 0.f, 0.f, 0.f};
    if (F.wave < 2) {
#pragma unroll
        for (int mt = 0; mt < 8; ++mt) *(LAS u32x2*)(ST + fr * 136 + 16 * mt + 4 * fq) = (u32x2){0u, 0u};
    }
    ScanRegs R;
    if (F.wave >= 2) { scan_load(F, R, (size_t)dn_slot(bh, 0), sp, F.tid - 128); scan_store(F.lds, R, F.tid - 128);
                       scan_load(F, R, (size_t)dn_slot(bh, 1), sp, F.tid - 128); }
    LDS_WAIT(); __syncthreads();
#pragma unroll 1
    for (int n = 0; n < NCH; ++n) {
        LAS unsigned char* buf = F.lds + (n & 1) * SC_BUF;
        if (F.wave >= 2) {
            if (n + 1 < NCH) scan_store(F.lds + ((n + 1) & 1) * SC_BUF, R, F.tid - 128);
            if (n + 2 < NCH) scan_load(F, R, (size_t)dn_slot(bh, n + 2), sp, F.tid - 128);
            if (n >= 1 && F.tid < 384) scan_out(F, b, h, sp, n - 1, F.tid - 128);
        } else {
            const LAS bf16_t* wc = (const LAS bf16_t*)(buf + SC_WC); const LAS bf16_t* qd = (const LAS bf16_t*)(buf + SC_QD); const LAS bf16_t* at = (const LAS bf16_t*)(buf + SC_AT);
            const LAS bf16_t* ke = (const LAS bf16_t*)(buf + SC_KE); const LAS bf16_t* uc = (const LAS bf16_t*)(buf + SC_UC) + cj * 1024;
            bf16x8 sb[4];
#pragma unroll
            for (int kk = 0; kk < 4; ++kk) sb[kk] = *(const LAS bf16x8*)(ST + fr * 136 + 32 * kk + 8 * fq);
            f32x4 vn[4], oo[4];
#pragma unroll
            for (int hf = 0; hf < 2; ++hf) {
                bf16x8 aw[2][4], aq[2][4];
#pragma unroll
                for (int m2 = 0; m2 < 2; ++m2)
#pragma unroll
                    for (int kk = 0; kk < 4; ++kk) { aw[m2][kk] = *(const LAS bf16x8*)(wc + (16 * (2 * hf + m2) + fr) * 136 + 32 * kk + 8 * fq); aq[m2][kk] = *(const LAS bf16x8*)(qd + (16 * (2 * hf + m2) + fr) * 136 + 32 * kk + 8 * fq); }
                __builtin_amdgcn_sched_barrier(0);
#pragma unroll
                for (int m2 = 0; m2 < 2; ++m2) { const int mt = 2 * hf + m2; vn[mt] = (f32x4){0.f, 0.f, 0.f, 0.f}; oo[mt] = (f32x4){0.f, 0.f, 0.f, 0.f}; }
#pragma unroll
                for (int kk = 0; kk < 4; ++kk)
#pragma unroll
                    for (int m2 = 0; m2 < 2; ++m2) { const int mt = 2 * hf + m2; vn[mt] = MFMA16(aw[m2][kk], sb[kk], vn[mt]); oo[mt] = MFMA16(aq[m2][kk], sb[kk], oo[mt]); }
                __builtin_amdgcn_sched_barrier(0);
            }
            u32x2 uvv[4];
#pragma unroll
            for (int mt = 0; mt < 4; ++mt) uvv[mt] = *(const LAS u32x2*)(uc + fr * 64 + 16 * mt + 4 * fq);
            __builtin_amdgcn_sched_barrier(0);
#pragma unroll
            for (int mt = 0; mt < 4; ++mt) { const u32x2 uv = uvv[mt];
                vn[mt][0] = bflo(uv.x) - vn[mt][0]; vn[mt][1] = bfhi(uv.x) - vn[mt][1]; vn[mt][2] = bflo(uv.y) - vn[mt][2]; vn[mt][3] = bfhi(uv.y) - vn[mt][3];
                u32x2 w; w.x = cvt_pk_bf16(vn[mt][0], vn[mt][1]); w.y = cvt_pk_bf16(vn[mt][2], vn[mt][3]);
                *(LAS u32x2*)(VT + fr * 72 + 16 * mt + 4 * fq) = w; }
            LDS_WAIT();
            bf16x8 vb[2];
#pragma unroll
            for (int kk = 0; kk < 2; ++kk) vb[kk] = *(const LAS bf16x8*)(VT + fr * 72 + 32 * kk + 8 * fq);
            bf16x8 aa[4][2];
#pragma unroll
            for (int mt = 0; mt < 4; ++mt)
#pragma unroll
                for (int kk = 0; kk < 2; ++kk) aa[mt][kk] = *(const LAS bf16x8*)(at + (16 * mt + fr) * 72 + 32 * kk + 8 * fq);
            bf16x8 ak[8][2];
#pragma unroll
            for (int mt = 0; mt < 4; ++mt)
#pragma unroll
                for (int kk = 0; kk < 2; ++kk) ak[mt][kk] = *(const LAS bf16x8*)(ke + (16 * mt + fr) * 72 + 32 * kk + 8 * fq);
            const float dec = *(const LAS float*)(buf + SC_GL);
            __builtin_amdgcn_sched_barrier(0);
#pragma unroll
            for (int mt = 0; mt < 4; ++mt) {
#pragma unroll
                for (int kk = 0; kk < 2; ++kk) oo[mt] = MFMA16(aa[mt][kk], vb[kk], oo[mt]); }
#pragma unroll
            for (int mt = 4; mt < 8; ++mt)
#pragma unroll
                for (int kk = 0; kk < 2; ++kk) ak[mt][kk] = *(const LAS bf16x8*)(ke + (16 * mt + fr) * 72 + 32 * kk + 8 * fq);
            __builtin_amdgcn_sched_barrier(0);
#pragma unroll
            for (int mt = 0; mt < 8; ++mt) { S[mt] = S[mt] * dec;
#pragma unroll
                for (int kk = 0; kk < 2; ++kk) S[mt] = MFMA16(ak[mt][kk], vb[kk], S[mt]); }
            __builtin_amdgcn_sched_barrier(0);
#pragma unroll
            for (int mt = 0; mt < 8; ++mt) { u32x2 w; w.x = cvt_pk_bf16(S[mt][0], S[mt][1]); w.y = cvt_pk_bf16(S[mt][2], S[mt][3]);
                *(LAS u32x2*)(ST + fr * 136 + 16 * mt + 4 * fq) = w; }
            LAS bf16_t* OT = (LAS bf16_t*)(F.lds + SC_OT + ((n & 1) * 2 + cj) * 2048);
#pragma unroll
            for (int mt = 0; mt < 4; ++mt) { u32x2 w; w.x = cvt_pk_bf16(oo[mt][0], oo[mt][1]); w.y = cvt_pk_bf16(oo[mt][2], oo[mt][3]); *(LAS u32x2*)(OT + fr * 64 + 16 * mt + 4 * fq) = w; }
        }
        LDS_WAIT(); __builtin_amdgcn_s_barrier(); asm volatile("" ::: "memory");
    }
    if (F.tid >= 128 && F.tid < 384) scan_out(F, b, h, sp, NCH - 1, F.tid - 128);
    LDS_WAIT(); __syncthreads();
}
__device__ __forceinline__ void convert_experts(const Frame& F, const Args& a, int cw, int nw) {
    LAS float* scr = (LAS float*)(F.lds + F.wave * 16896);
    const float* w_gu = a.in[14]; const float* w_dn = a.in[16]; unsigned char* WGU = F.ws + WS_WGU; unsigned char* WDN = F.ws + WS_WDN;
    constexpr int I_GU = NE * 8 * 64, I_DN = NE * 8 * 32;
    for (int it = cw; it < I_GU + I_DN; it += nw) {
        int r = it;
        if (r < I_GU) { const int e = r / 512, q = r % 512, kb = q / 64, nb = q % 64; const int c0 = 32 * nb, j = c0 & 1023, drow = (j >> 7) * 256 + (c0 >= 1024 ? 128 : 0) + (j & 127);
            tr_item8(w_gu + (size_t)e * 1024 * 2048 + (size_t)(128 * kb) * 2048 + c0, 2048, WGU + (size_t)e * 2048 * 1024 + (size_t)drow * 1024 + 128 * kb, scr, F.lane); continue; } r -= I_GU;
        { const int e = r / 256, q = r % 256, kb = q / 32, nb = q % 32;
            tr_item8(w_dn + (size_t)e * 1024 * 1024 + (size_t)(128 * kb) * 1024 + 32 * nb, 1024, WDN + (size_t)e * 1024 * 1024 + (size_t)(32 * nb) * 1024 + 128 * kb, scr, F.lane); }
    }
}

__device__ __forceinline__ void dn_out(const Frame& F, const Args& a) {
    const int gw = F.vcu * NWAVES + F.wave, NGW = F.G * NWAVES;
    const bf16_t* Og = (const bf16_t*)(F.ws + WS_O); const bf16_t* PROJ = (const bf16_t*)(F.ws + WS_R3); bf16_t* MIX = (bf16_t*)(F.ws + WS_MIX);
    const float* ng = a.in[9] + 8 * (F.lane & 15);
    const f32x4 g0 = *(const f32x4*)ng, g1 = *(const f32x4*)(ng + 4);
    for (int m = gw; m < T; m += NGW) {
        const u32x4 ow = *(const u32x4*)(Og + (size_t)m * 512 + 8 * F.lane);
        f32x4 o0 = (f32x4){bflo(ow[0]), bfhi(ow[0]), bflo(ow[1]), bfhi(ow[1])}, o1 = (f32x4){bflo(ow[2]), bfhi(ow[2]), bflo(ow[3]), bfhi(ow[3])};
        const u32x4 z = *(const u32x4*)(PROJ + (size_t)m * NPROJ + 2560 + 8 * F.lane);
        float ss = (o0[0] * o0[0] + o0[1] * o0[1]) + (o0[2] * o0[2] + o0[3] * o0[3]) + (o1[0] * o1[0] + o1[1] * o1[1]) + (o1[2] * o1[2] + o1[3] * o1[3]);
#pragma unroll
        for (int o = 1; o < 16; o <<= 1) ss += __shfl_xor(ss, o);
        const float rstd = rsqrtf(ss * (1.0f / HD) + EPS);
        o0 = o0 * rstd * g0; o1 = o1 * rstd * g1;
        u32x4 w; w.x = cvt_pk_bf16(o0[0] * silu_f(bflo(z[0])), o0[1] * silu_f(bfhi(z[0]))); w.y = cvt_pk_bf16(o0[2] * silu_f(bflo(z[1])), o0[3] * silu_f(bfhi(z[1])));
        w.z = cvt_pk_bf16(o1[0] * silu_f(bflo(z[2])), o1[1] * silu_f(bfhi(z[2]))); w.w = cvt_pk_bf16(o1[2] * silu_f(bflo(z[3])), o1[3] * silu_f(bfhi(z[3])));
        *(u32x4*)(MIX + (size_t)m * D + 512 + 8 * F.lane) = w;
    }
}

constexpr int RT_PITCH = 1032;
__device__ __forceinline__ void route(const Frame& F, const Args& a) {
    const int gw = F.vcu * NWAVES + F.wave, NGW = F.G * NWAVES;
    const bf16_t* HB = (const bf16_t*)(F.ws + WS_H); const bf16_t* RWT = (const bf16_t*)(F.ws + WS_RWT); const float* rb = a.in[13]; const float* g2 = a.in[11];
    int* EIDX = (int*)(F.ws + WS_EIDX); float* GATEW = (float*)(F.ws + WS_GATEW); int* EPOS = (int*)(F.ws + WS_EPOS);
    unsigned* cnt = (unsigned*)(F.ws + WS_CTL) + CW_CNT;
    LAS bf16_t* tl = (LAS bf16_t*)(F.lds + F.wave * 17664); LAS float* lg = (LAS float*)(F.lds + F.wave * 17664 + 16512);
    LAS unsigned* lcnt = (LAS unsigned*)(F.lds + 8 * 17664);
    if (F.tid < 64) lcnt[F.tid] = 0u;
    LDS_WAIT(); __syncthreads();
    const int fr = F.lane & 15, fq = F.lane >> 4;
    f32x4 gv[4];
#pragma unroll
    for (int j = 0; j < 4; ++j) gv[j] = *(const f32x4*)(g2 + 4 * F.lane + 256 * j);
    for (int batch = gw; batch < T / 8; batch += NGW) {
        const size_t r0 = (size_t)batch * 8;
        u32x2 raw[8][4];
#pragma unroll
        for (int row = 0; row < 8; ++row)
#pragma unroll
            for (int j = 0; j < 4; ++j) raw[row][j] = ((const u32x2*)(HB + (r0 + row) * D))[F.lane + 64 * j];
#pragma unroll
        for (int row = 0; row < 8; ++row) {
            f32x4 v[4]; float ss = 0.f;
#pragma unroll
            for (int j = 0; j < 4; ++j) { v[j] = (f32x4){bflo(raw[row][j].x), bfhi(raw[row][j].x), bflo(raw[row][j].y), bfhi(raw[row][j].y)}; ss += (v[j][0] * v[j][0] + v[j][1] * v[j][1]) + (v[j][2] * v[j][2] + v[j][3] * v[j][3]); }
            const float rstd = rsqrtf(wave_sum(ss) * (1.0f / D) + EPS);
            unsigned* y8 = (unsigned*)(F.ws + WS_HN8 + (r0 + row) * D) + F.lane;
#pragma unroll
            for (int j = 0; j < 4; ++j) { const f32x4 y = v[j] * rstd * gv[j]; y8[64 * j] = cvt4_fp8(y[0], y[1], y[2], y[3]);
                u32x2 w; w.x = cvt_pk_bf16(y[0], y[1]); w.y = cvt_pk_bf16(y[2], y[3]); *(LAS u32x2*)(tl + row * RT_PITCH + 4 * F.lane + 256 * j) = w; }
        }
        LDS_WAIT();
        f32x4 acc0 = (f32x4){0.f, 0.f, 0.f, 0.f}, acc1 = acc0;
#pragma unroll 4
        for (int kk = 0; kk < 32; ++kk) {
            const bf16x8 af = *(const LAS bf16x8*)(tl + (fr & 7) * RT_PITCH + 32 * kk + 8 * fq);
            const bf16x8 b0 = *(const bf16x8*)(RWT + (size_t)fr * D + 32 * kk + 8 * fq), b1 = *(const bf16x8*)(RWT + (size_t)(16 + fr) * D + 32 * kk + 8 * fq);
            acc0 = MFMA16(af, b0, acc0); acc1 = MFMA16(af, b1, acc1);
        }
        const float bb0 = rb[fr], bb1 = rb[16 + fr];
        if (fq < 2) {
#pragma unroll
            for (int r = 0; r < 4; ++r) { lg[(4 * fq + r) * 36 + fr] = acc0[r] + bb0; lg[(4 * fq + r) * 36 + 16 + fr] = acc1[r] + bb1; } }
        LDS_WAIT();
        if (F.lane < 8) {
            const int row = F.lane; const size_t t = r0 + row;
            float v[32];
#pragma unroll
            for (int q = 0; q < 8; ++q) { const f32x4 x = *(const LAS f32x4*)(lg + row * 36 + 4 * q); v[4 * q] = x[0]; v[4 * q + 1] = x[1]; v[4 * q + 2] = x[2]; v[4 * q + 3] = x[3]; }
            float tv[4]; int ti[4];
#pragma unroll
            for (int k = 0; k < 4; ++k) { float best = -3.0e38f; int bi = 0;
#pragma unroll
                for (int e = 0; e < 32; ++e) { if (v[e] > best) { best = v[e]; bi = e; } }
                tv[k] = best; ti[k] = bi;
#pragma unroll
                for (int e = 0; e < 32; ++e) v[e] = (e == bi) ? -3.0e38f : v[e]; }
            const float e1 = __expf(tv[1] - tv[0]), e2 = __expf(tv[2] - tv[0]), e3 = __expf(tv[3] - tv[0]); const float inv = 1.0f / (1.0f + e1 + e2 + e3);
            const float gk[4] = {inv, e1 * inv, e2 * inv, e3 * inv};
#pragma unroll
            for (int k = 0; k < 4; ++k) {
                const unsigned pos = __hip_atomic_fetch_add(lcnt + ti[k], 1u, __ATOMIC_RELAXED, __HIP_MEMORY_SCOPE_WORKGROUP);
                EIDX[t * 4 + k] = ti[k]; GATEW[t * 4 + k] = gk[k]; EPOS[t * 4 + k] = (int)pos;
            }
        }
        LDS_WAIT();
    }
    VM_WAIT(); LDS_WAIT(); __syncthreads();
    if (F.tid < NE) { const unsigned c = lcnt[F.tid]; lcnt[32 + F.tid] = c ? __hip_atomic_fetch_add(cnt + 64 * F.tid, c, __ATOMIC_RELAXED, __HIP_MEMORY_SCOPE_AGENT) : 0u; }
    LDS_WAIT(); __syncthreads();
    for (int batch = gw; batch < T / 8; batch += NGW) if (F.lane < 32) { const size_t a0 = (size_t)batch * 32 + F.lane; EPOS[a0] += (int)lcnt[32 + EIDX[a0]]; }
}

constexpr int TB_OFF = 131072;
__device__ __forceinline__ void build_tables(const Frame& F) {
    LAS int* pst = (LAS int*)(F.lds + TB_OFF); LAS int* cn = pst + 40; LAS int* tile_e = pst + 80;
    const unsigned* cnt = (const unsigned*)(F.ws + WS_CTL) + CW_CNT;
    if (F.tid < 64) {
        const int e = F.lane & 31; const int c = (int)__hip_atomic_load(cnt + 64 * e, __ATOMIC_RELAXED, __HIP_MEMORY_SCOPE_AGENT);
        const int padded = (c + 255) & ~255;
        int incl = padded;
#pragma unroll
        for (int o = 1; o < 32; o <<= 1) { const int t = __shfl_up(incl, o); if (e >= o) incl += t; }
        if (F.lane < 32) { pst[e] = incl - padded; cn[e] = c; if (e == 31) pst[32] = incl;
            for (int j = 0; j < padded / 256; ++j) tile_e[(incl - padded) / 256 + j] = e; }
    }
    LDS_WAIT(); __syncthreads();
}

__device__ __forceinline__ void gather_rows(const Frame& F) {
    const int gw = F.vcu * NWAVES + F.wave, NGW = F.G * NWAVES;
    LAS int* pst = (LAS int*)(F.lds + TB_OFF); LAS int* cn = pst + 40; LAS int* tile_e = pst + 80;
    const unsigned char* HN8 = F.ws + WS_HN8; unsigned char* XS = F.ws + WS_R3;
    const int* EIDX = (const int*)(F.ws + WS_EIDX); const int* EPOS = (const int*)(F.ws + WS_EPOS); const float* GATEW = (const float*)(F.ws + WS_GATEW); float* GSORT = (float*)(F.ws + WS_GSORT); int* ROWOF = (int*)(F.ws + WS_ROWOF);
    const int rtot = pst[32];
    for (int tl = gw; tl < (rtot >> 8); tl += NGW) { const int e = tile_e[tl], first = pst[e] + cn[e], lo = tl << 8;
        for (int R = (first > lo ? first : lo); R < lo + 256; ++R) { *((u32x4*)(XS + (size_t)R * D) + F.lane) = (u32x4){0u, 0u, 0u, 0u}; if (F.lane == 0) GSORT[R] = 0.f; } }
    for (int t0 = gw * 4; t0 < T; t0 += NGW * 4) {
        int Rl = 0;
        if (F.lane < 16) { const int a = t0 * 4 + F.lane; const int e = EIDX[a]; Rl = pst[e] + EPOS[a]; ROWOF[a] = Rl; GSORT[Rl] = GATEW[a]; }
        u32x4 v[4];
#pragma unroll
        for (int j = 0; j < 4; ++j) v[j] = *((const u32x4*)(HN8 + (size_t)(t0 + j) * D) + F.lane);
#pragma unroll
        for (int j = 0; j < 4; ++j)
#pragma unroll
            for (int k = 0; k < 4; ++k) { const int R = __builtin_amdgcn_readlane(Rl, 4 * j + k); *((u32x4*)(XS + (size_t)R * D) + F.lane) = v[j]; }
    }
}

__device__ __forceinline__ void combine(const Frame& F, const Args& a) {
    const int gw = F.vcu * NWAVES + F.wave, NGW = F.G * NWAVES;
    const bf16_t* H = (const bf16_t*)(F.ws + WS_H); const unsigned char* YS = F.ws + WS_YS; const int* ROWOF = (const int*)(F.ws + WS_ROWOF); const float* gf = a.in[18];
    f32x4 gv[4];
#pragma unroll
    for (int j = 0; j < 4; ++j) gv[j] = *(const f32x4*)(gf + 4 * F.lane + 256 * j);
    for (int m = gw; m < T; m += NGW) {
        const u32x2* xr = (const u32x2*)(H + (size_t)m * D) + F.lane;
        f32x4 v[4];
#pragma unroll
        for (int j = 0; j < 4; ++j) { const u32x2 hw = xr[64 * j]; v[j] = (f32x4){bflo(hw.x), bfhi(hw.x), bflo(hw.y), bfhi(hw.y)}; }
#if !defined(DBG_SKIP_MOE)
#pragma unroll
        for (int k = 0; k < 4; ++k) { const int R = ROWOF[m * 4 + k]; const int* yr = (const int*)(YS + (size_t)R * D) + F.lane;
#pragma unroll
            for (int j = 0; j < 4; ++j) { const int w = yr[64 * j]; const f32x2 lo = __builtin_amdgcn_cvt_pk_f32_fp8(w, false), hi = __builtin_amdgcn_cvt_pk_f32_fp8(w, true);
                v[j][0] += lo.x; v[j][1] += lo.y; v[j][2] += hi.x; v[j][3] += hi.y; } }
#endif
        float ss = 0.f;
#pragma unroll
        for (int j = 0; j < 4; ++j) ss += (v[j][0] * v[j][0] + v[j][1] * v[j][1]) + (v[j][2] * v[j][2] + v[j][3] * v[j][3]);
        const float rstd = rsqrtf(wave_sum(ss) * (1.0f / D) + EPS);
        f32x4* o = (f32x4*)(a.out + (size_t)m * D) + F.lane;
#pragma unroll
        for (int j = 0; j < 4; ++j) o[64 * j] = v[j] * rstd * gv[j];
    }
}

__device__ __forceinline__ void dbg_dump(const Frame& F, const Args& a, int what) {
    const int gw = F.vcu * NWAVES + F.wave, NGW = F.G * NWAVES;
    for (int m = gw; m < T; m += NGW) {
        for (int c = F.lane; c < D; c += 64) {
            float v = 0.f;
            if (what == 1) v = bf2f(((const bf16_t*)(F.ws + WS_R3))[(size_t)m * NPROJ + c]);
            else if (what == 2) v = bf2f(((const bf16_t*)(F.ws + WS_MIX))[(size_t)m * D + c]);
            else if (what == 3) v = ((const float*)(F.ws + WS_O))[(size_t)m * 512 + (c & 511)];
            else if (what == 4) v = ((const float*)(F.ws + WS_H))[(size_t)m * D + c];
            else if (what == 5) v = bf2f(((const bf16_t*)(F.ws + WS_R3))[(size_t)m * NPROJ + 1024 + c]);
            else if (what == 6) v = bf2f(((const bf16_t*)(F.ws + WS_R3))[(size_t)m * NPROJ + 2048 + c]);
            else if (what == 7) v = bf2f(((const bf16_t*)(F.ws + WS_Y))[(size_t)m * D + c]);
            else if (what == 9) v = bf2f(((const bf16_t*)(F.ws + WS_WC))[((size_t)m * D + c) & 0xFFFFFF]);
            else if (what == 10) v = bf2f(((const bf16_t*)(F.ws + WS_UC))[((size_t)m * D + c) & 0xFFFFFF]);
            else if (what == 11) v = bf2f(((const bf16_t*)(F.ws + WS_QD))[((size_t)m * D + c) & 0xFFFFFF]);
            else if (what == 12) v = bf2f(((const bf16_t*)(F.ws + WS_KET))[((size_t)m * D + c) & 0xFFFFFF]);
            else if (what == 13) v = bf2f(((const bf16_t*)(F.ws + WS_AT))[((size_t)m * D + c) & 0x7FFFFF]);
            else if (what == 14) v = ((const float*)(F.ws + WS_AB))[(size_t)m * 8 + (c & 7)];
            else if (what == 8) v = bf2f(((const bf16_t*)(F.ws + WS_MIX))[(size_t)m * D + (c & 511)]);
            if (!(v - v == 0.f)) v = 12345.f;
            a.out[(size_t)m * D + c] = v;
        }
    }
}

constexpr int NPHASES = 12;
__global__ void __launch_bounds__(NTHREADS, 2) fwd(Args args) {
    __shared__ __attribute__((aligned(16))) unsigned char lds_raw[LDS_BYTES];
    Frame F;
    F.lds = (LAS unsigned char*)lds_raw;
    F.tid = threadIdx.x; F.lane = F.tid & 63; F.wave = __builtin_amdgcn_readfirstlane(F.tid >> 6);
    F.G = gridDim.x; { const int bx = blockIdx.x; F.vcu = (F.G % 8 == 0) ? (bx % 8) * (F.G / 8) + bx / 8 : bx; }
    F.ws = args.ws;
    volatile LAS unsigned* MISC = (volatile LAS unsigned*)(F.lds + LDSCTL_OFF);
    for (int u = F.tid; u < (LDS_BYTES - LDSCTL_OFF) / 4; u += NTHREADS) MISC[u] = 0u;
    __syncthreads();
#if !MK_PER_PHASE
    XcdBarrier bar = xcd_barrier_post((unsigned*)(F.ws + WS_CTL) + CW_BAR, MISC + 8);
#define GRID_BAR() xcd_barrier(bar)
#else
#define GRID_BAR() do { } while (0)
#endif
    const int lo = args.ph_lo, hi = args.ph_hi;
#define IN(k) (lo <= (k) && (k) < hi)
#ifndef PROBE_DOUBLE
#define PROBE_DOUBLE (-1)
#endif
#define REP(k) for (int rep_ = 0; rep_ < ((PROBE_DOUBLE) == (k) ? 2 : 1); ++rep_)
#define SEAM(k) do { if (IN(k) && IN((k) + 1)) GRID_BAR(); } while (0)

    if (IN(0)) REP(0) { p0_prologue(F, args); } SEAM(0);
    if (IN(1)) REP(1) {
        pg8::Gemm g{(const bf16_t*)(F.ws + WS_Y), (const bf16_t*)(F.ws + WS_WIN), T, NPROJ, D}; pg8::StaticOrder S; S.init(T, NPROJ, F.G, (int)blockIdx.x);
        pg8::EpiProj E{(bf16_t*)(F.ws + WS_R3)};
        pg8::gemm_phase<pg8::EpiProj, pg8::StaticOrder>(F.lds, g, S, E);
    } SEAM(1);
    if (IN(2)) REP(2) {
        if (F.vcu < NB * 32 * NH) {
            bf16x8 af[4]; GmPre GP; int hcur = -1;
            gmlp_prefetch(F, GP, F.vcu);
            for (int u = F.vcu; u < NB * 32 * NH; u += F.G) {
                if ((u & 3) != hcur) { hcur = u & 3; gmlp_wfrags(F, args, hcur, af); }
                gmlp_unit(F, args, u, af, GP, (u + F.G < NB * 32 * NH) ? u + F.G : -1);
            }
        }
        if (F.vcu < NCHUNKS) {
            const int h0 = (F.vcu >> 6) & 3;
            DnPre P; int hcur = -1;
            dn_prefetch(F, P, F.vcu);
            for (int u = F.vcu; u < NCHUNKS; u += F.G) {
                const int hh = (u >> 6) & 3;
                if (hh != hcur) { __syncthreads(); for (int i = F.tid; i < 3 * 4 * 128; i += NTHREADS) { const int ten = i / 512, j = (i >> 7) & 3, c = i & 127; ((LAS float*)(F.lds + DN_CW))[i] = args.in[6][(size_t)j * 1536 + ten * 512 + hh * HD + c]; } hcur = hh; LDS_WAIT(); __syncthreads(); }
                dn_chunk(F, args, u, P, (u + F.G < NCHUNKS) ? u + F.G : -1);
            }
            (void)h0;
        }
    } SEAM(2);
    if (IN(3)) {
        const int bx = (int)blockIdx.x, nscan = F.G >= 2 ? F.G / 2 : 1;
        if (bx < nscan) {
            const int sid = (nscan % 8 == 0) ? (bx % 8) * (nscan / 8) + bx / 8 : bx;
            for (int it = sid; it < NB * NH * 4; it += nscan) dn_scan(F, it);
            if (F.G < 2) convert_experts(F, args, F.wave, NWAVES);
        } else convert_experts(F, args, (bx - nscan) * NWAVES + F.wave, (F.G - nscan) * NWAVES);
    } SEAM(3);
    if (IN(4)) REP(4) { dn_out(F, args); } SEAM(4);
    if (IN(5)) REP(5) {
        pg8::Gemm g{(const bf16_t*)(F.ws + WS_MIX), (const bf16_t*)(F.ws + WS_WOUT), T, D, D}; pg8::StaticOrder S; S.init(T, D, F.G, (int)blockIdx.x);
        pg8::EpiResid E{args.in[0], (bf16_t*)(F.ws + WS_H)};
        pg8::gemm_phase<pg8::EpiResid, pg8::StaticOrder>(F.lds, g, S, E);
    } SEAM(5);
    if (IN(6)) { route(F, args); } SEAM(6);
    if (IN(8)) { build_tables(F); REP(8) gather_rows(F); } SEAM(8);
    if (IN(9)) {
        if (!IN(8)) build_tables(F);
        const int rtot = ((LAS int*)(F.lds + TB_OFF))[32];
        REP(9) {
        pg8::Gemm g{(const bf16_t*)(F.ws + WS_R3), (const bf16_t*)(F.ws + WS_WGU), rtot, 2048, D / 2}; pg8::MoeOrder S; S.init(rtot, 2048, F.G, (int)blockIdx.x); S.tile_e = (const LAS int*)(F.lds + TB_OFF) + 80;
        pg8::EpiSwiglu E{F.ws + WS_R4, args.in[15]};
        pg8::gemm_phase<pg8::EpiSwiglu, pg8::MoeOrder, true>(F.lds, g, S, E);
        }
    } SEAM(9);
    if (IN(10)) {
        if (!IN(9)) build_tables(F);
        const int rtot = ((LAS int*)(F.lds + TB_OFF))[32];
        REP(10) {
        pg8::Gemm g{(const bf16_t*)(F.ws + WS_R4), (const bf16_t*)(F.ws + WS_WDN), rtot, D, DFF / 2}; pg8::MoeOrder S; S.init(rtot, D, F.G, (int)blockIdx.x); S.tile_e = (const LAS int*)(F.lds + TB_OFF) + 80;
        pg8::EpiDown E{F.ws + WS_YS, args.in[17], (const float*)(F.ws + WS_GSORT)};
        pg8::gemm_phase<pg8::EpiDown, pg8::MoeOrder, true>(F.lds, g, S, E);
        }
    } SEAM(10);
    if (IN(11)) REP(11) { combine(F, args); }
#if defined(DBG_DUMP)
    if (IN(12)) { dbg_dump(F, args, DBG_DUMP); }
#endif
#undef IN
#undef SEAM
}

extern "C" void kernel_launch(void* const* d_in, const int* in_sizes, int n_in, void* d_out, int out_size, void* d_ws, size_t ws_size, hipStream_t stream) {
    static int grid = 0;
    if (grid == 0) {
        if (n_in != 19 || out_size != T * D || ws_size < WS_END) { fprintf(stderr, "kernel_launch: unexpected shapes (n_in %d, out %d, ws %zu)\n", n_in, out_size, ws_size); grid = -1; return; }
        int dev = 0, cus = 0, per_cu = 0;
        if (hipGetDevice(&dev) != hipSuccess || hipDeviceGetAttribute(&cus, hipDeviceAttributeMultiprocessorCount, dev) != hipSuccess) { grid = -1; return; }
        if (hipOccupancyMaxActiveBlocksPerMultiprocessor(&per_cu, (const void*)fwd, NTHREADS, 0) != hipSuccess || per_cu < 1) fprintf(stderr, "kernel_launch: occupancy query reports %d\n", per_cu);
        (void)hipGetLastError();
        grid = cus;
    }
    if (grid < 0) return;
    (void)hipMemsetAsync((char*)d_ws + WS_CTL, 0, CTL_ZERO_BYTES, stream);
    Args a{};
    for (int i = 0; i < 19; ++i) a.in[i] = (const float*)d_in[i];
    a.out = (float*)d_out; a.ws = (unsigned char*)d_ws;
#if MK_PER_PHASE
    for (int p = 0; p < NPHASES; ++p) {
#if defined(DBG_DUMP)
        if (p > DBG_LAST) continue;
#endif
        a.ph_lo = p; a.ph_hi = p + 1; hipLaunchKernelGGL(fwd, dim3(grid), dim3(NTHREADS), 0, stream, a); }
#if defined(DBG_DUMP)
    a.ph_lo = 12; a.ph_hi = 13; hipLaunchKernelGGL(fwd, dim3(grid), dim3(NTHREADS), 0, stream, a);
#endif
#else
    a.ph_lo = 0; a.ph_hi = NPHASES; hipLaunchKernelGGL(fwd, dim3(grid), dim3(NTHREADS), 0, stream, a);
#endif
}
```

```cpp
#include <hip/hip_runtime.h>
#include <cstdio>
#include <cstdint>

#ifndef MK_PER_PHASE
#define MK_PER_PHASE 0
#endif

#define LAS __attribute__((address_space(3)))
#define GAS __attribute__((address_space(1)))
typedef unsigned short bf16_t;
typedef short bf16x8 __attribute__((ext_vector_type(8)));
typedef float f32x4 __attribute__((ext_vector_type(4)));
typedef float f32x2 __attribute__((ext_vector_type(2)));
typedef unsigned u32x4 __attribute__((ext_vector_type(4)));
typedef unsigned u32x2 __attribute__((ext_vector_type(2)));
typedef int i32x4 __attribute__((ext_vector_type(4)));
typedef int i32x8 __attribute__((ext_vector_type(8)));

constexpr int NB = 8, SEQ = 4096, D = 1024, T = NB * SEQ;
constexpr int DIN = 3080, NPROJ = 3072;
constexpr int NE = 32, TOPK = 4, DFF = 1024;
constexpr int NH = 4, HD = 128, GMC = 128, DNC = 64;
constexpr int NCH = SEQ / DNC;
constexpr int NCHUNKS = NB * NH * NCH;
constexpr int RMAX = T * TOPK + NE * 256;
constexpr float EPS = 1e-6f;
constexpr int NWAVES = 8, NTHREADS = 512;

constexpr size_t MiB = 1u << 20;
constexpr size_t WS_CTL = 0, CTL_ZERO_BYTES = 32768;
constexpr size_t WS_AB = 1 * MiB;
constexpr size_t WS_EIDX = 2 * MiB;
constexpr size_t WS_GATEW = 2 * MiB + 512 * 1024;
constexpr size_t WS_ROWOF = 3 * MiB;
constexpr size_t WS_EPOS = 3 * MiB + 512 * 1024;
constexpr size_t WS_GSORT = 4 * MiB;
constexpr size_t WS_LIST = 5 * MiB;
constexpr size_t WS_RWT = 9 * MiB;
constexpr size_t WS_GLAST = 10 * MiB;
constexpr size_t WS_WIN = 16 * MiB;
constexpr size_t WS_WOUT = 22 * MiB;
constexpr size_t WS_WGU = 24 * MiB;
constexpr size_t WS_WDN = 152 * MiB;
constexpr size_t WS_HN8 = 88 * MiB;
constexpr size_t WS_H = 216 * MiB;
constexpr size_t WS_R3 = 344 * MiB;
constexpr size_t WS_R4 = 616 * MiB;
constexpr size_t WS_Y = WS_R4;
constexpr size_t WS_WC = WS_R4;
constexpr size_t WS_UC = WS_R4 + 32 * MiB;
constexpr size_t WS_QD = WS_R4 + 64 * MiB;
constexpr size_t WS_KET = WS_R4 + 96 * MiB;
constexpr size_t WS_AT = WS_R4 + 128 * MiB;
constexpr size_t WS_MIX = WS_R4 + 144 * MiB;
constexpr size_t WS_O = WS_R4 + 208 * MiB;
constexpr size_t WS_HN = 888 * MiB;
constexpr size_t WS_YS = WS_R3 + 136 * MiB;
constexpr size_t WS_END = 952 * MiB;
constexpr int CW_BAR = 0;
constexpr int CW_CNT = 4096;

constexpr int RING_BYTES = 155648;
constexpr int LDSCTL_OFF = RING_BYTES;
constexpr int LDS_BYTES = RING_BYTES + 1024;

#define LDS_WAIT() asm volatile("s_waitcnt lgkmcnt(0)" ::: "memory")
#define VM_WAIT() asm volatile("s_waitcnt vmcnt(0)" ::: "memory")
#define LDS_BAR() do { asm volatile("s_waitcnt lgkmcnt(0)" ::: "memory"); __builtin_amdgcn_s_barrier(); asm volatile("" ::: "memory"); } while (0)
typedef __bf16 bf16x2_t __attribute__((ext_vector_type(2)));
__device__ __forceinline__ unsigned cvt_pk_bf16(float lo, float hi) { const bf16x2_t r = __builtin_convertvector((f32x2){lo, hi}, bf16x2_t); return __builtin_bit_cast(unsigned, r); }
__device__ __forceinline__ float bf2f(unsigned short b) { return __uint_as_float(((unsigned)b) << 16); }
__device__ __forceinline__ float bflo(unsigned w) { return __uint_as_float(w << 16); }
__device__ __forceinline__ float bfhi(unsigned w) { return __uint_as_float(w & 0xffff0000u); }
__device__ __forceinline__ bf16_t f2bf(float f) { return (bf16_t)(cvt_pk_bf16(f, 0.f) & 0xffffu); }
__device__ __forceinline__ unsigned cvt4_fp8(float a, float b, float c, float d) { int r = __builtin_amdgcn_cvt_pk_fp8_f32(a, b, 0, false); r = __builtin_amdgcn_cvt_pk_fp8_f32(c, d, r, true); return (unsigned)r; }
constexpr float W8_SCALE = 32.0f, W8_INV = 1.0f / 32.0f;
__device__ __forceinline__ float wave_sum(float v) {
#pragma unroll
    for (int o = 1; o < 64; o <<= 1) v += __shfl_xor(v, o);
    return v;
}
__device__ __forceinline__ float sigmoid_f(float v) { return __builtin_amdgcn_rcpf(1.0f + __builtin_amdgcn_exp2f(-1.44269504f * v)); }
__device__ __forceinline__ float silu_f(float v) { return v * sigmoid_f(v); }
__device__ __forceinline__ f32x2 gelu_pk(f32x2 v) {
    const f32x2 av = __builtin_elementwise_abs(v), d = av * 0.2316418882f + 1.0f;
    f32x2 t; t.x = __builtin_amdgcn_rcpf(d.x); t.y = __builtin_amdgcn_rcpf(d.y);
    f32x2 q = t * 0.5307027145f + (-0.7265760135f); q = q * t + 0.7107068705f; q = q * t + (-0.142248368f); q = q * t + 0.127414796f; q = q * t;
    const f32x2 s = (v * v) * (-0.72134752044f);
    f32x2 e; e.x = __builtin_amdgcn_exp2f(s.x); e.y = __builtin_amdgcn_exp2f(s.y);
    const f32x2 m = v * (q * e), r = v - m;
    f32x2 o; o.x = v.x < 0.f ? m.x : r.x; o.y = v.y < 0.f ? m.y : r.y; return o;
}

#define XB_TMO      128
#define XB_XCNT(j)  (256  + 64 * (j))
#define XB_XSUB(j)  (1280 + 64 * (j))
#define XB_XGEN(j)  (2304 + 64 * (j))
#define XB_TOP      3328
#define XB_TOPGEN   3392
#define XCD_BAR_WORDS 3456
#define XB_SPIN_CAP (1u << 18)
__device__ __forceinline__ unsigned xb_ld(unsigned* p)              { return __hip_atomic_load(p, __ATOMIC_RELAXED, __HIP_MEMORY_SCOPE_AGENT); }
__device__ __forceinline__ unsigned xb_add(unsigned* p, unsigned v) { return __hip_atomic_fetch_add(p, v, __ATOMIC_RELAXED, __HIP_MEMORY_SCOPE_AGENT); }
__device__ __forceinline__ unsigned xb_xcc_id() { return (unsigned)__builtin_amdgcn_s_getreg((3 << 11) | 20) & 0xFu; }
#define XB_SPIN(cond, bar) do { unsigned _sp = 0; while (cond) { __builtin_amdgcn_s_sleep(1); \
    if ((++_sp & 255u) == 0u) { if (xb_ld(&(bar)[XB_TMO])) break; if (_sp > XB_SPIN_CAP) { atomicAdd(&(bar)[XB_TMO], 1u); break; } } } } while (0)
struct XcdBarrier { unsigned* bar; unsigned x; volatile LAS unsigned* st; };
__device__ __forceinline__ XcdBarrier xcd_barrier_post(unsigned* bar, volatile LAS unsigned* st) {
    XcdBarrier b; b.bar = bar; b.x = xb_xcc_id(); b.st = st;
    if (threadIdx.x == 0) (void)xb_add(&bar[XB_XCNT(b.x)], 1u);
    return b;
}
__device__ __forceinline__ void xcd_barrier_complete(unsigned* bar, unsigned x, unsigned& nloc, unsigned& nx) {
    const unsigned G = gridDim.x * gridDim.y * gridDim.z;
    unsigned sum, cnt, mine, sp = 0u;
    for (;;) {
        sum = 0u; cnt = 0u; mine = 0u;
#pragma unroll
        for (unsigned j = 0; j < 16; ++j) { const unsigned c = xb_ld(&bar[XB_XCNT(j)]); sum += c; cnt += (c > 0u) ? 1u : 0u; mine = (j == x) ? c : mine; }
        if (sum == G) break;
        __builtin_amdgcn_s_sleep(1);
        if ((++sp & 255u) == 0u) { if (xb_ld(&bar[XB_TMO])) break; if (sp > XB_SPIN_CAP) { atomicAdd(&bar[XB_TMO], 1u); break; } }
    }
    nloc = mine > 0u ? mine : 1u; nx = cnt > 0u ? cnt : 1u;
}
__device__ __forceinline__ void xcd_barrier(const XcdBarrier& b) {
    asm volatile("s_waitcnt vmcnt(0)" ::: "memory");
    __syncthreads();
    if (threadIdx.x == 0) {
        unsigned* bar = b.bar;
        __builtin_amdgcn_s_waitcnt(0);
        unsigned nloc = b.st[0], nx = b.st[1];
        if (nloc == 0u) { xcd_barrier_complete(bar, b.x, nloc, nx); b.st[0] = nloc; b.st[1] = nx; }
        const unsigned old = xb_add(&bar[XB_XSUB(b.x)], 1u);
        const unsigned gen = old / nloc;
        if (old + 1u == (gen + 1u) * nloc) {
            __builtin_amdgcn_fence(__ATOMIC_RELEASE, "agent");
            asm volatile("s_waitcnt vmcnt(0)" ::: "memory");
            const unsigned og = xb_add(&bar[XB_TOP], 1u);
            const unsigned tg = og / nx;
            if (og + 1u == (tg + 1u) * nx) xb_add(&bar[XB_TOPGEN], 1u);
            else XB_SPIN(xb_ld(&bar[XB_TOPGEN]) == tg, bar);
            __builtin_amdgcn_fence(__ATOMIC_ACQUIRE, "agent");
            xb_add(&bar[XB_XGEN(b.x)], 1u);
            asm volatile("s_waitcnt vmcnt(0)" ::: "memory");
        } else {
            XB_SPIN(xb_ld(&bar[XB_XGEN(b.x)]) == gen, bar);
            __builtin_amdgcn_fence(__ATOMIC_ACQUIRE, "agent");
            asm volatile("s_waitcnt vmcnt(0)" ::: "memory");
        }
    }
    __syncthreads();
}

namespace pg8 {
constexpr int BM = 256, BK = 64, HALF = 128, HTB = HALF * BK * 2, STAGE_BYTES = 8 * HTB, NXCD = 8, WGM = 8;
__host__ __device__ __forceinline__ int lds_byte(int r, int c) { const int st = (r >> 4) * 2 + (c >> 5), rr = r & 15, cc = c & 31, ob = rr * 64 + cc * 2; return st * 1024 + (ob ^ (((ob >> 9) & 1) << 5)); }
__host__ __device__ __forceinline__ void stage_rc(int b, int& R, int& C) { const int st = b / 1024, sb = b % 1024, swz = sb ^ (((sb >> 9) & 1) << 5); R = (st >> 1) * 16 + swz / 64; C = (st & 1) * 32 + (swz % 64) / 2; }
__host__ __device__ __forceinline__ int perm32(int rho) { const int n = rho >> 4, i = rho & 15; return 8 * (i >> 2) + 4 * n + (i & 3); }

constexpr int EPI_LDS = 135168;
struct Unit { int pm, pn, pb; };
struct Gemm { const bf16_t* A; const bf16_t* Bt; int M, N, K; };

struct StaticOrder {
    int nM, nN, nwg, G, c;
    __device__ void init(int M, int N, int G_, int c_) { nM = M / BM; nN = N / BM; nwg = nM * nN; G = G_; c = c_; }
    __device__ bool next(int i, Unit& u) const {
        const long L = (long)i * G + c; if (L >= nwg) return false;
        int wgid = (int)L; { const int q = nwg / NXCD, r = nwg % NXCD, xcd = wgid % NXCD, off = wgid / NXCD; wgid = (xcd < r ? xcd * (q + 1) : r * (q + 1) + (xcd - r) * q) + off; }
        const int nig = WGM * nN, gid = wgid / nig, fm = gid * WGM, gsz = (nM - fm) < WGM ? (nM - fm) : WGM;
        u.pm = fm + ((wgid % nig) % gsz); u.pn = (wgid % nig) / gsz; u.pb = u.pn; return true;
    }
};
struct MoeOrder : StaticOrder {
    const LAS int* tile_e;
    __device__ bool next(int i, Unit& u) const { if (!StaticOrder::next(i, u)) return false; u.pb = __builtin_amdgcn_readfirstlane(tile_e[u.pm]) * nN + u.pn; return true; }
};

template <class Epi, class Sched, bool FP8 = false>
__device__ __forceinline__ void gemm_phase(LAS unsigned char* lds, const Gemm g, const Sched& S, const Epi& E) {
    const int tid = threadIdx.x, wid = __builtin_amdgcn_readfirstlane(tid >> 6), lane = tid & 63, wr = wid >> 2, wc = wid & 3, fr = lane & 15, fq = lane >> 4;
    const int K = g.K, nt = K / BK;
    unsigned voffA[2], voffB[2];
#pragma unroll
    for (int i = 0; i < 2; ++i) { int R, C; stage_rc(tid * 16 + i * 8192, R, C); const int Rb = Epi::PERM ? ((R & ~31) + perm32(R & 31)) : R;
        voffA[i] = (unsigned)(R * K + C) * 2u; voffB[i] = (unsigned)(Rb * K + C) * 2u; }
    const size_t kstep = (size_t)(BK * 2);
    const size_t hstep = (size_t)HALF * K * 2;
    const size_t tstep = 2 * hstep;
    const unsigned ldsw = (unsigned)wid * 1024u;
    const int aoff = lds_byte(wr * 64 + fr, fq * 8), boff = lds_byte(wc * 32 + fr, fq * 8);
    LAS unsigned char* ldsA = lds + aoff; LAS unsigned char* ldsB = lds + 4 * HTB + boff;
    asm volatile("" : "+v"(ldsA)); asm volatile("" : "+v"(ldsB));
#define PG8_SA(b, h) (((b) * 2 + (h)) * HTB)
#define PG8_SB(b, h) ((4 + (b) * 2 + (h)) * HTB)
#define PG8_STAGE(bufoff, gbase, voff) do { _Pragma("unroll") for (int _i = 0; _i < 2; ++_i) \
        __builtin_amdgcn_global_load_lds((const unsigned*)((const char*)(gbase) + (voff)[_i]), (LAS unsigned*)(lds + (bufoff) + ldsw + _i * 8192), 16, 0, 0); } while (0)
#define PG8_LD2(dst, addr) do { if constexpr (FP8) { const i32x4 lo_ = *(const LAS i32x4*)(addr), hi_ = *(const LAS i32x4*)((addr) + 1024); (dst).w = __builtin_shufflevector(lo_, hi_, 0, 1, 2, 3, 4, 5, 6, 7); } \
        else { (dst).h[0] = *(const LAS bf16x8*)(addr); (dst).h[1] = *(const LAS bf16x8*)((addr) + 1024); } } while (0)
#define PG8_LDA(dst, b, h) do { _Pragma("unroll") for (int m = 0; m < 4; ++m) PG8_LD2(dst[m], ldsA + PG8_SA(b, h) + m * 2048); } while (0)
#define PG8_LDB(dst, b, h) do { _Pragma("unroll") for (int n = 0; n < 2; ++n) PG8_LD2(dst[n], ldsB + PG8_SA(b, h) + n * 2048); } while (0)
#define PG8_MMA(ai, bj, At, Bt) do { __builtin_amdgcn_s_setprio(1); \
        if constexpr (FP8) { _Pragma("unroll") for (int m = 0; m < 4; ++m) _Pragma("unroll") for (int n = 0; n < 2; ++n) \
            asm volatile("v_mfma_f32_16x16x128_f8f6f4 %0, %1, %2, %0" : "+v"(acc[ai][bj][m][n]) : "v"(Bt[n].w), "v"(At[m].w)); } \
        else { _Pragma("unroll") for (int m = 0; m < 4; ++m) _Pragma("unroll") for (int n = 0; n < 2; ++n) _Pragma("unroll") for (int k = 0; k < 2; ++k) \
            acc[ai][bj][m][n] = __builtin_amdgcn_mfma_f32_16x16x32_bf16(Bt[n].h[k], At[m].h[k], acc[ai][bj][m][n], 0, 0, 0); } \
        __builtin_amdgcn_s_setprio(0); } while (0)
#define PG8_WAIT_V(n) asm volatile("s_waitcnt vmcnt(" #n ")" ::: "memory")
#define PG8_WAIT_L(n) asm volatile("s_waitcnt lgkmcnt(" #n ")" ::: "memory")
#define PG8_BAR __builtin_amdgcn_s_barrier()
#define PG8_SCHED __builtin_amdgcn_sched_barrier(0)
    Unit cur, nxt; int ui = 0;
    if (!S.next(0, cur)) return;
    f32x4 acc[2][2][4][2];
#pragma unroll
    for (int a = 0; a < 2; ++a)
#pragma unroll
        for (int b = 0; b < 2; ++b)
#pragma unroll
            for (int m = 0; m < 4; ++m)
#pragma unroll
                for (int n = 0; n < 2; ++n) acc[a][b][m][n] = (f32x4){0.f, 0.f, 0.f, 0.f};
    union Frag { bf16x8 h[2]; i32x8 w; };
    Frag At[4], B0[2], B1[2];
    const char* cA = (const char*)g.A + (size_t)cur.pm * tstep; const char* cB = (const char*)g.Bt + (size_t)cur.pb * tstep;
    PG8_STAGE(PG8_SB(0, 0), cB, voffB); PG8_STAGE(PG8_SB(0, 1), cB + hstep, voffB); PG8_STAGE(PG8_SA(0, 0), cA, voffA); PG8_STAGE(PG8_SA(0, 1), cA + hstep, voffA);
    if (wr == 1) PG8_BAR;
    PG8_WAIT_V(2); PG8_BAR;
    PG8_STAGE(PG8_SB(1, 0), cB + kstep, voffB); PG8_STAGE(PG8_SA(1, 0), cA + kstep, voffA); PG8_STAGE(PG8_SB(1, 1), cB + hstep + kstep, voffB);
    PG8_WAIT_V(6); PG8_BAR;
    for (;;) {
        const bool has_next = S.next(ui + 1, nxt);
        const char* nA = has_next ? (const char*)g.A + (size_t)nxt.pm * tstep : cA; const char* nB = has_next ? (const char*)g.Bt + (size_t)nxt.pb * tstep : cB;
        for (int t = 0; t < nt; t += 2) {
            const bool last = (t == nt - 2);
            if constexpr (Epi::HAS_PREFETCH) { if (t == 0 && wid == 0) E.prefetch(lds + EPI_LDS + (ui & 1) * 2048, cur, lane); }
            const char* a1 = cA + (size_t)(t + 1) * kstep;
            const char* a2 = last ? nA : cA + (size_t)(t + 2) * kstep; const char* b2 = last ? nB : cB + (size_t)(t + 2) * kstep;
            const char* a3 = a2 + kstep; const char* b3 = b2 + kstep;
            PG8_LDB(B0, 0, 0); PG8_LDB(B1, 0, 1); PG8_SCHED; PG8_LDA(At, 0, 0); PG8_STAGE(PG8_SA(1, 1), a1 + hstep, voffA);
            PG8_WAIT_V(8); PG8_WAIT_L(0); PG8_BAR; PG8_MMA(0, 0, At, B0); PG8_MMA(0, 1, At, B1); PG8_BAR; PG8_SCHED;
            PG8_LDA(At, 0, 1); PG8_STAGE(PG8_SB(0, 0), b2, voffB); PG8_STAGE(PG8_SB(0, 1), b2 + hstep, voffB); PG8_STAGE(PG8_SA(0, 0), a2, voffA);
            PG8_WAIT_V(8); PG8_WAIT_L(0); PG8_BAR; PG8_MMA(1, 0, At, B0); PG8_MMA(1, 1, At, B1); PG8_BAR; PG8_SCHED;
            PG8_LDB(B0, 1, 0); PG8_LDB(B1, 1, 1); PG8_SCHED; PG8_LDA(At, 1, 0); PG8_STAGE(PG8_SA(0, 1), a2 + hstep, voffA);
            PG8_WAIT_V(8); PG8_WAIT_L(0); PG8_BAR; PG8_MMA(0, 0, At, B0); PG8_MMA(0, 1, At, B1); PG8_BAR; PG8_SCHED;
            PG8_LDA(At, 1, 1); PG8_STAGE(PG8_SB(1, 0), b3, voffB); PG8_STAGE(PG8_SB(1, 1), b3 + hstep, voffB); PG8_STAGE(PG8_SA(1, 0), a3, voffA);
            PG8_WAIT_V(8); PG8_WAIT_L(0); PG8_BAR; PG8_MMA(1, 0, At, B0); PG8_MMA(1, 1, At, B1); PG8_BAR; PG8_SCHED;
        }
        if (wr == 0) PG8_BAR;
        if constexpr (FP8) asm volatile("s_nop 15\n\ts_nop 15" ::: "memory");
        { int fr_ = fr, fq_ = fq; asm volatile("" : "+v"(fr_), "+v"(fq_));
          E(acc, cur, wr, wc, fr_, fq_, (const LAS float*)(lds + EPI_LDS + (ui & 1) * 2048)); }
        if (!has_next) break;
#pragma unroll
        for (int a = 0; a < 2; ++a)
#pragma unroll
            for (int b = 0; b < 2; ++b)
#pragma unroll
                for (int m = 0; m < 4; ++m)
#pragma unroll
                    for (int n = 0; n < 2; ++n) { acc[a][b][m][n] = (f32x4){0.f, 0.f, 0.f, 0.f}; if constexpr (FP8) asm volatile("" : "+v"(acc[a][b][m][n])); }
        cur = nxt; cA = nA; cB = nB; ++ui;
        if (wr == 1) PG8_BAR;
    }
    PG8_WAIT_V(0);
    PG8_BAR;
#undef PG8_SA
#undef PG8_SB
#undef PG8_STAGE
#undef PG8_LDA
#undef PG8_LDB
#undef PG8_MMA
#undef PG8_LD2
#undef PG8_WAIT_V
#undef PG8_WAIT_L
#undef PG8_BAR
#undef PG8_SCHED
}

struct EpiProj {
    static constexpr bool PERM = true, HAS_PREFETCH = false;
    bf16_t* O;
    __device__ __forceinline__ void operator()(const f32x4 (&acc)[2][2][4][2], const Unit& u, int wr, int wc, int fr, int fq, const LAS float*) const {
        const int row0 = u.pm * BM + wr * 64 + fr, col0 = u.pn * BM + wc * 32 + 8 * fq;
#pragma unroll
        for (int ai = 0; ai < 2; ++ai)
#pragma unroll
            for (int m = 0; m < 4; ++m) { bf16_t* rowp = O + (size_t)(row0 + ai * HALF + m * 16) * NPROJ + col0;
#pragma unroll
                for (int bj = 0; bj < 2; ++bj) { const f32x4 v0 = acc[ai][bj][m][0], v1 = acc[ai][bj][m][1];
                    u32x4 w; w.x = cvt_pk_bf16(v0[0], v0[1]); w.y = cvt_pk_bf16(v0[2], v0[3]); w.z = cvt_pk_bf16(v1[0], v1[1]); w.w = cvt_pk_bf16(v1[2], v1[3]);
                    *(u32x4*)(rowp + bj * HALF) = w; } }
    }
};
struct EpiResid {
    static constexpr bool PERM = true, HAS_PREFETCH = false;
    const float* X; bf16_t* H;
    __device__ __forceinline__ void operator()(const f32x4 (&acc)[2][2][4][2], const Unit& u, int wr, int wc, int fr, int fq, const LAS float*) const {
        const int row0 = u.pm * BM + wr * 64 + fr, col0 = u.pn * BM + wc * 32 + 8 * fq;
#pragma unroll
        for (int ai = 0; ai < 2; ++ai)
#pragma unroll
            for (int m = 0; m < 4; ++m) { const size_t off = (size_t)(row0 + ai * HALF + m * 16) * D + col0;
#pragma unroll
                for (int bj = 0; bj < 2; ++bj) { const f32x4 v0 = acc[ai][bj][m][0] + *(const f32x4*)(X + off + bj * HALF), v1 = acc[ai][bj][m][1] + *(const f32x4*)(X + off + bj * HALF + 4);
                    u32x4 w; w.x = cvt_pk_bf16(v0[0], v0[1]); w.y = cvt_pk_bf16(v0[2], v0[3]); w.z = cvt_pk_bf16(v1[0], v1[1]); w.w = cvt_pk_bf16(v1[2], v1[3]);
                    *(u32x4*)(H + off + bj * HALF) = w; } }
    }
};
struct EpiSwiglu {
    static constexpr bool PERM = true, HAS_PREFETCH = true;
    unsigned char* O; const float* bgu;
    __device__ __forceinline__ void prefetch(LAS unsigned char* area, const Unit& u, int lane) const {
        const float* src = bgu + (size_t)(u.pb >> 3) * 2048 + u.pn * HALF + (lane < 32 ? 4 * lane : 1024 + 4 * (lane - 32));
        __builtin_amdgcn_global_load_lds((const unsigned*)src, (LAS unsigned*)area, 16, 0, 0);
    }
    __device__ __forceinline__ void operator()(const f32x4 (&acc)[2][2][4][2], const Unit& u, int wr, int wc, int fr, int fq, const LAS float* bl) const {
        const int row0 = u.pm * BM + wr * 64 + fr, jl = wc * 32 + 8 * fq, j0 = u.pn * HALF + jl;
        f32x4 bgv[2], buv[2];
#pragma unroll
        for (int n = 0; n < 2; ++n) { bgv[n] = *(const LAS f32x4*)(bl + jl + 4 * n); buv[n] = *(const LAS f32x4*)(bl + 128 + jl + 4 * n); }
#pragma unroll
        for (int ai = 0; ai < 2; ++ai)
#pragma unroll
            for (int m = 0; m < 4; ++m) { unsigned char* rowp = O + (size_t)(row0 + ai * HALF + m * 16) * DFF + j0;
                u32x2 w;
#pragma unroll
                for (int n = 0; n < 2; ++n) { const f32x4 g4 = acc[ai][0][m][n] * W8_INV + bgv[n], u4 = acc[ai][1][m][n] * W8_INV + buv[n]; f32x4 r;
#pragma unroll
                    for (int j = 0; j < 4; ++j) { const float ga = fminf(g4[j], 7.0f), ua = fminf(fmaxf(u4[j], -7.0f), 7.0f);
                        r[j] = (ua + 1.0f) * ga * __builtin_amdgcn_rcpf(1.0f + __builtin_amdgcn_exp2f(-2.4554669f * ga)); }
                    w[n] = cvt4_fp8(r[0], r[1], r[2], r[3]); }
                *(u32x2*)rowp = w; }
    }
};
struct EpiDown {
    static constexpr bool PERM = true, HAS_PREFETCH = true;
    unsigned char* O; const float* bdn; const float* gsort;
    __device__ __forceinline__ void prefetch(LAS unsigned char* area, const Unit& u, int lane) const {
        __builtin_amdgcn_global_load_lds((const unsigned*)(bdn + (size_t)(u.pb >> 2) * D + u.pn * BM + 4 * lane), (LAS unsigned*)area, 16, 0, 0);
        __builtin_amdgcn_global_load_lds((const unsigned*)(gsort + (size_t)u.pm * BM + 4 * lane), (LAS unsigned*)(area + 1024), 16, 0, 0);
    }
    __device__ __forceinline__ void operator()(const f32x4 (&acc)[2][2][4][2], const Unit& u, int wr, int wc, int fr, int fq, const LAS float* bl) const {
        const int rl = wr * 64 + fr, cl = wc * 32 + 8 * fq, row0 = u.pm * BM + rl, col0 = u.pn * BM + cl;
        f32x4 bv[2][2]; float gw[2][4];
#pragma unroll
        for (int bj = 0; bj < 2; ++bj) { bv[bj][0] = *(const LAS f32x4*)(bl + cl + bj * HALF); bv[bj][1] = *(const LAS f32x4*)(bl + cl + bj * HALF + 4); }
#pragma unroll
        for (int ai = 0; ai < 2; ++ai)
#pragma unroll
            for (int m = 0; m < 4; ++m) gw[ai][m] = bl[256 + rl + ai * HALF + m * 16];
#pragma unroll
        for (int ai = 0; ai < 2; ++ai)
#pragma unroll
            for (int m = 0; m < 4; ++m) { const int r = row0 + ai * HALF + m * 16; const float g = gw[ai][m] * W8_INV; unsigned char* rowp = O + (size_t)r * D + col0;
#pragma unroll
                for (int bj = 0; bj < 2; ++bj) { const f32x4 v0 = acc[ai][bj][m][0] * g + bv[bj][0] * gw[ai][m], v1 = acc[ai][bj][m][1] * g + bv[bj][1] * gw[ai][m];
                    u32x2 w; w.x = cvt4_fp8(v0[0], v0[1], v0[2], v0[3]); w.y = cvt4_fp8(v1[0], v1[1], v1[2], v1[3]);
                    *(u32x2*)(rowp + bj * HALF) = w; } }
    }
};
}

struct Args {
    const float* in[19]; float* out; unsigned char* ws; int ph_lo, ph_hi;
};
struct Frame {
    LAS unsigned char* lds;
    int tid, lane, wave, G, vcu;
    unsigned char* ws;
};
#define MFMA16(a, b, c) __builtin_amdgcn_mfma_f32_16x16x32_bf16((a), (b), (c), 0, 0, 0)

__device__ __forceinline__ void tr_item(const float* src, size_t ldw, bf16_t* dst, LAS float* scr, int lane) {
    f32x4 v[16];
    const int kq = lane >> 4, n4 = 4 * (lane & 15);
#pragma unroll
    for (int i = 0; i < 16; ++i) v[i] = *(const f32x4*)(src + (size_t)(4 * i + kq) * ldw + n4);
#pragma unroll
    for (int i = 0; i < 16; ++i) { LAS float* s = scr + (4 * i + kq) * 65 + n4; s[0] = v[i][0]; s[1] = v[i][1]; s[2] = v[i][2]; s[3] = v[i][3]; }
    LDS_WAIT();
    const int c = lane & 7;
#pragma unroll
    for (int r = 0; r < 8; ++r) { const int n = 8 * r + (lane >> 3); const LAS float* s = scr + (8 * c) * 65 + n;
        u32x4 o; o.x = cvt_pk_bf16(s[0 * 65], s[1 * 65]); o.y = cvt_pk_bf16(s[2 * 65], s[3 * 65]); o.z = cvt_pk_bf16(s[4 * 65], s[5 * 65]); o.w = cvt_pk_bf16(s[6 * 65], s[7 * 65]);
        *(u32x4*)(dst + (size_t)n * 1024 + 8 * c) = o; }
    LDS_WAIT();
}
__device__ __forceinline__ void tr_item8(const float* src, size_t ldw, unsigned char* dst, LAS float* scr, int lane) {
    f32x4 v[16];
    const int kq = lane >> 3, n4 = 4 * (lane & 7);
#pragma unroll
    for (int i = 0; i < 16; ++i) v[i] = *(const f32x4*)(src + (size_t)(8 * i + kq) * ldw + n4);
#pragma unroll
    for (int i = 0; i < 16; ++i) { LAS float* s = scr + (8 * i + kq) * 33 + n4; s[0] = v[i][0]; s[1] = v[i][1]; s[2] = v[i][2]; s[3] = v[i][3]; }
    LDS_WAIT();
    const int c = lane >> 3, nn = lane & 7;
#pragma unroll
    for (int r = 0; r < 4; ++r) { const int n = 8 * r + nn; const LAS float* s = scr + (16 * c) * 33 + n;
        u32x4 o;
#pragma unroll
        for (int q = 0; q < 4; ++q) o[q] = cvt4_fp8(s[(4 * q) * 33] * W8_SCALE, s[(4 * q + 1) * 33] * W8_SCALE, s[(4 * q + 2) * 33] * W8_SCALE, s[(4 * q + 3) * 33] * W8_SCALE);
        *(u32x4*)(dst + (size_t)n * 1024 + 16 * c) = o; }
    LDS_WAIT();
}
__device__ __forceinline__ void p0_prologue(const Frame& F, const Args& a) {
    LAS float* scr = (LAS float*)(F.lds + F.wave * 16896);
    const int gw = F.vcu * NWAVES + F.wave, NGW = F.G * NWAVES;
    const float* w_in = a.in[2]; const float* w_out = a.in[10]; const float* w_gu = a.in[14]; const float* w_dn = a.in[16]; const float* rw = a.in[12];
    bf16_t* WIN = (bf16_t*)(F.ws + WS_WIN); bf16_t* WOUT = (bf16_t*)(F.ws + WS_WOUT); unsigned char* WGU = F.ws + WS_WGU; unsigned char* WDN = F.ws + WS_WDN; bf16_t* RWT = (bf16_t*)(F.ws + WS_RWT);
    constexpr int I_IN = 16 * 48, I_OUT = 16 * 16, NITEMS = I_IN + I_OUT;
    for (int it = gw; it < NITEMS; it += NGW) {
        int r = it;
        if (r < I_IN) { const int kb = r / 48, nb = r % 48; tr_item(w_in + (size_t)(64 * kb) * DIN + 64 * nb, DIN, WIN + (size_t)(64 * nb) * 1024 + 64 * kb, scr, F.lane); continue; } r -= I_IN;
        { const int kb = r / 16, nb = r % 16; tr_item(w_out + (size_t)(64 * kb) * D + 64 * nb, D, WOUT + (size_t)(64 * nb) * 1024 + 64 * kb, scr, F.lane); }
    }
    for (int i = gw * 64 + F.lane; i < 32 * 1024; i += NGW * 64) { const int e = i >> 10, k = i & 1023; RWT[i] = f2bf(rw[(size_t)k * 32 + e]); }
    const float* x = a.in[0]; const float* g1 = a.in[1];
    bf16_t* Y = (bf16_t*)(F.ws + WS_Y); float* AB = (float*)(F.ws + WS_AB);
    f32x4 gv[4]; f32x4 wab[4][4][2];
#pragma unroll
    for (int j = 0; j < 4; ++j) { gv[j] = *(const f32x4*)(g1 + 4 * F.lane + 256 * j);
#pragma unroll
        for (int i = 0; i < 4; ++i) { const float* p = w_in + (size_t)(4 * F.lane + 256 * j + i) * DIN + NPROJ; wab[j][i][0] = *(const f32x4*)p; wab[j][i][1] = *(const f32x4*)(p + 4); } }
    f32x4 v[4];
    if (gw < T) {
#pragma unroll
        for (int j = 0; j < 4; ++j) v[j] = ((const f32x4*)(x + (size_t)gw * D) + F.lane)[64 * j];
    }
    for (int m = gw; m < T; m += NGW) {
        f32x4 vn[4];
        if (m + NGW < T) {
#pragma unroll
            for (int j = 0; j < 4; ++j) vn[j] = ((const f32x4*)(x + (size_t)(m + NGW) * D) + F.lane)[64 * j];
        }
        float ss = 0.f;
#pragma unroll
        for (int j = 0; j < 4; ++j) ss += (v[j][0] * v[j][0] + v[j][1] * v[j][1]) + (v[j][2] * v[j][2] + v[j][3] * v[j][3]);
        const float rstd = rsqrtf(wave_sum(ss) * (1.0f / D) + EPS);
        f32x4 p0 = (f32x4){0.f, 0.f, 0.f, 0.f}, p1 = p0;
        u32x2* yo = (u32x2*)(Y + (size_t)m * D) + F.lane;
#pragma unroll
        for (int j = 0; j < 4; ++j) { const f32x4 y = v[j] * rstd * gv[j];
#pragma unroll
            for (int i = 0; i < 4; ++i) { p0 += wab[j][i][0] * y[i]; p1 += wab[j][i][1] * y[i]; }
            u32x2 w; w.x = cvt_pk_bf16(y[0], y[1]); w.y = cvt_pk_bf16(y[2], y[3]); yo[64 * j] = w; }
        const bool b0 = F.lane & 1, b1 = F.lane & 2, b2 = F.lane & 4;
        f32x4 k4 = b0 ? p1 : p0, s4 = b0 ? p0 : p1;
#pragma unroll
        for (int i = 0; i < 4; ++i) k4[i] += __shfl_xor(s4[i], 1);
        f32x2 k2 = b1 ? (f32x2){k4[2], k4[3]} : (f32x2){k4[0], k4[1]}, s2 = b1 ? (f32x2){k4[0], k4[1]} : (f32x2){k4[2], k4[3]};
        k2.x += __shfl_xor(s2.x, 2); k2.y += __shfl_xor(s2.y, 2);
        float k1 = b2 ? k2.y : k2.x; const float s1 = b2 ? k2.x : k2.y;
        k1 += __shfl_xor(s1, 4);
        k1 += __shfl_xor(k1, 8); k1 += __shfl_xor(k1, 16); k1 += __shfl_xor(k1, 32);
        if (F.lane < 8) AB[(size_t)m * 8 + (b0 ? 4 : 0) + (b1 ? 2 : 0) + (b2 ? 1 : 0)] = k1;
#pragma unroll
        for (int j = 0; j < 4; ++j) v[j] = vn[j];
    }
}

constexpr int GM_LDT = 136;
constexpr int GM_U = 34816;
struct GmPre { u32x4 v[4], u[4]; };
__device__ __forceinline__ void gmlp_prefetch(const Frame& F, GmPre& P, int unit) {
    const int h = unit & 3, bn = unit >> 2, sp = F.tid >> 3, seg = F.tid & 7;
    const bf16_t* pv = (const bf16_t*)(F.ws + WS_R3) + ((size_t)bn * GMC + 2 * sp) * NPROJ + 512 + h * HD + 16 * seg; const bf16_t* pu = pv - 512;
    P.v[0] = *(const u32x4*)pv; P.v[1] = *(const u32x4*)(pv + 8); P.v[2] = *(const u32x4*)(pv + NPROJ); P.v[3] = *(const u32x4*)(pv + NPROJ + 8);
    P.u[0] = *(const u32x4*)pu; P.u[1] = *(const u32x4*)(pu + 8); P.u[2] = *(const u32x4*)(pu + NPROJ); P.u[3] = *(const u32x4*)(pu + NPROJ + 8);
}
__device__ __forceinline__ void gmlp_unit(const Frame& F, const Args& a, int unit, const bf16x8 (&af)[4], GmPre& P, int next_unit) {
    const int h = unit & 3, bn = unit >> 2;
    bf16_t* MIX = (bf16_t*)(F.ws + WS_MIX);
    const float* gmg = a.in[3] + h * HD; const float* bs = a.in[5] + h * GMC;
    LAS bf16_t* vnT = (LAS bf16_t*)F.lds;
    LAS bf16_t* uI = (LAS bf16_t*)(F.lds + GM_U);
    const size_t row0 = (size_t)bn * GMC;
    const int sp = F.tid >> 3, seg = F.tid & 7;
    {
        float x0[16], x1[16];
#pragma unroll
        for (int i = 0; i < 4; ++i) { x0[2 * i] = bflo(P.v[0][i]); x0[2 * i + 1] = bfhi(P.v[0][i]); x0[8 + 2 * i] = bflo(P.v[1][i]); x0[9 + 2 * i] = bfhi(P.v[1][i]);
                                      x1[2 * i] = bflo(P.v[2][i]); x1[2 * i + 1] = bfhi(P.v[2][i]); x1[8 + 2 * i] = bflo(P.v[3][i]); x1[9 + 2 * i] = bfhi(P.v[3][i]); }
#pragma unroll
        for (int i = 0; i < 16; ++i) { const f32x2 gg2 = gelu_pk((f32x2){x0[i], x1[i]}); x0[i] = gg2.x; x1[i] = gg2.y; }
        float s0 = 0.f, s1 = 0.f;
#pragma unroll
        for (int i = 0; i < 16; ++i) { s0 += x0[i] * x0[i]; s1 += x1[i] * x1[i]; }
#pragma unroll
        for (int o = 1; o < 8; o <<= 1) { s0 += __shfl_xor(s0, o); s1 += __shfl_xor(s1, o); }
        const float r0 = rsqrtf(s0 * (1.0f / HD) + EPS), r1 = rsqrtf(s1 * (1.0f / HD) + EPS);
#pragma unroll
        for (int i = 0; i < 16; ++i) { const float gg = gmg[16 * seg + i];
            *(LAS unsigned*)(vnT + (16 * seg + i) * GM_LDT + (((((sp >> 2) ^ seg) & 7) | ((sp >> 2) & 8)) << 3) + ((2 * sp) & 7)) = cvt_pk_bf16(x0[i] * r0 * gg, x1[i] * r1 * gg); }
#pragma unroll
        for (int rr = 0; rr < 2; ++rr)
#pragma unroll
            for (int hh = 0; hh < 2; ++hh) { const u32x4 uw = P.u[2 * rr + hh]; u32x4 o;
#pragma unroll
                for (int i = 0; i < 4; ++i) { const f32x2 g2 = gelu_pk((f32x2){bflo(uw[i]), bfhi(uw[i])}); o[i] = cvt_pk_bf16(g2.x, g2.y); }
                *(LAS u32x4*)(uI + (2 * sp + rr) * GM_LDT + 16 * seg + 8 * hh) = o; }
    }
    if (next_unit >= 0) gmlp_prefetch(F, P, next_unit);
    LDS_BAR();
    const int fr = F.lane & 15, fq = F.lane >> 4;
    f32x4 acc[8];
#pragma unroll
    for (int nt = 0; nt < 8; ++nt) { acc[nt] = (f32x4){0.f, 0.f, 0.f, 0.f};
#pragma unroll
        for (int kk = 0; kk < 4; ++kk) { const int ch = 4 * kk + fq; const bf16x8 bfr = *(const LAS bf16x8*)(vnT + (16 * nt + fr) * GM_LDT + ((((ch ^ nt) & 7) | (ch & 8)) << 3)); acc[nt] = MFMA16(af[kk], bfr, acc[nt]); } }
#pragma unroll
    for (int r = 0; r < 4; ++r) { const int t = 16 * F.wave + 4 * fq + r; const float bias = bs[t];
#pragma unroll
        for (int nt = 0; nt < 8; ++nt) { LAS bf16_t* q = uI + t * GM_LDT + 16 * nt + fr; *q = f2bf(bf2f(*q) * (acc[nt][r] + bias)); } }
    LDS_BAR();
#pragma unroll
    for (int rr = 0; rr < 2; ++rr)
#pragma unroll
        for (int hh = 0; hh < 2; ++hh) *(u32x4*)(MIX + (row0 + 2 * sp + rr) * D + h * HD + 16 * seg + 8 * hh) = *(const LAS u32x4*)(uI + (2 * sp + rr) * GM_LDT + 16 * seg + 8 * hh);
    LDS_BAR();
}
__device__ __forceinline__ void gmlp_wfrags(const Frame& F, const Args& a, int h, bf16x8 (&af)[4]) {
    const float* Wh = a.in[4] + (size_t)h * GMC * GMC;
    const int fr = F.lane & 15, fq = F.lane >> 4, trow = 16 * F.wave + fr;
#pragma unroll
    for (int kk = 0; kk < 4; ++kk) { const int s0 = 32 * kk + 8 * fq; const float* wp = Wh + (size_t)trow * GMC + s0;
        const f32x4 w0 = *(const f32x4*)wp, w1 = *(const f32x4*)(wp + 4); float wv[8] = {w0[0], w0[1], w0[2], w0[3], w1[0], w1[1], w1[2], w1[3]};
#pragma unroll
        for (int j = 0; j < 8; ++j) if (s0 + j > trow) wv[j] = 0.f;
        u32x4 pk; pk.x = cvt_pk_bf16(wv[0], wv[1]); pk.y = cvt_pk_bf16(wv[2], wv[3]); pk.z = cvt_pk_bf16(wv[4], wv[5]); pk.w = cvt_pk_bf16(wv[6], wv[7]);
        af[kk] = __builtin_bit_cast(bf16x8, pk); }
}

constexpr int DN_QS = 0;
constexpr int DN_KS = 17408;
constexpr int DN_KT = 34816;
constexpr int DN_XT = 53248;
constexpr int DN_LN = 90112;
constexpr int DN_LD = 99328;
constexpr int DN_TI = 103680;
constexpr int DN_YT = 106752;
constexpr int DN_GC = 119040;
constexpr int DN_CW = 120064;
static_assert(DN_CW + 6144 <= RING_BYTES, "DeltaNet chunk LDS map");
__device__ __forceinline__ int tsw(int r, int pos) { return r * 72 + ((((pos >> 3) ^ (r >> 3)) & 7) << 3) + (pos & 7); }
__device__ __forceinline__ int dn_slot(int bh, int n) { return bh * NCH + ((n + 7 * bh) & (NCH - 1)); }
struct DnPre { u32x4 xv[3][2][4]; float av, bv; };
__device__ __forceinline__ void dn_prefetch(const Frame& F, DnPre& P, int unit) {
    const int n = unit & 63, bh = unit >> 6, h = bh & 3, b = bh >> 2, fr = F.lane & 15, fq = F.lane >> 4;
    const bf16_t* PROJ = (const bf16_t*)(F.ws + WS_R3); const float* AB = (const float*)(F.ws + WS_AB);
    const size_t trow0 = (size_t)b * SEQ + (size_t)n * DNC;
    P.av = AB[(trow0 + F.lane) * 8 + h]; P.bv = AB[(trow0 + F.lane) * 8 + 4 + h];
#pragma unroll
    for (int ten = 0; ten < 3; ++ten) { const int ch = ten * 512 + h * HD + 8 * fr;
#pragma unroll
        for (int hp = 0; hp < 2; ++hp) { const int pos = hp * 32 + 4 * F.wave + fq;
#pragma unroll
            for (int j = 0; j < 4; ++j) { const int sp = n * DNC + pos - 3 + j;
                P.xv[ten][hp][j] = (sp >= 0) ? *(const u32x4*)(PROJ + ((size_t)b * SEQ + sp) * NPROJ + 1024 + ch) : (u32x4){0u, 0u, 0u, 0u}; } } }
}
__device__ __forceinline__ void dn_chunk(const Frame& F, const Args& a, int unit, DnPre& P, int next_unit) {
    const int n = unit & 63, bh = unit >> 6, h = bh & 3, b = bh >> 2;
    const LAS float* cwL = (const LAS float*)(F.lds + DN_CW);
    LAS unsigned char* L = F.lds;
    LAS bf16_t* qs = (LAS bf16_t*)(L + DN_QS); LAS bf16_t* ks = (LAS bf16_t*)(L + DN_KS); LAS bf16_t* kT = (LAS bf16_t*)(L + DN_KT); LAS bf16_t* XT = (LAS bf16_t*)(L + DN_XT);
    LAS bf16_t* Ln = (LAS bf16_t*)(L + DN_LN); LAS float* Ld = (LAS float*)(L + DN_LD); LAS bf16_t* Ti = (LAS bf16_t*)(L + DN_TI); LAS bf16_t* YT = (LAS bf16_t*)(L + DN_YT + F.wave * 1536);
    LAS float* gcs = (LAS float*)(L + DN_GC); LAS float* bts = gcs + 64; LAS float* egs = gcs + 128;
    const size_t trow0 = (size_t)b * SEQ + (size_t)n * DNC;
    int fr = F.lane & 15, fq = F.lane >> 4;
    asm volatile("" : "+v"(fr), "+v"(fq));
    float my_gc, my_beta, my_eg;
    {
        const float av = P.av, bv = P.bv;
        const float xg = av + a.in[8][h];
        const float sp = xg > 20.f ? xg : log1pf(__expf(xg));
        float g = -__expf(a.in[7][h]) * sp;
#pragma unroll
        for (int o = 1; o < 64; o <<= 1) { const float t = __shfl_up(g, o); if (F.lane >= o) g += t; }
        my_gc = g; my_beta = sigmoid_f(bv); my_eg = __expf(g);
        if (F.wave == 0) { gcs[F.lane] = my_gc; bts[F.lane] = my_beta; egs[F.lane] = my_eg; }
    }
    const int slot = dn_slot(bh, n);
    bf16_t* QDg = (bf16_t*)(F.ws + WS_QD) + (size_t)slot * 64 * 128;
#pragma unroll
    for (int ten = 0; ten < 3; ++ten) {
        f32x4 w0[4], w1[4];
#pragma unroll
        for (int j = 0; j < 4; ++j) { w0[j] = *(const LAS f32x4*)(cwL + (ten * 4 + j) * 128 + 8 * fr); w1[j] = *(const LAS f32x4*)(cwL + (ten * 4 + j) * 128 + 8 * fr + 4); }
#pragma unroll
        for (int hp = 0; hp < 2; ++hp) { const int pos = hp * 32 + 4 * F.wave + fq;
            float accv[8];
#pragma unroll
            for (int i = 0; i < 8; ++i) accv[i] = 0.f;
#pragma unroll
            for (int j = 0; j < 4; ++j) { const u32x4 x = P.xv[ten][hp][j];
                accv[0] += bflo(x[0]) * w0[j][0]; accv[1] += bfhi(x[0]) * w0[j][1]; accv[2] += bflo(x[1]) * w0[j][2]; accv[3] += bfhi(x[1]) * w0[j][3];
                accv[4] += bflo(x[2]) * w1[j][0]; accv[5] += bfhi(x[2]) * w1[j][1]; accv[6] += bflo(x[3]) * w1[j][2]; accv[7] += bfhi(x[3]) * w1[j][3]; }
            float ss = 0.f;
#pragma unroll
            for (int i = 0; i < 8; ++i) { accv[i] = silu_f(accv[i]); ss += accv[i] * accv[i]; }
#pragma unroll
            for (int o = 1; o < 16; o <<= 1) ss += __shfl_xor(ss, o);
            const float bp = __shfl(my_beta, pos), ep = __shfl(my_eg, pos);
            if (ten == 0) { const float sc = rsqrtf(ss + EPS) * 0.08838834764831845f;
#pragma unroll
                for (int i = 0; i < 8; ++i) accv[i] *= sc;
                u32x4 w; w.x = cvt_pk_bf16(accv[0], accv[1]); w.y = cvt_pk_bf16(accv[2], accv[3]); w.z = cvt_pk_bf16(accv[4], accv[5]); w.w = cvt_pk_bf16(accv[6], accv[7]);
                *(LAS u32x4*)(qs + pos * 136 + 8 * fr) = w;
                u32x4 wd; wd.x = cvt_pk_bf16(accv[0] * ep, accv[1] * ep); wd.y = cvt_pk_bf16(accv[2] * ep, accv[3] * ep); wd.z = cvt_pk_bf16(accv[4] * ep, accv[5] * ep); wd.w = cvt_pk_bf16(accv[6] * ep, accv[7] * ep);
                *(u32x4*)(QDg + pos * 128 + 8 * fr) = wd;
            } else if (ten == 1) { const float sc = rsqrtf(ss + EPS);
#pragma unroll
                for (int i = 0; i < 8; ++i) accv[i] *= sc;
                u32x4 w; w.x = cvt_pk_bf16(accv[0], accv[1]); w.y = cvt_pk_bf16(accv[2], accv[3]); w.z = cvt_pk_bf16(accv[4], accv[5]); w.w = cvt_pk_bf16(accv[6], accv[7]);
                *(LAS u32x4*)(ks + pos * 136 + 8 * fr) = w;
                const float rs = bp * ep;
#pragma unroll
                for (int i = 0; i < 8; ++i) { kT[tsw(8 * fr + i, pos)] = f2bf(accv[i]); XT[tsw(128 + 8 * fr + i, pos)] = f2bf(accv[i] * rs); }
            } else {
#pragma unroll
                for (int i = 0; i < 8; ++i) XT[tsw(8 * fr + i, pos)] = f2bf(accv[i] * bp);
            }
        }
    }
    if (next_unit >= 0) dn_prefetch(F, P, next_unit);
    LDS_BAR();
    bf16_t* ATg = (bf16_t*)(F.ws + WS_AT) + (size_t)slot * 64 * 64;
    {
        const int mt = F.wave & 3; const LAS bf16_t* Asrc = (F.wave < 4) ? ks : qs;
        f32x4 acc[4];
#pragma unroll
        for (int nt = 0; nt < 4; ++nt) acc[nt] = (f32x4){0.f, 0.f, 0.f, 0.f};
#pragma unroll
        for (int kk = 0; kk < 4; ++kk) { const bf16x8 af = *(const LAS bf16x8*)(Asrc + (16 * mt + fr) * 136 + 32 * kk + 8 * fq);
#pragma unroll
            for (int nt = 0; nt < 4; ++nt) { const bf16x8 bfr = *(const LAS bf16x8*)(ks + (16 * nt + fr) * 136 + 32 * kk + 8 * fq); acc[nt] = MFMA16(af, bfr, acc[nt]); } }
#pragma unroll
        for (int r = 0; r < 4; ++r) { const int i = 16 * mt + 4 * fq + r; const float gi = gcs[i], bi = bts[i];
#pragma unroll
            for (int nt = 0; nt < 4; ++nt) { const int j = 16 * nt + fr; const float dec = __expf(fminf(gi - gcs[j], 0.f));
                if (F.wave < 4) { const float lv = (j < i) ? bi * acc[nt][r] * dec : 0.f; Ln[i * 72 + j] = f2bf(-lv); if (nt == mt) Ld[(mt * 16 + 4 * fq + r) * 17 + fr] = lv; }
                else ATg[i * 64 + j] = f2bf((j <= i) ? acc[nt][r] * dec : 0.f); } }
    }
    LDS_BAR();
    if (F.wave == 0) {
        const int blk = fq, c = fr;
        float t[16];
#pragma unroll
        for (int i = 0; i < 16; ++i) { float s = (i == c) ? 1.f : 0.f;
#pragma unroll
            for (int j = 0; j < i; ++j) s -= Ld[(blk * 16 + i) * 17 + j] * t[j];
            t[i] = s; }
#pragma unroll
        for (int i = 0; i < 16; ++i) Ti[(16 * blk + i) * 24 + c] = f2bf(t[i]);
    } else {
        bf16_t* KETg = (bf16_t*)(F.ws + WS_KET) + (size_t)slot * 128 * 64;
        const float glast = gcs[63];
        for (int idx = F.tid - 64; idx < 128 * 8; idx += NTHREADS - 64) {
            const int d = idx >> 3, gp = idx & 7;
            const u32x4 v = *(const LAS u32x4*)(kT + tsw(d, 8 * gp)); u32x4 w;
#pragma unroll
            for (int i = 0; i < 4; ++i) w[i] = cvt_pk_bf16(bflo(v[i]) * __expf(glast - gcs[8 * gp + 2 * i]), bfhi(v[i]) * __expf(glast - gcs[8 * gp + 2 * i + 1]));
            *(u32x4*)(KETg + d * 64 + 8 * gp) = w;
        }
        if (F.tid == 64) ((float*)(F.ws + WS_GLAST))[slot] = __expf(glast);
    }
    LDS_BAR();
    {
        bf16_t* Og = (bf16_t*)(F.ws + (F.wave < 4 ? WS_UC : WS_WC)) + (size_t)slot * 64 * 128;
        const int ncol0 = (F.wave & 3) * 32;
        const bf16x8 zf = (bf16x8){0, 0, 0, 0, 0, 0, 0, 0};
#pragma unroll
        for (int bb = 0; bb < 4; ++bb) {
            f32x4 acc[2];
#pragma unroll
            for (int t = 0; t < 2; ++t) { const u32x2 rv = *(const LAS u32x2*)(XT + tsw(32 * F.wave + 16 * t + fr, 16 * bb + 4 * fq));
                acc[t] = (f32x4){bflo(rv.x), bfhi(rv.x), bflo(rv.y), bfhi(rv.y)}; }
            if (bb >= 1) {
#pragma unroll
                for (int kk = 0; kk < 2; ++kk) if (32 * kk < 16 * bb) {
                    bf16x8 af = *(const LAS bf16x8*)(Ln + (16 * bb + fr) * 72 + 32 * kk + 8 * fq);
                    if (32 * kk + 8 * fq >= 16 * bb) af = zf;
#pragma unroll
                    for (int t = 0; t < 2; ++t) { const bf16x8 bfr = *(const LAS bf16x8*)(XT + tsw(32 * F.wave + 16 * t + fr, 32 * kk + 8 * fq)); acc[t] = MFMA16(af, bfr, acc[t]); }
                }
            }
#pragma unroll
            for (int t = 0; t < 2; ++t) { u32x2 w; w.x = cvt_pk_bf16(acc[t][0], acc[t][1]); w.y = cvt_pk_bf16(acc[t][2], acc[t][3]); *(LAS u32x2*)(YT + (16 * t + fr) * 24 + 4 * fq) = w; }
            LDS_WAIT();
            bf16x8 a2 = *(const LAS bf16x8*)(Ti + (16 * bb + fr) * 24 + 8 * (fq & 1));
            if (fq >= 2) a2 = zf;
#pragma unroll
            for (int t = 0; t < 2; ++t) { bf16x8 b2 = *(const LAS bf16x8*)(YT + (16 * t + fr) * 24 + 8 * (fq & 1)); if (fq >= 2) b2 = zf;
                f32x4 x = MFMA16(a2, b2, ((f32x4){0.f, 0.f, 0.f, 0.f}));
                u32x2 w; w.x = cvt_pk_bf16(x[0], x[1]); w.y = cvt_pk_bf16(x[2], x[3]);
                *(LAS u32x2*)(XT + tsw(32 * F.wave + 16 * t + fr, 16 * bb + 4 * fq)) = w;
                if (F.wave < 4) *(u32x2*)(Og + (ncol0 + 16 * t + fr) * 64 + 16 * bb + 4 * fq) = w;
                else {
#pragma unroll
                    for (int r = 0; r < 4; ++r) Og[(16 * bb + 4 * fq + r) * 128 + ncol0 + 16 * t + fr] = f2bf(x[r]); } }
            LDS_WAIT();
        }
    }
    LDS_BAR();
}

constexpr int SC_WC = 0, SC_QD = 17408, SC_AT = 34816, SC_KE = 44032, SC_UC = 62464, SC_GL = 66560, SC_BUF = 66816;
constexpr int SC_ST = 2 * SC_BUF, SC_SLICE = 6656  , SC_OT = SC_ST + 2 * SC_SLICE;
static_assert(SC_OT + 8192 <= RING_BYTES, "scan LDS map");
constexpr int SC_NLD = 384;
struct ScanRegs { u32x4 w[3], q[3], k[3], a[2], u; float gl; };
__device__ __forceinline__ void scan_load(const Frame& F, ScanRegs& R, size_t cu, int sp, int lt) {
    const unsigned char* wc = F.ws + WS_WC + cu * 16384; const unsigned char* qd = F.ws + WS_QD + cu * 16384; const unsigned char* ke = F.ws + WS_KET + cu * 16384;
    const unsigned char* at = F.ws + WS_AT + cu * 8192; const unsigned char* uc = F.ws + WS_UC + cu * 16384 + (size_t)sp * 4096;
    const unsigned o = (unsigned)lt * 16u;
#pragma unroll
    for (int i = 0; i < 3; ++i) if (i < 2 || lt < 256) { R.w[i] = *(const u32x4*)(wc + o + i * (SC_NLD * 16)); R.q[i] = *(const u32x4*)(qd + o + i * (SC_NLD * 16)); R.k[i] = *(const u32x4*)(ke + o + i * (SC_NLD * 16)); }
    R.a[0] = *(const u32x4*)(at + o); if (lt < 128) R.a[1] = *(const u32x4*)(at + o + SC_NLD * 16);
    if (lt < 256) R.u = *(const u32x4*)(uc + o);
    R.gl = ((const float*)(F.ws + WS_GLAST))[cu];
}
__device__ __forceinline__ void scan_store(LAS unsigned char* buf, const ScanRegs& R, int lt) {
    if (lt == 0) *(LAS float*)(buf + SC_GL) = R.gl;
    const int d16 = ((lt >> 4) * 136 + (lt & 15) * 8) * 2;
    const int d8 = ((lt >> 3) * 72 + (lt & 7) * 8) * 2;
#pragma unroll
    for (int i = 0; i < 3; ++i) if (i < 2 || lt < 256) { *(LAS u32x4*)(buf + SC_WC + d16 + i * (24 * 136 * 2)) = R.w[i]; *(LAS u32x4*)(buf + SC_QD + d16 + i * (24 * 136 * 2)) = R.q[i]; *(LAS u32x4*)(buf + SC_KE + d8 + i * (48 * 72 * 2)) = R.k[i]; }
    *(LAS u32x4*)(buf + SC_AT + d8) = R.a[0]; if (lt < 128) *(LAS u32x4*)(buf + SC_AT + d8 + 48 * 72 * 2) = R.a[1];
    if (lt < 256) *(LAS u32x4*)(buf + SC_UC + lt * 16) = R.u;
}
__device__ __forceinline__ void scan_out(const Frame& F, int b, int h, int sp, int nn, int lt) {
    bf16_t* Og = (bf16_t*)(F.ws + WS_O);
    const int pos = lt >> 2, e4 = (lt & 3) * 4;
#pragma unroll
    for (int j = 0; j < 2; ++j) { const LAS bf16_t* OT = (const LAS bf16_t*)(F.lds + SC_OT + ((nn & 1) * 2 + j) * 2048);
        u32x2 w; w.x = (unsigned)OT[e4 * 64 + pos] | ((unsigned)OT[(e4 + 1) * 64 + pos] << 16); w.y = (unsigned)OT[(e4 + 2) * 64 + pos] | ((unsigned)OT[(e4 + 3) * 64 + pos] << 16);
        *(u32x2*)(Og + ((size_t)b * SEQ + (size_t)nn * DNC + pos) * 512 + h * HD + 16 * (2 * sp + j) + e4) = w; }
}
__device__ __forceinline__ void dn_scan(const Frame& F, int item) {
    const int bh = item >> 2, sp = item & 3, h = bh & 3, b = bh >> 2;
    const int cj = F.wave & 1;
    LAS bf16_t* ST = (LAS bf16_t*)(F.lds + SC_ST + cj * SC_SLICE); LAS bf16_t* VT = (LAS bf16_t*)(F.lds + SC_ST + cj * SC_SLICE + 4352);
    const int fr = F.lane & 15, fq = F.lane >> 4;
    f32x4 S[8];
#pragma unroll
    for (int mt = 0; mt < 8; ++mt) S[mt] = (f32x4){0.f, 0.f, 0.f, 0.f};
    if (F.wave < 2) {
#pragma unroll
        for (int mt = 0; mt < 8; ++mt) *(LAS u32x2*)(ST + fr * 136 + 16 * mt + 4 * fq) = (u32x2){0u, 0u};
    }
    ScanRegs R;
    if (F.wave >= 2) { scan_load(F, R, (size_t)dn_slot(bh, 0), sp, F.tid - 128); scan_store(F.lds, R, F.tid - 128);
                       scan_load(F, R, (size_t)dn_slot(bh, 1), sp, F.tid - 128); }
    LDS_WAIT(); __syncthreads();
#pragma unroll 1
    for (int n = 0; n < NCH; ++n) {
        LAS unsigned char* buf = F.lds + (n & 1) * SC_BUF;
        if (F.wave >= 2) {
            if (n + 1 < NCH) scan_store(F.lds + ((n + 1) & 1) * SC_BUF, R, F.tid - 128);
            if (n + 2 < NCH) scan_load(F, R, (size_t)dn_slot(bh, n + 2), sp, F.tid - 128);
            if (n >= 1 && F.tid < 384) scan_out(F, b, h, sp, n - 1, F.tid - 128);
        } else {
            const LAS bf16_t* wc = (const LAS bf16_t*)(buf + SC_WC); const LAS bf16_t* qd = (const LAS bf16_t*)(buf + SC_QD); const LAS bf16_t* at = (const LAS bf16_t*)(buf + SC_AT);
            const LAS bf16_t* ke = (const LAS bf16_t*)(buf + SC_KE); const LAS bf16_t* uc = (const LAS bf16_t*)(buf + SC_UC) + cj * 1024;
            bf16x8 sb[4];
#pragma unroll
            for (int kk = 0; kk < 4; ++kk) sb[kk] = *(const LAS bf16x8*)(ST + fr * 136 + 32 * kk + 8 * fq);
            f32x4 vn[4], oo[4];
#pragma unroll
            for (int hf = 0; hf < 2; ++hf) {
                bf16x8 aw[2][4], aq[2][4];
#pragma unroll
                for (int m2 = 0; m2 < 2; ++m2)
#pragma unroll
                    for (int kk = 0; kk < 4; ++kk) { aw[m2][kk] = *(const LAS bf16x8*)(wc + (16 * (2 * hf + m2) + fr) * 136 + 32 * kk + 8 * fq); aq[m2][kk] = *(const LAS bf16x8*)(qd + (16 * (2 * hf + m2) + fr) * 136 + 32 * kk + 8 * fq); }
                __builtin_amdgcn_sched_barrier(0);
#pragma unroll
                for (int m2 = 0; m2 < 2; ++m2) { const int mt = 2 * hf + m2; vn[mt] = (f32x4){0.f, 0.f, 0.f, 0.f}; oo[mt] = (f32x4){0.f, 0.f, 0.f, 0.f}; }
#pragma unroll
                for (int kk = 0; kk < 4; ++kk)
#pragma unroll
                    for (int m2 = 0; m2 < 2; ++m2) { const int mt = 2 * hf + m2; vn[mt] = MFMA16(aw[m2][kk], sb[kk], vn[mt]); oo[mt] = MFMA16(aq[m2][kk], sb[kk], oo[mt]); }
                __builtin_amdgcn_sched_barrier(0);
            }
            u32x2 uvv[4];
#pragma unroll
            for (int mt = 0; mt < 4; ++mt) uvv[mt] = *(const LAS u32x2*)(uc + fr * 64 + 16 * mt + 4 * fq);
            __builtin_amdgcn_sched_barrier(0);
#pragma unroll
            for (int mt = 0; mt < 4; ++mt) { const u32x2 uv = uvv[mt];
                vn[mt][0] = bflo(uv.x) - vn[mt][0]; vn[mt][1] = bfhi(uv.x) - vn[mt][1]; vn[mt][2] = bflo(uv.y) - vn[mt][2]; vn[mt][3] = bfhi(uv.y) - vn[mt][3];
                u32x2 w; w.x = cvt_pk_bf16(vn[mt][0], vn[mt][1]); w.y = cvt_pk_bf16(vn[mt][2], vn[mt][3]);
                *(LAS u32x2*)(VT + fr * 72 + 16 * mt + 4 * fq) = w; }
            LDS_WAIT();
            bf16x8 vb[2];
#pragma unroll
            for (int kk = 0; kk < 2; ++kk) vb[kk] = *(const LAS bf16x8*)(VT + fr * 72 + 32 * kk + 8 * fq);
            bf16x8 aa[4][2];
#pragma unroll
            for (int mt = 0; mt < 4; ++mt)
#pragma unroll
                for (int kk = 0; kk < 2; ++kk) aa[mt][kk] = *(const LAS bf16x8*)(at + (16 * mt + fr) * 72 + 32 * kk + 8 * fq);
            bf16x8 ak[8][2];
#pragma unroll
            for (int mt = 0; mt < 4; ++mt)
#pragma unroll
                for (int kk = 0; kk < 2; ++kk) ak[mt][kk] = *(const LAS bf16x8*)(ke + (16 * mt + fr) * 72 + 32 * kk + 8 * fq);
            const float dec = *(const LAS float*)(buf + SC_GL);
            __builtin_amdgcn_sched_barrier(0);
#pragma unroll
            for (int mt = 0; mt < 4; ++mt) {
#pragma unroll
                for (int kk = 0; kk < 2; ++kk) oo[mt] = MFMA16(aa[mt][kk], vb[kk], oo[mt]); }
#pragma unroll
            for (int mt = 4; mt < 8; ++mt)
#pragma unroll
                for (int kk = 0; kk < 2; ++kk) ak[mt][kk] = *(const LAS bf16x8*)(ke + (16 * mt + fr) * 72 + 32 * kk + 8 * fq);
            __builtin_amdgcn_sched_barrier(0);
#pragma unroll
            for (int mt = 0; mt < 8; ++mt) { S[mt] = S[mt] * dec;
#pragma unroll
                for (int kk = 0; kk < 2; ++kk) S[mt] = MFMA16(ak[mt][kk], vb[kk], S[mt]); }
            __builtin_amdgcn_sched_barrier(0);
#pragma unroll
            for (int mt = 0; mt < 8; ++mt) { u32x2 w; w.x = cvt_pk_bf16(S[mt][0], S[mt][1]); w.y = cvt_pk_bf16(S[mt][2], S[mt][3]);
                *(LAS u32x2*)(ST + fr * 136 + 16 * mt + 4 * fq) = w; }
            LAS bf16_t* OT = (LAS bf16_t*)(F.lds + SC_OT + ((n & 1) * 2 + cj) * 2048);
#pragma unroll
            for (int mt = 0; mt < 4; ++mt) { u32x2 w; w.x = cvt_pk_bf16(oo[mt][0], oo[mt][1]); w.y = cvt_pk_bf16(oo[mt][2], oo[mt][3]); *(LAS u32x2*)(OT + fr * 64 + 16 * mt + 4 * fq) = w; }
        }
        LDS_WAIT(); __builtin_amdgcn_s_barrier(); asm volatile("" ::: "memory");
    }
    if (F.tid >= 128 && F.tid < 384) scan_out(F, b, h, sp, NCH - 1, F.tid - 128);
    LDS_WAIT(); __syncthreads();
}
__device__ __forceinline__ void convert_experts(const Frame& F, const Args& a, int cw, int nw) {
    LAS float* scr = (LAS float*)(F.lds + F.wave * 16896);
    const float* w_gu = a.in[14]; const float* w_dn = a.in[16]; unsigned char* WGU = F.ws + WS_WGU; unsigned char* WDN = F.ws + WS_WDN;
    constexpr int I_GU = NE * 8 * 64, I_DN = NE * 8 * 32;
    for (int it = cw; it < I_GU + I_DN; it += nw) {
        int r = it;
        if (r < I_GU) { const int e = r / 512, q = r % 512, kb = q / 64, nb = q % 64; const int c0 = 32 * nb, j = c0 & 1023, drow = (j >> 7) * 256 + (c0 >= 1024 ? 128 : 0) + (j & 127);
            tr_item8(w_gu + (size_t)e * 1024 * 2048 + (size_t)(128 * kb) * 2048 + c0, 2048, WGU + (size_t)e * 2048 * 1024 + (size_t)drow * 1024 + 128 * kb, scr, F.lane); continue; } r -= I_GU;
        { const int e = r / 256, q = r % 256, kb = q / 32, nb = q % 32;
            tr_item8(w_dn + (size_t)e * 1024 * 1024 + (size_t)(128 * kb) * 1024 + 32 * nb, 1024, WDN + (size_t)e * 1024 * 1024 + (size_t)(32 * nb) * 1024 + 128 * kb, scr, F.lane); }
    }
}

__device__ __forceinline__ void dn_out(const Frame& F, const Args& a) {
    const int gw = F.vcu * NWAVES + F.wave, NGW = F.G * NWAVES;
    const bf16_t* Og = (const bf16_t*)(F.ws + WS_O); const bf16_t* PROJ = (const bf16_t*)(F.ws + WS_R3); bf16_t* MIX = (bf16_t*)(F.ws + WS_MIX);
    const float* ng = a.in[9] + 8 * (F.lane & 15);
    const f32x4 g0 = *(const f32x4*)ng, g1 = *(const f32x4*)(ng + 4);
    for (int m = gw; m < T; m += NGW) {
        const u32x4 ow = *(const u32x4*)(Og + (size_t)m * 512 + 8 * F.lane);
        f32x4 o0 = (f32x4){bflo(ow[0]), bfhi(ow[0]), bflo(ow[1]), bfhi(ow[1])}, o1 = (f32x4){bflo(ow[2]), bfhi(ow[2]), bflo(ow[3]), bfhi(ow[3])};
        const u32x4 z = *(const u32x4*)(PROJ + (size_t)m * NPROJ + 2560 + 8 * F.lane);
        float ss = (o0[0] * o0[0] + o0[1] * o0[1]) + (o0[2] * o0[2] + o0[3] * o0[3]) + (o1[0] * o1[0] + o1[1] * o1[1]) + (o1[2] * o1[2] + o1[3] * o1[3]);
#pragma unroll
        for (int o = 1; o < 16; o <<= 1) ss += __shfl_xor(ss, o);
        const float rstd = rsqrtf(ss * (1.0f / HD) + EPS);
        o0 = o0 * rstd * g0; o1 = o1 * rstd * g1;
        u32x4 w; w.x = cvt_pk_bf16(o0[0] * silu_f(bflo(z[0])), o0[1] * silu_f(bfhi(z[0]))); w.y = cvt_pk_bf16(o0[2] * silu_f(bflo(z[1])), o0[3] * silu_f(bfhi(z[1])));
        w.z = cvt_pk_bf16(o1[0] * silu_f(bflo(z[2])), o1[1] * silu_f(bfhi(z[2]))); w.w = cvt_pk_bf16(o1[2] * silu_f(bflo(z[3])), o1[3] * silu_f(bfhi(z[3])));
        *(u32x4*)(MIX + (size_t)m * D + 512 + 8 * F.lane) = w;
    }
}

constexpr int RT_PITCH = 1032;
__device__ __forceinline__ void route(const Frame& F, const Args& a) {
    const int gw = F.vcu * NWAVES + F.wave, NGW = F.G * NWAVES;
    const bf16_t* HB = (const bf16_t*)(F.ws + WS_H); const bf16_t* RWT = (const bf16_t*)(F.ws + WS_RWT); const float* rb = a.in[13]; const float* g2 = a.in[11];
    int* EIDX = (int*)(F.ws + WS_EIDX); float* GATEW = (float*)(F.ws + WS_GATEW); int* EPOS = (int*)(F.ws + WS_EPOS);
    unsigned* cnt = (unsigned*)(F.ws + WS_CTL) + CW_CNT;
    LAS bf16_t* tl = (LAS bf16_t*)(F.lds + F.wave * 17664); LAS float* lg = (LAS float*)(F.lds + F.wave * 17664 + 16512);
    LAS unsigned* lcnt = (LAS unsigned*)(F.lds + 8 * 17664);
    if (F.tid < 64) lcnt[F.tid] = 0u;
    LDS_WAIT(); __syncthreads();
    const int fr = F.lane & 15, fq = F.lane >> 4;
    f32x4 gv[4];
#pragma unroll
    for (int j = 0; j < 4; ++j) gv[j] = *(const f32x4*)(g2 + 4 * F.lane + 256 * j);
    for (int batch = gw; batch < T / 8; batch += NGW) {
        const size_t r0 = (size_t)batch * 8;
        u32x2 raw[8][4];
#pragma unroll
        for (int row = 0; row < 8; ++row)
#pragma unroll
            for (int j = 0; j < 4; ++j) raw[row][j] = ((const u32x2*)(HB + (r0 + row) * D))[F.lane + 64 * j];
#pragma unroll
        for (int row = 0; row < 8; ++row) {
            f32x4 v[4]; float ss = 0.f;
#pragma unroll
            for (int j = 0; j < 4; ++j) { v[j] = (f32x4){bflo(raw[row][j].x), bfhi(raw[row][j].x), bflo(raw[row][j].y), bfhi(raw[row][j].y)}; ss += (v[j][0] * v[j][0] + v[j][1] * v[j][1]) + (v[j][2] * v[j][2] + v[j][3] * v[j][3]); }
            const float rstd = rsqrtf(wave_sum(ss) * (1.0f / D) + EPS);
            unsigned* y8 = (unsigned*)(F.ws + WS_HN8 + (r0 + row) * D) + F.lane;
#pragma unroll
            for (int j = 0; j < 4; ++j) { const f32x4 y = v[j] * rstd * gv[j]; y8[64 * j] = cvt4_fp8(y[0], y[1], y[2], y[3]);
                u32x2 w; w.x = cvt_pk_bf16(y[0], y[1]); w.y = cvt_pk_bf16(y[2], y[3]); *(LAS u32x2*)(tl + row * RT_PITCH + 4 * F.lane + 256 * j) = w; }
        }
        LDS_WAIT();
        f32x4 acc0 = (f32x4){0.f, 0.f, 0.f, 0.f}, acc1 = acc0;
#pragma unroll 1
        for (int k8 = 0; k8 < 32; k8 += 8) {
            bf16x8 b0[8], b1[8];
#pragma unroll
            for (int kk = 0; kk < 8; ++kk) { b0[kk] = *(const bf16x8*)(RWT + (size_t)fr * D + 32 * (k8 + kk) + 8 * fq); b1[kk] = *(const bf16x8*)(RWT + (size_t)(16 + fr) * D + 32 * (k8 + kk) + 8 * fq); }
#pragma unroll
            for (int kk = 0; kk < 8; ++kk) { const bf16x8 af = *(const LAS bf16x8*)(tl + (fr & 7) * RT_PITCH + 32 * (k8 + kk) + 8 * fq);
                acc0 = MFMA16(af, b0[kk], acc0); acc1 = MFMA16(af, b1[kk], acc1); }
        }
        const float bb0 = rb[fr], bb1 = rb[16 + fr];
        if (fq < 2) {
#pragma unroll
            for (int r = 0; r < 4; ++r) { lg[(4 * fq + r) * 36 + fr] = acc0[r] + bb0; lg[(4 * fq + r) * 36 + 16 + fr] = acc1[r] + bb1; } }
        LDS_WAIT();
        if (F.lane < 8) {
            const int row = F.lane; const size_t t = r0 + row;
            float v[32];
#pragma unroll
            for (int q = 0; q < 8; ++q) { const f32x4 x = *(const LAS f32x4*)(lg + row * 36 + 4 * q); v[4 * q] = x[0]; v[4 * q + 1] = x[1]; v[4 * q + 2] = x[2]; v[4 * q + 3] = x[3]; }
            float tv[4]; int ti[4];
#pragma unroll
            for (int k = 0; k < 4; ++k) { float best = -3.0e38f; int bi = 0;
#pragma unroll
                for (int e = 0; e < 32; ++e) { if (v[e] > best) { best = v[e]; bi = e; } }
                tv[k] = best; ti[k] = bi;
#pragma unroll
                for (int e = 0; e < 32; ++e) v[e] = (e == bi) ? -3.0e38f : v[e]; }
            const float e1 = __expf(tv[1] - tv[0]), e2 = __expf(tv[2] - tv[0]), e3 = __expf(tv[3] - tv[0]); const float inv = 1.0f / (1.0f + e1 + e2 + e3);
            const float gk[4] = {inv, e1 * inv, e2 * inv, e3 * inv};
#pragma unroll
            for (int k = 0; k < 4; ++k) {
                const unsigned pos = __hip_atomic_fetch_add(lcnt + ti[k], 1u, __ATOMIC_RELAXED, __HIP_MEMORY_SCOPE_WORKGROUP);
                EIDX[t * 4 + k] = ti[k]; GATEW[t * 4 + k] = gk[k]; EPOS[t * 4 + k] = (int)pos;
            }
        }
        LDS_WAIT();
    }
    VM_WAIT(); LDS_WAIT(); __syncthreads();
    if (F.tid < NE) { const unsigned c = lcnt[F.tid]; lcnt[32 + F.tid] = c ? __hip_atomic_fetch_add(cnt + 64 * F.tid, c, __ATOMIC_RELAXED, __HIP_MEMORY_SCOPE_AGENT) : 0u; }
    LDS_WAIT(); __syncthreads();
    for (int batch = gw; batch < T / 8; batch += NGW) if (F.lane < 32) { const size_t a0 = (size_t)batch * 32 + F.lane; EPOS[a0] += (int)lcnt[32 + EIDX[a0]]; }
}

constexpr int TB_OFF = 131072;
__device__ __forceinline__ void build_tables(const Frame& F) {
    LAS int* pst = (LAS int*)(F.lds + TB_OFF); LAS int* cn = pst + 40; LAS int* tile_e = pst + 80;
    const unsigned* cnt = (const unsigned*)(F.ws + WS_CTL) + CW_CNT;
    if (F.tid < 64) {
        const int e = F.lane & 31; const int c = (int)__hip_atomic_load(cnt + 64 * e, __ATOMIC_RELAXED, __HIP_MEMORY_SCOPE_AGENT);
        const int padded = (c + 255) & ~255;
        int incl = padded;
#pragma unroll
        for (int o = 1; o < 32; o <<= 1) { const int t = __shfl_up(incl, o); if (e >= o) incl += t; }
        if (F.lane < 32) { pst[e] = incl - padded; cn[e] = c; if (e == 31) pst[32] = incl;
            for (int j = 0; j < padded / 256; ++j) tile_e[(incl - padded) / 256 + j] = e; }
    }
    LDS_WAIT(); __syncthreads();
}

__device__ __forceinline__ void gather_rows(const Frame& F) {
    const int gw = F.vcu * NWAVES + F.wave, NGW = F.G * NWAVES;
    LAS int* pst = (LAS int*)(F.lds + TB_OFF); LAS int* cn = pst + 40; LAS int* tile_e = pst + 80;
    const unsigned char* HN8 = F.ws + WS_HN8; unsigned char* XS = F.ws + WS_R3;
    const int* EIDX = (const int*)(F.ws + WS_EIDX); const int* EPOS = (const int*)(F.ws + WS_EPOS); const float* GATEW = (const float*)(F.ws + WS_GATEW); float* GSORT = (float*)(F.ws + WS_GSORT); int* ROWOF = (int*)(F.ws + WS_ROWOF);
    const int rtot = pst[32];
    for (int tl = gw; tl < (rtot >> 8); tl += NGW) { const int e = tile_e[tl], first = pst[e] + cn[e], lo = tl << 8;
        for (int R = (first > lo ? first : lo); R < lo + 256; ++R) { *((u32x4*)(XS + (size_t)R * D) + F.lane) = (u32x4){0u, 0u, 0u, 0u}; if (F.lane == 0) GSORT[R] = 0.f; } }
    for (int t0 = gw * 4; t0 < T; t0 += NGW * 4) {
        int Rl = 0;
        if (F.lane < 16) { const int a = t0 * 4 + F.lane; const int e = EIDX[a]; Rl = pst[e] + EPOS[a]; ROWOF[a] = Rl; GSORT[Rl] = GATEW[a]; }
        u32x4 v[4];
#pragma unroll
        for (int j = 0; j < 4; ++j) v[j] = *((const u32x4*)(HN8 + (size_t)(t0 + j) * D) + F.lane);
#pragma unroll
        for (int j = 0; j < 4; ++j)
#pragma unroll
            for (int k = 0; k < 4; ++k) { const int R = __builtin_amdgcn_readlane(Rl, 4 * j + k); *((u32x4*)(XS + (size_t)R * D) + F.lane) = v[j]; }
    }
}

__device__ __forceinline__ void combine(const Frame& F, const Args& a) {
    const int gw = F.vcu * NWAVES + F.wave, NGW = F.G * NWAVES;
    const bf16_t* H = (const bf16_t*)(F.ws + WS_H); const unsigned char* YS = F.ws + WS_YS; const int* ROWOF = (const int*)(F.ws + WS_ROWOF); const float* gf = a.in[18];
    f32x4 gv[4];
#pragma unroll
    for (int j = 0; j < 4; ++j) gv[j] = *(const f32x4*)(gf + 4 * F.lane + 256 * j);
    for (int m = gw; m < T; m += NGW) {
        const u32x2* xr = (const u32x2*)(H + (size_t)m * D) + F.lane;
        f32x4 v[4];
#pragma unroll
        for (int j = 0; j < 4; ++j) { const u32x2 hw = xr[64 * j]; v[j] = (f32x4){bflo(hw.x), bfhi(hw.x), bflo(hw.y), bfhi(hw.y)}; }
#if !defined(DBG_SKIP_MOE)
#pragma unroll
        for (int k = 0; k < 4; ++k) { const int R = ROWOF[m * 4 + k]; const int* yr = (const int*)(YS + (size_t)R * D) + F.lane;
#pragma unroll
            for (int j = 0; j < 4; ++j) { const int w = yr[64 * j]; const f32x2 lo = __builtin_amdgcn_cvt_pk_f32_fp8(w, false), hi = __builtin_amdgcn_cvt_pk_f32_fp8(w, true);
                v[j][0] += lo.x; v[j][1] += lo.y; v[j][2] += hi.x; v[j][3] += hi.y; } }
#endif
        float ss = 0.f;
#pragma unroll
        for (int j = 0; j < 4; ++j) ss += (v[j][0] * v[j][0] + v[j][1] * v[j][1]) + (v[j][2] * v[j][2] + v[j][3] * v[j][3]);
        const float rstd = rsqrtf(wave_sum(ss) * (1.0f / D) + EPS);
        f32x4* o = (f32x4*)(a.out + (size_t)m * D) + F.lane;
#pragma unroll
        for (int j = 0; j < 4; ++j) o[64 * j] = v[j] * rstd * gv[j];
    }
}

__device__ __forceinline__ void dbg_dump(const Frame& F, const Args& a, int what) {
    const int gw = F.vcu * NWAVES + F.wave, NGW = F.G * NWAVES;
    for (int m = gw; m < T; m += NGW) {
        for (int c = F.lane; c < D; c += 64) {
            float v = 0.f;
            if (what == 1) v = bf2f(((const bf16_t*)(F.ws + WS_R3))[(size_t)m * NPROJ + c]);
            else if (what == 2) v = bf2f(((const bf16_t*)(F.ws + WS_MIX))[(size_t)m * D + c]);
            else if (what == 3) v = ((const float*)(F.ws + WS_O))[(size_t)m * 512 + (c & 511)];
            else if (what == 4) v = ((const float*)(F.ws + WS_H))[(size_t)m * D + c];
            else if (what == 5) v = bf2f(((const bf16_t*)(F.ws + WS_R3))[(size_t)m * NPROJ + 1024 + c]);
            else if (what == 6) v = bf2f(((const bf16_t*)(F.ws + WS_R3))[(size_t)m * NPROJ + 2048 + c]);
            else if (what == 7) v = bf2f(((const bf16_t*)(F.ws + WS_Y))[(size_t)m * D + c]);
            else if (what == 9) v = bf2f(((const bf16_t*)(F.ws + WS_WC))[((size_t)m * D + c) & 0xFFFFFF]);
            else if (what == 10) v = bf2f(((const bf16_t*)(F.ws + WS_UC))[((size_t)m * D + c) & 0xFFFFFF]);
            else if (what == 11) v = bf2f(((const bf16_t*)(F.ws + WS_QD))[((size_t)m * D + c) & 0xFFFFFF]);
            else if (what == 12) v = bf2f(((const bf16_t*)(F.ws + WS_KET))[((size_t)m * D + c) & 0xFFFFFF]);
            else if (what == 13) v = bf2f(((const bf16_t*)(F.ws + WS_AT))[((size_t)m * D + c) & 0x7FFFFF]);
            else if (what == 14) v = ((const float*)(F.ws + WS_AB))[(size_t)m * 8 + (c & 7)];
            else if (what == 8) v = bf2f(((const bf16_t*)(F.ws + WS_MIX))[(size_t)m * D + (c & 511)]);
            if (!(v - v == 0.f)) v = 12345.f;
            a.out[(size_t)m * D + c] = v;
        }
    }
}

constexpr int NPHASES = 12;
__global__ void __launch_bounds__(NTHREADS, 2) fwd(Args args) {
    __shared__ __attribute__((aligned(16))) unsigned char lds_raw[LDS_BYTES];
    Frame F;
    F.lds = (LAS unsigned char*)lds_raw;
    F.tid = threadIdx.x; F.lane = F.tid & 63; F.wave = __builtin_amdgcn_readfirstlane(F.tid >> 6);
    F.G = gridDim.x; { const int bx = blockIdx.x; F.vcu = (F.G % 8 == 0) ? (bx % 8) * (F.G / 8) + bx / 8 : bx; }
    F.ws = args.ws;
    volatile LAS unsigned* MISC = (volatile LAS unsigned*)(F.lds + LDSCTL_OFF);
    for (int u = F.tid; u < (LDS_BYTES - LDSCTL_OFF) / 4; u += NTHREADS) MISC[u] = 0u;
    __syncthreads();
#if !MK_PER_PHASE
    XcdBarrier bar = xcd_barrier_post((unsigned*)(F.ws + WS_CTL) + CW_BAR, MISC + 8);
#define GRID_BAR() xcd_barrier(bar)
#else
#define GRID_BAR() do { } while (0)
#endif
    const int lo = args.ph_lo, hi = args.ph_hi;
#define IN(k) (lo <= (k) && (k) < hi)
#ifndef PROBE_DOUBLE
#define PROBE_DOUBLE (-1)
#endif
#define REP(k) for (int rep_ = 0; rep_ < ((PROBE_DOUBLE) == (k) ? 2 : 1); ++rep_)
#define SEAM(k) do { if (IN(k) && IN((k) + 1)) GRID_BAR(); } while (0)

    if (IN(0)) REP(0) { p0_prologue(F, args); } SEAM(0);
    if (IN(1)) REP(1) {
        pg8::Gemm g{(const bf16_t*)(F.ws + WS_Y), (const bf16_t*)(F.ws + WS_WIN), T, NPROJ, D}; pg8::StaticOrder S; S.init(T, NPROJ, F.G, (int)blockIdx.x);
        pg8::EpiProj E{(bf16_t*)(F.ws + WS_R3)};
        pg8::gemm_phase<pg8::EpiProj, pg8::StaticOrder>(F.lds, g, S, E);
    } SEAM(1);
    if (IN(2)) REP(2) {
        if (F.vcu < NB * 32 * NH) {
            bf16x8 af[4]; GmPre GP; int hcur = -1;
            gmlp_prefetch(F, GP, F.vcu);
            for (int u = F.vcu; u < NB * 32 * NH; u += F.G) {
                if ((u & 3) != hcur) { hcur = u & 3; gmlp_wfrags(F, args, hcur, af); }
                gmlp_unit(F, args, u, af, GP, (u + F.G < NB * 32 * NH) ? u + F.G : -1);
            }
        }
        if (F.vcu < NCHUNKS) {
            const int h0 = (F.vcu >> 6) & 3;
            DnPre P; int hcur = -1;
            dn_prefetch(F, P, F.vcu);
            for (int u = F.vcu; u < NCHUNKS; u += F.G) {
                const int hh = (u >> 6) & 3;
                if (hh != hcur) { __syncthreads(); for (int i = F.tid; i < 3 * 4 * 128; i += NTHREADS) { const int ten = i / 512, j = (i >> 7) & 3, c = i & 127; ((LAS float*)(F.lds + DN_CW))[i] = args.in[6][(size_t)j * 1536 + ten * 512 + hh * HD + c]; } hcur = hh; LDS_WAIT(); __syncthreads(); }
                dn_chunk(F, args, u, P, (u + F.G < NCHUNKS) ? u + F.G : -1);
            }
            (void)h0;
        }
    } SEAM(2);
    if (IN(3)) {
        const int bx = (int)blockIdx.x, nscan = F.G >= 2 ? F.G / 2 : 1;
        if (bx < nscan) {
            const int sid = (nscan % 8 == 0) ? (bx % 8) * (nscan / 8) + bx / 8 : bx;
            for (int it = sid; it < NB * NH * 4; it += nscan) dn_scan(F, it);
            if (F.G < 2) convert_experts(F, args, F.wave, NWAVES);
        } else convert_experts(F, args, (bx - nscan) * NWAVES + F.wave, (F.G - nscan) * NWAVES);
    } SEAM(3);
    if (IN(4)) REP(4) { dn_out(F, args); } SEAM(4);
    if (IN(5)) REP(5) {
        pg8::Gemm g{(const bf16_t*)(F.ws + WS_MIX), (const bf16_t*)(F.ws + WS_WOUT), T, D, D}; pg8::StaticOrder S; S.init(T, D, F.G, (int)blockIdx.x);
        pg8::EpiResid E{args.in[0], (bf16_t*)(F.ws + WS_H)};
        pg8::gemm_phase<pg8::EpiResid, pg8::StaticOrder>(F.lds, g, S, E);
    } SEAM(5);
    if (IN(6)) { route(F, args); } SEAM(6);
    if (IN(8)) { build_tables(F); REP(8) gather_rows(F); } SEAM(8);
    if (IN(9)) {
        if (!IN(8)) build_tables(F);
        const int rtot = ((LAS int*)(F.lds + TB_OFF))[32];
        REP(9) {
        pg8::Gemm g{(const bf16_t*)(F.ws + WS_R3), (const bf16_t*)(F.ws + WS_WGU), rtot, 2048, D / 2}; pg8::MoeOrder S; S.init(rtot, 2048, F.G, (int)blockIdx.x); S.tile_e = (const LAS int*)(F.lds + TB_OFF) + 80;
        pg8::EpiSwiglu E{F.ws + WS_R4, args.in[15]};
        pg8::gemm_phase<pg8::EpiSwiglu, pg8::MoeOrder, true>(F.lds, g, S, E);
        }
    } SEAM(9);
    if (IN(10)) {
        if (!IN(9)) build_tables(F);
        const int rtot = ((LAS int*)(F.lds + TB_OFF))[32];
        REP(10) {
        pg8::Gemm g{(const bf16_t*)(F.ws + WS_R4), (const bf16_t*)(F.ws + WS_WDN), rtot, D, DFF / 2}; pg8::MoeOrder S; S.init(rtot, D, F.G, (int)blockIdx.x); S.tile_e = (const LAS int*)(F.lds + TB_OFF) + 80;
        pg8::EpiDown E{F.ws + WS_YS, args.in[17], (const float*)(F.ws + WS_GSORT)};
        pg8::gemm_phase<pg8::EpiDown, pg8::MoeOrder, true>(F.lds, g, S, E);
        }
    } SEAM(10);
    if (IN(11)) REP(11) { combine(F, args); }
#if defined(DBG_DUMP)
    if (IN(12)) { dbg_dump(F, args, DBG_DUMP); }
#endif
#undef IN
#undef SEAM
}

extern "C" void kernel_launch(void* const* d_in, const int* in_sizes, int n_in, void* d_out, int out_size, void* d_ws, size_t ws_size, hipStream_t stream) {
    static int grid = 0;
    if (grid == 0) {
        if (n_in != 19 || out_size != T * D || ws_size < WS_END) { fprintf(stderr, "kernel_launch: unexpected shapes (n_in %d, out %d, ws %zu)\n", n_in, out_size, ws_size); grid = -1; return; }
        int dev = 0, cus = 0, per_cu = 0;
        if (hipGetDevice(&dev) != hipSuccess || hipDeviceGetAttribute(&cus, hipDeviceAttributeMultiprocessorCount, dev) != hipSuccess) { grid = -1; return; }
        if (hipOccupancyMaxActiveBlocksPerMultiprocessor(&per_cu, (const void*)fwd, NTHREADS, 0) != hipSuccess || per_cu < 1) fprintf(stderr, "kernel_launch: occupancy query reports %d\n", per_cu);
        (void)hipGetLastError();
        grid = cus;
    }
    if (grid < 0) return;
    (void)hipMemsetAsync((char*)d_ws + WS_CTL, 0, CTL_ZERO_BYTES, stream);
    Args a{};
    for (int i = 0; i < 19; ++i) a.in[i] = (const float*)d_in[i];
    a.out = (float*)d_out; a.ws = (unsigned char*)d_ws;
#if MK_PER_PHASE
    for (int p = 0; p < NPHASES; ++p) {
#if defined(DBG_DUMP)
        if (p > DBG_LAST) continue;
#endif
        a.ph_lo = p; a.ph_hi = p + 1; hipLaunchKernelGGL(fwd, dim3(grid), dim3(NTHREADS), 0, stream, a); }
#if defined(DBG_DUMP)
    a.ph_lo = 12; a.ph_hi = 13; hipLaunchKernelGGL(fwd, dim3(grid), dim3(NTHREADS), 0, stream, a);
#endif
#else
    a.ph_lo = 0; a.ph_hi = NPHASES; hipLaunchKernelGGL(fwd, dim3(grid), dim3(NTHREADS), 0, stream, a);
#endif
}
```

```cpp
#include <hip/hip_runtime.h>
#include <cstdio>
#include <cstdint>

#ifndef MK_PER_PHASE
#define MK_PER_PHASE 0
#endif

#define LAS __attribute__((address_space(3)))
#define GAS __attribute__((address_space(1)))
typedef unsigned short bf16_t;
typedef short bf16x8 __attribute__((ext_vector_type(8)));
typedef float f32x4 __attribute__((ext_vector_type(4)));
typedef float f32x2 __attribute__((ext_vector_type(2)));
typedef unsigned u32x4 __attribute__((ext_vector_type(4)));
typedef unsigned u32x2 __attribute__((ext_vector_type(2)));
typedef int i32x4 __attribute__((ext_vector_type(4)));
typedef int i32x8 __attribute__((ext_vector_type(8)));

constexpr int NB = 8, SEQ = 4096, D = 1024, T = NB * SEQ;
constexpr int DIN = 3080, NPROJ = 3072;
constexpr int NE = 32, TOPK = 4, DFF = 1024;
constexpr int NH = 4, HD = 128, GMC = 128, DNC = 64;
constexpr int NCH = SEQ / DNC;
constexpr int NCHUNKS = NB * NH * NCH;
constexpr int RMAX = T * TOPK + NE * 256;
constexpr float EPS = 1e-6f;
constexpr int NWAVES = 8, NTHREADS = 512;

constexpr size_t MiB = 1u << 20;
constexpr size_t WS_CTL = 0, CTL_ZERO_BYTES = 32768;
constexpr size_t WS_AB = 1 * MiB;
constexpr size_t WS_EIDX = 2 * MiB;
constexpr size_t WS_GATEW = 2 * MiB + 512 * 1024;
constexpr size_t WS_ROWOF = 3 * MiB;
constexpr size_t WS_EPOS = 3 * MiB + 512 * 1024;
constexpr size_t WS_GSORT = 4 * MiB;
constexpr size_t WS_LIST = 5 * MiB;
constexpr size_t WS_RWT = 9 * MiB;
constexpr size_t WS_GLAST = 10 * MiB;
constexpr size_t WS_WIN = 16 * MiB;
constexpr size_t WS_WOUT = 22 * MiB;
constexpr size_t WS_WGU = 24 * MiB;
constexpr size_t WS_WDN = 152 * MiB;
constexpr size_t WS_HN8 = 88 * MiB;
constexpr size_t WS_H = 216 * MiB;
constexpr size_t WS_R3 = 344 * MiB;
constexpr size_t WS_R4 = 616 * MiB;
constexpr size_t WS_Y = WS_R4;
constexpr size_t WS_WC = WS_R4;
constexpr size_t WS_UC = WS_R4 + 32 * MiB;
constexpr size_t WS_QD = WS_R4 + 64 * MiB;
constexpr size_t WS_KET = WS_R4 + 96 * MiB;
constexpr size_t WS_AT = WS_R4 + 128 * MiB;
constexpr size_t WS_MIX = WS_R4 + 144 * MiB;
constexpr size_t WS_O = WS_R4 + 208 * MiB;
constexpr size_t WS_HN = 888 * MiB;
constexpr size_t WS_YS = WS_R3 + 136 * MiB;
constexpr size_t WS_END = 952 * MiB;
constexpr int CW_BAR = 0;
constexpr int CW_CNT = 4096;

constexpr int RING_BYTES = 155648;
constexpr int LDSCTL_OFF = RING_BYTES;
constexpr int LDS_BYTES = RING_BYTES + 1024;

#define LDS_WAIT() asm volatile("s_waitcnt lgkmcnt(0)" ::: "memory")
#define VM_WAIT() asm volatile("s_waitcnt vmcnt(0)" ::: "memory")
#define LDS_BAR() do { asm volatile("s_waitcnt lgkmcnt(0)" ::: "memory"); __builtin_amdgcn_s_barrier(); asm volatile("" ::: "memory"); } while (0)
typedef __bf16 bf16x2_t __attribute__((ext_vector_type(2)));
__device__ __forceinline__ unsigned cvt_pk_bf16(float lo, float hi) { const bf16x2_t r = __builtin_convertvector((f32x2){lo, hi}, bf16x2_t); return __builtin_bit_cast(unsigned, r); }
__device__ __forceinline__ float bf2f(unsigned short b) { return __uint_as_float(((unsigned)b) << 16); }
__device__ __forceinline__ float bflo(unsigned w) { return __uint_as_float(w << 16); }
__device__ __forceinline__ float bfhi(unsigned w) { return __uint_as_float(w & 0xffff0000u); }
__device__ __forceinline__ bf16_t f2bf(float f) { return (bf16_t)(cvt_pk_bf16(f, 0.f) & 0xffffu); }
__device__ __forceinline__ unsigned cvt4_fp8(float a, float b, float c, float d) { int r = __builtin_amdgcn_cvt_pk_fp8_f32(a, b, 0, false); r = __builtin_amdgcn_cvt_pk_fp8_f32(c, d, r, true); return (unsigned)r; }
constexpr float W8_SCALE = 32.0f, W8_INV = 1.0f / 32.0f;
__device__ __forceinline__ float wave_sum(float v) {
#pragma unroll
    for (int o = 1; o < 64; o <<= 1) v += __shfl_xor(v, o);
    return v;
}
__device__ __forceinline__ float sigmoid_f(float v) { return __builtin_amdgcn_rcpf(1.0f + __builtin_amdgcn_exp2f(-1.44269504f * v)); }
__device__ __forceinline__ float silu_f(float v) { return v * sigmoid_f(v); }
__device__ __forceinline__ f32x2 gelu_pk(f32x2 v) {
    const f32x2 av = __builtin_elementwise_abs(v), d = av * 0.2316418882f + 1.0f;
    f32x2 t; t.x = __builtin_amdgcn_rcpf(d.x); t.y = __builtin_amdgcn_rcpf(d.y);
    f32x2 q = t * 0.5307027145f + (-0.7265760135f); q = q * t + 0.7107068705f; q = q * t + (-0.142248368f); q = q * t + 0.127414796f; q = q * t;
    const f32x2 s = (v * v) * (-0.72134752044f);
    f32x2 e; e.x = __builtin_amdgcn_exp2f(s.x); e.y = __builtin_amdgcn_exp2f(s.y);
    const f32x2 m = v * (q * e), r = v - m;
    f32x2 o; o.x = v.x < 0.f ? m.x : r.x; o.y = v.y < 0.f ? m.y : r.y; return o;
}

#define XB_TMO      128
#define XB_XCNT(j)  (256  + 64 * (j))
#define XB_XSUB(j)  (1280 + 64 * (j))
#define XB_XGEN(j)  (2304 + 64 * (j))
#define XB_TOP      3328
#define XB_TOPGEN   3392
#define XCD_BAR_WORDS 3456
#define XB_SPIN_CAP (1u << 18)
__device__ __forceinline__ unsigned xb_ld(unsigned* p)              { return __hip_atomic_load(p, __ATOMIC_RELAXED, __HIP_MEMORY_SCOPE_AGENT); }
__device__ __forceinline__ unsigned xb_add(unsigned* p, unsigned v) { return __hip_atomic_fetch_add(p, v, __ATOMIC_RELAXED, __HIP_MEMORY_SCOPE_AGENT); }
__device__ __forceinline__ unsigned xb_xcc_id() { return (unsigned)__builtin_amdgcn_s_getreg((3 << 11) | 20) & 0xFu; }
#define XB_SPIN(cond, bar) do { unsigned _sp = 0; while (cond) { __builtin_amdgcn_s_sleep(1); \
    if ((++_sp & 255u) == 0u) { if (xb_ld(&(bar)[XB_TMO])) break; if (_sp > XB_SPIN_CAP) { atomicAdd(&(bar)[XB_TMO], 1u); break; } } } } while (0)
struct XcdBarrier { unsigned* bar; unsigned x; volatile LAS unsigned* st; };
__device__ __forceinline__ XcdBarrier xcd_barrier_post(unsigned* bar, volatile LAS unsigned* st) {
    XcdBarrier b; b.bar = bar; b.x = xb_xcc_id(); b.st = st;
    if (threadIdx.x == 0) (void)xb_add(&bar[XB_XCNT(b.x)], 1u);
    return b;
}
__device__ __forceinline__ void xcd_barrier_complete(unsigned* bar, unsigned x, unsigned& nloc, unsigned& nx) {
    const unsigned G = gridDim.x * gridDim.y * gridDim.z;
    unsigned sum, cnt, mine, sp = 0u;
    for (;;) {
        sum = 0u; cnt = 0u; mine = 0u;
#pragma unroll
        for (unsigned j = 0; j < 16; ++j) { const unsigned c = xb_ld(&bar[XB_XCNT(j)]); sum += c; cnt += (c > 0u) ? 1u : 0u; mine = (j == x) ? c : mine; }
        if (sum == G) break;
        __builtin_amdgcn_s_sleep(1);
        if ((++sp & 255u) == 0u) { if (xb_ld(&bar[XB_TMO])) break; if (sp > XB_SPIN_CAP) { atomicAdd(&bar[XB_TMO], 1u); break; } }
    }
    nloc = mine > 0u ? mine : 1u; nx = cnt > 0u ? cnt : 1u;
}
__device__ __forceinline__ void xcd_barrier(const XcdBarrier& b) {
    asm volatile("s_waitcnt vmcnt(0)" ::: "memory");
    __syncthreads();
    if (threadIdx.x == 0) {
        unsigned* bar = b.bar;
        __builtin_amdgcn_s_waitcnt(0);
        unsigned nloc = b.st[0], nx = b.st[1];
        if (nloc == 0u) { xcd_barrier_complete(bar, b.x, nloc, nx); b.st[0] = nloc; b.st[1] = nx; }
        const unsigned old = xb_add(&bar[XB_XSUB(b.x)], 1u);
        const unsigned gen = old / nloc;
        if (old + 1u == (gen + 1u) * nloc) {
            __builtin_amdgcn_fence(__ATOMIC_RELEASE, "agent");
            asm volatile("s_waitcnt vmcnt(0)" ::: "memory");
            const unsigned og = xb_add(&bar[XB_TOP], 1u);
            const unsigned tg = og / nx;
            if (og + 1u == (tg + 1u) * nx) xb_add(&bar[XB_TOPGEN], 1u);
            else XB_SPIN(xb_ld(&bar[XB_TOPGEN]) == tg, bar);
            __builtin_amdgcn_fence(__ATOMIC_ACQUIRE, "agent");
            xb_add(&bar[XB_XGEN(b.x)], 1u);
            asm volatile("s_waitcnt vmcnt(0)" ::: "memory");
        } else {
            XB_SPIN(xb_ld(&bar[XB_XGEN(b.x)]) == gen, bar);
            __builtin_amdgcn_fence(__ATOMIC_ACQUIRE, "agent");
            asm volatile("s_waitcnt vmcnt(0)" ::: "memory");
        }
    }
    __syncthreads();
}

namespace pg8 {
constexpr int BM = 256, BK = 64, HALF = 128, HTB = HALF * BK * 2, STAGE_BYTES = 8 * HTB, NXCD = 8, WGM = 8;
__host__ __device__ __forceinline__ int lds_byte(int r, int c) { const int st = (r >> 4) * 2 + (c >> 5), rr = r & 15, cc = c & 31, ob = rr * 64 + cc * 2; return st * 1024 + (ob ^ (((ob >> 9) & 1) << 5)); }
__host__ __device__ __forceinline__ void stage_rc(int b, int& R, int& C) { const int st = b / 1024, sb = b % 1024, swz = sb ^ (((sb >> 9) & 1) << 5); R = (st >> 1) * 16 + swz / 64; C = (st & 1) * 32 + (swz % 64) / 2; }
__host__ __device__ __forceinline__ int perm32(int rho) { const int n = rho >> 4, i = rho & 15; return 8 * (i >> 2) + 4 * n + (i & 3); }

constexpr int EPI_LDS = 135168;
struct Unit { int pm, pn, pb; };
struct Gemm { const bf16_t* A; const bf16_t* Bt; int M, N, K; };

struct StaticOrder {
    int nM, nN, nwg, G, c;
    __device__ void init(int M, int N, int G_, int c_) { nM = M / BM; nN = N / BM; nwg = nM * nN; G = G_; c = c_; }
    __device__ bool next(int i, Unit& u) const {
        const long L = (long)i * G + c; if (L >= nwg) return false;
        int wgid = (int)L; { const int q = nwg / NXCD, r = nwg % NXCD, xcd = wgid % NXCD, off = wgid / NXCD; wgid = (xcd < r ? xcd * (q + 1) : r * (q + 1) + (xcd - r) * q) + off; }
        const int nig = WGM * nN, gid = wgid / nig, fm = gid * WGM, gsz = (nM - fm) < WGM ? (nM - fm) : WGM;
        u.pm = fm + ((wgid % nig) % gsz); u.pn = (wgid % nig) / gsz; u.pb = u.pn; return true;
    }
};
struct MoeOrder : StaticOrder {
    const LAS int* tile_e;
    __device__ bool next(int i, Unit& u) const { if (!StaticOrder::next(i, u)) return false; u.pb = __builtin_amdgcn_readfirstlane(tile_e[u.pm]) * nN + u.pn; return true; }
};

template <class Epi, class Sched, bool FP8 = false>
__device__ __forceinline__ void gemm_phase(LAS unsigned char* lds, const Gemm g, const Sched& S, const Epi& E) {
    const int tid = threadIdx.x, wid = __builtin_amdgcn_readfirstlane(tid >> 6), lane = tid & 63, wr = wid >> 2, wc = wid & 3, fr = lane & 15, fq = lane >> 4;
    const int K = g.K, nt = K / BK;
    unsigned voffA[2], voffB[2];
#pragma unroll
    for (int i = 0; i < 2; ++i) { int R, C; stage_rc(tid * 16 + i * 8192, R, C); const int Rb = Epi::PERM ? ((R & ~31) + perm32(R & 31)) : R;
        voffA[i] = (unsigned)(R * K + C) * 2u; voffB[i] = (unsigned)(Rb * K + C) * 2u; }
    const size_t kstep = (size_t)(BK * 2);
    const size_t hstep = (size_t)HALF * K * 2;
    const size_t tstep = 2 * hstep;
    const unsigned ldsw = (unsigned)wid * 1024u;
    const int aoff = lds_byte(wr * 64 + fr, fq * 8), boff = lds_byte(wc * 32 + fr, fq * 8);
    LAS unsigned char* ldsA = lds + aoff; LAS unsigned char* ldsB = lds + 4 * HTB + boff;
    asm volatile("" : "+v"(ldsA)); asm volatile("" : "+v"(ldsB));
#define PG8_SA(b, h) (((b) * 2 + (h)) * HTB)
#define PG8_SB(b, h) ((4 + (b) * 2 + (h)) * HTB)
#define PG8_STAGE(bufoff, gbase, voff) do { _Pragma("unroll") for (int _i = 0; _i < 2; ++_i) \
        __builtin_amdgcn_global_load_lds((const unsigned*)((const char*)(gbase) + (voff)[_i]), (LAS unsigned*)(lds + (bufoff) + ldsw + _i * 8192), 16, 0, 0); } while (0)
#define PG8_LD2(dst, addr) do { if constexpr (FP8) { const i32x4 lo_ = *(const LAS i32x4*)(addr), hi_ = *(const LAS i32x4*)((addr) + 1024); (dst).w = __builtin_shufflevector(lo_, hi_, 0, 1, 2, 3, 4, 5, 6, 7); } \
        else { (dst).h[0] = *(const LAS bf16x8*)(addr); (dst).h[1] = *(const LAS bf16x8*)((addr) + 1024); } } while (0)
#define PG8_LDA(dst, b, h) do { _Pragma("unroll") for (int m = 0; m < 4; ++m) PG8_LD2(dst[m], ldsA + PG8_SA(b, h) + m * 2048); } while (0)
#define PG8_LDB(dst, b, h) do { _Pragma("unroll") for (int n = 0; n < 2; ++n) PG8_LD2(dst[n], ldsB + PG8_SA(b, h) + n * 2048); } while (0)
#define PG8_MMA(ai, bj, At, Bt) do { __builtin_amdgcn_s_setprio(1); \
        if constexpr (FP8) { _Pragma("unroll") for (int m = 0; m < 4; ++m) _Pragma("unroll") for (int n = 0; n < 2; ++n) \
            asm volatile("v_mfma_f32_16x16x128_f8f6f4 %0, %1, %2, %0" : "+v"(acc[ai][bj][m][n]) : "v"(Bt[n].w), "v"(At[m].w)); } \
        else { _Pragma("unroll") for (int m = 0; m < 4; ++m) _Pragma("unroll") for (int n = 0; n < 2; ++n) _Pragma("unroll") for (int k = 0; k < 2; ++k) \
            acc[ai][bj][m][n] = __builtin_amdgcn_mfma_f32_16x16x32_bf16(Bt[n].h[k], At[m].h[k], acc[ai][bj][m][n], 0, 0, 0); } \
        __builtin_amdgcn_s_setprio(0); } while (0)
#define PG8_WAIT_V(n) asm volatile("s_waitcnt vmcnt(" #n ")" ::: "memory")
#define PG8_WAIT_L(n) asm volatile("s_waitcnt lgkmcnt(" #n ")" ::: "memory")
#define PG8_BAR __builtin_amdgcn_s_barrier()
#define PG8_SCHED __builtin_amdgcn_sched_barrier(0)
    Unit cur, nxt; int ui = 0;
    if (!S.next(0, cur)) return;
    f32x4 acc[2][2][4][2];
#pragma unroll
    for (int a = 0; a < 2; ++a)
#pragma unroll
        for (int b = 0; b < 2; ++b)
#pragma unroll
            for (int m = 0; m < 4; ++m)
#pragma unroll
                for (int n = 0; n < 2; ++n) acc[a][b][m][n] = (f32x4){0.f, 0.f, 0.f, 0.f};
    union Frag { bf16x8 h[2]; i32x8 w; };
    Frag At[4], B0[2], B1[2];
    const char* cA = (const char*)g.A + (size_t)cur.pm * tstep; const char* cB = (const char*)g.Bt + (size_t)cur.pb * tstep;
    PG8_STAGE(PG8_SB(0, 0), cB, voffB); PG8_STAGE(PG8_SB(0, 1), cB + hstep, voffB); PG8_STAGE(PG8_SA(0, 0), cA, voffA); PG8_STAGE(PG8_SA(0, 1), cA + hstep, voffA);
    if (wr == 1) PG8_BAR;
    PG8_WAIT_V(2); PG8_BAR;
    PG8_STAGE(PG8_SB(1, 0), cB + kstep, voffB); PG8_STAGE(PG8_SA(1, 0), cA + kstep, voffA); PG8_STAGE(PG8_SB(1, 1), cB + hstep + kstep, voffB);
    PG8_WAIT_V(6); PG8_BAR;
    for (;;) {
        const bool has_next = S.next(ui + 1, nxt);
        const char* nA = has_next ? (const char*)g.A + (size_t)nxt.pm * tstep : cA; const char* nB = has_next ? (const char*)g.Bt + (size_t)nxt.pb * tstep : cB;
        for (int t = 0; t < nt; t += 2) {
            const bool last = (t == nt - 2);
            if constexpr (Epi::HAS_PREFETCH) { if (t == 0 && wid == 0) E.prefetch(lds + EPI_LDS + (ui & 1) * 2048, cur, lane); }
            const char* a1 = cA + (size_t)(t + 1) * kstep;
            const char* a2 = last ? nA : cA + (size_t)(t + 2) * kstep; const char* b2 = last ? nB : cB + (size_t)(t + 2) * kstep;
            const char* a3 = a2 + kstep; const char* b3 = b2 + kstep;
            PG8_LDB(B0, 0, 0); PG8_LDB(B1, 0, 1); PG8_SCHED; PG8_LDA(At, 0, 0); PG8_STAGE(PG8_SA(1, 1), a1 + hstep, voffA);
            PG8_WAIT_V(8); PG8_WAIT_L(0); PG8_BAR; PG8_MMA(0, 0, At, B0); PG8_MMA(0, 1, At, B1); PG8_BAR; PG8_SCHED;
            PG8_LDA(At, 0, 1); PG8_STAGE(PG8_SB(0, 0), b2, voffB); PG8_STAGE(PG8_SB(0, 1), b2 + hstep, voffB); PG8_STAGE(PG8_SA(0, 0), a2, voffA);
            PG8_WAIT_V(8); PG8_WAIT_L(0); PG8_BAR; PG8_MMA(1, 0, At, B0); PG8_MMA(1, 1, At, B1); PG8_BAR; PG8_SCHED;
            PG8_LDB(B0, 1, 0); PG8_LDB(B1, 1, 1); PG8_SCHED; PG8_LDA(At, 1, 0); PG8_STAGE(PG8_SA(0, 1), a2 + hstep, voffA);
            PG8_WAIT_V(8); PG8_WAIT_L(0); PG8_BAR; PG8_MMA(0, 0, At, B0); PG8_MMA(0, 1, At, B1); PG8_BAR; PG8_SCHED;
            PG8_LDA(At, 1, 1); PG8_STAGE(PG8_SB(1, 0), b3, voffB); PG8_STAGE(PG8_SB(1, 1), b3 + hstep, voffB); PG8_STAGE(PG8_SA(1, 0), a3, voffA);
            PG8_WAIT_V(8); PG8_WAIT_L(0); PG8_BAR; PG8_MMA(1, 0, At, B0); PG8_MMA(1, 1, At, B1); PG8_BAR; PG8_SCHED;
        }
        if (wr == 0) PG8_BAR;
        if constexpr (FP8) asm volatile("s_nop 15\n\ts_nop 15" ::: "memory");
        { int fr_ = fr, fq_ = fq; asm volatile("" : "+v"(fr_), "+v"(fq_));
          E(acc, cur, wr, wc, fr_, fq_, (const LAS float*)(lds + EPI_LDS + (ui & 1) * 2048)); }
        if (!has_next) break;
#pragma unroll
        for (int a = 0; a < 2; ++a)
#pragma unroll
            for (int b = 0; b < 2; ++b)
#pragma unroll
                for (int m = 0; m < 4; ++m)
#pragma unroll
                    for (int n = 0; n < 2; ++n) { acc[a][b][m][n] = (f32x4){0.f, 0.f, 0.f, 0.f}; if constexpr (FP8) asm volatile("" : "+v"(acc[a][b][m][n])); }
        cur = nxt; cA = nA; cB = nB; ++ui;
        if (wr == 1) PG8_BAR;
    }
    PG8_WAIT_V(0);
    PG8_BAR;
#undef PG8_SA
#undef PG8_SB
#undef PG8_STAGE
#undef PG8_LDA
#undef PG8_LDB
#undef PG8_MMA
#undef PG8_LD2
#undef PG8_WAIT_V
#undef PG8_WAIT_L
#undef PG8_BAR
#undef PG8_SCHED
}

struct EpiProj {
    static constexpr bool PERM = true, HAS_PREFETCH = false;
    bf16_t* O;
    __device__ __forceinline__ void operator()(const f32x4 (&acc)[2][2][4][2], const Unit& u, int wr, int wc, int fr, int fq, const LAS float*) const {
        const int row0 = u.pm * BM + wr * 64 + fr, col0 = u.pn * BM + wc * 32 + 8 * fq;
#pragma unroll
        for (int ai = 0; ai < 2; ++ai)
#pragma unroll
            for (int m = 0; m < 4; ++m) { bf16_t* rowp = O + (size_t)(row0 + ai * HALF + m * 16) * NPROJ + col0;
#pragma unroll
                for (int bj = 0; bj < 2; ++bj) { const f32x4 v0 = acc[ai][bj][m][0], v1 = acc[ai][bj][m][1];
                    u32x4 w; w.x = cvt_pk_bf16(v0[0], v0[1]); w.y = cvt_pk_bf16(v0[2], v0[3]); w.z = cvt_pk_bf16(v1[0], v1[1]); w.w = cvt_pk_bf16(v1[2], v1[3]);
                    *(u32x4*)(rowp + bj * HALF) = w; } }
    }
};
struct EpiResid {
    static constexpr bool PERM = true, HAS_PREFETCH = false;
    const float* X; bf16_t* H;
    __device__ __forceinline__ void operator()(const f32x4 (&acc)[2][2][4][2], const Unit& u, int wr, int wc, int fr, int fq, const LAS float*) const {
        const int row0 = u.pm * BM + wr * 64 + fr, col0 = u.pn * BM + wc * 32 + 8 * fq;
#pragma unroll
        for (int ai = 0; ai < 2; ++ai)
#pragma unroll
            for (int m = 0; m < 4; ++m) { const size_t off = (size_t)(row0 + ai * HALF + m * 16) * D + col0;
#pragma unroll
                for (int bj = 0; bj < 2; ++bj) { const f32x4 v0 = acc[ai][bj][m][0] + *(const f32x4*)(X + off + bj * HALF), v1 = acc[ai][bj][m][1] + *(const f32x4*)(X + off + bj * HALF + 4);
                    u32x4 w; w.x = cvt_pk_bf16(v0[0], v0[1]); w.y = cvt_pk_bf16(v0[2], v0[3]); w.z = cvt_pk_bf16(v1[0], v1[1]); w.w = cvt_pk_bf16(v1[2], v1[3]);
                    *(u32x4*)(H + off + bj * HALF) = w; } }
    }
};
struct EpiSwiglu {
    static constexpr bool PERM = true, HAS_PREFETCH = true;
    unsigned char* O; const float* bgu;
    __device__ __forceinline__ void prefetch(LAS unsigned char* area, const Unit& u, int lane) const {
        const float* src = bgu + (size_t)(u.pb >> 3) * 2048 + u.pn * HALF + (lane < 32 ? 4 * lane : 1024 + 4 * (lane - 32));
        __builtin_amdgcn_global_load_lds((const unsigned*)src, (LAS unsigned*)area, 16, 0, 0);
    }
    __device__ __forceinline__ void operator()(const f32x4 (&acc)[2][2][4][2], const Unit& u, int wr, int wc, int fr, int fq, const LAS float* bl) const {
        const int row0 = u.pm * BM + wr * 64 + fr, jl = wc * 32 + 8 * fq, j0 = u.pn * HALF + jl;
        f32x4 bgv[2], buv[2];
#pragma unroll
        for (int n = 0; n < 2; ++n) { bgv[n] = *(const LAS f32x4*)(bl + jl + 4 * n); buv[n] = *(const LAS f32x4*)(bl + 128 + jl + 4 * n); }
#pragma unroll
        for (int ai = 0; ai < 2; ++ai)
#pragma unroll
            for (int m = 0; m < 4; ++m) { unsigned char* rowp = O + (size_t)(row0 + ai * HALF + m * 16) * DFF + j0;
                u32x2 w;
#pragma unroll
                for (int n = 0; n < 2; ++n) { const f32x4 g4 = acc[ai][0][m][n] * W8_INV + bgv[n], u4 = acc[ai][1][m][n] * W8_INV + buv[n]; f32x4 r;
#pragma unroll
                    for (int j = 0; j < 4; ++j) { const float ga = fminf(g4[j], 7.0f), ua = fminf(fmaxf(u4[j], -7.0f), 7.0f);
                        r[j] = (ua + 1.0f) * ga * __builtin_amdgcn_rcpf(1.0f + __builtin_amdgcn_exp2f(-2.4554669f * ga)); }
                    w[n] = cvt4_fp8(r[0], r[1], r[2], r[3]); }
                *(u32x2*)rowp = w; }
    }
};
struct EpiDown {
    static constexpr bool PERM = true, HAS_PREFETCH = true;
    unsigned char* O; const float* bdn; const float* gsort;
    __device__ __forceinline__ void prefetch(LAS unsigned char* area, const Unit& u, int lane) const {
        __builtin_amdgcn_global_load_lds((const unsigned*)(bdn + (size_t)(u.pb >> 2) * D + u.pn * BM + 4 * lane), (LAS unsigned*)area, 16, 0, 0);
        __builtin_amdgcn_global_load_lds((const unsigned*)(gsort + (size_t)u.pm * BM + 4 * lane), (LAS unsigned*)(area + 1024), 16, 0, 0);
    }
    __device__ __forceinline__ void operator()(const f32x4 (&acc)[2][2][4][2], const Unit& u, int wr, int wc, int fr, int fq, const LAS float* bl) const {
        const int rl = wr * 64 + fr, cl = wc * 32 + 8 * fq, row0 = u.pm * BM + rl, col0 = u.pn * BM + cl;
        f32x4 bv[2][2]; float gw[2][4];
#pragma unroll
        for (int bj = 0; bj < 2; ++bj) { bv[bj][0] = *(const LAS f32x4*)(bl + cl + bj * HALF); bv[bj][1] = *(const LAS f32x4*)(bl + cl + bj * HALF + 4); }
#pragma unroll
        for (int ai = 0; ai < 2; ++ai)
#pragma unroll
            for (int m = 0; m < 4; ++m) gw[ai][m] = bl[256 + rl + ai * HALF + m * 16];
#pragma unroll
        for (int ai = 0; ai < 2; ++ai)
#pragma unroll
            for (int m = 0; m < 4; ++m) { const int r = row0 + ai * HALF + m * 16; const float g = gw[ai][m] * W8_INV; unsigned char* rowp = O + (size_t)r * D + col0;
#pragma unroll
                for (int bj = 0; bj < 2; ++bj) { const f32x4 v0 = acc[ai][bj][m][0] * g + bv[bj][0] * gw[ai][m], v1 = acc[ai][bj][m][1] * g + bv[bj][1] * gw[ai][m];
                    u32x2 w; w.x = cvt4_fp8(v0[0], v0[1], v0[2], v0[3]); w.y = cvt4_fp8(v1[0], v1[1], v1[2], v1[3]);
                    *(u32x2*)(rowp + bj * HALF) = w; } }
    }
};
}

struct Args {
    const float* in[19]; float* out; unsigned char* ws; int ph_lo, ph_hi;
};
struct Frame {
    LAS unsigned char* lds;
    int tid, lane, wave, G, vcu;
    unsigned char* ws;
};
#define MFMA16(a, b, c) __builtin_amdgcn_mfma_f32_16x16x32_bf16((a), (b), (c), 0, 0, 0)

__device__ __forceinline__ void tr_item(const float* src, size_t ldw, bf16_t* dst, LAS float* scr, int lane) {
    f32x4 v[16];
    const int kq = lane >> 4, n4 = 4 * (lane & 15);
#pragma unroll
    for (int i = 0; i < 16; ++i) v[i] = *(const f32x4*)(src + (size_t)(4 * i + kq) * ldw + n4);
#pragma unroll
    for (int i = 0; i < 16; ++i) { LAS float* s = scr + (4 * i + kq) * 65 + n4; s[0] = v[i][0]; s[1] = v[i][1]; s[2] = v[i][2]; s[3] = v[i][3]; }
    LDS_WAIT();
    const int c = lane & 7;
#pragma unroll
    for (int r = 0; r < 8; ++r) { const int n = 8 * r + (lane >> 3); const LAS float* s = scr + (8 * c) * 65 + n;
        u32x4 o; o.x = cvt_pk_bf16(s[0 * 65], s[1 * 65]); o.y = cvt_pk_bf16(s[2 * 65], s[3 * 65]); o.z = cvt_pk_bf16(s[4 * 65], s[5 * 65]); o.w = cvt_pk_bf16(s[6 * 65], s[7 * 65]);
        *(u32x4*)(dst + (size_t)n * 1024 + 8 * c) = o; }
    LDS_WAIT();
}
__device__ __forceinline__ void tr_item8(const float* src, size_t ldw, unsigned char* dst, LAS float* scr, int lane) {
    f32x4 v[16];
    const int kq = lane >> 3, n4 = 4 * (lane & 7);
#pragma unroll
    for (int i = 0; i < 16; ++i) v[i] = *(const f32x4*)(src + (size_t)(8 * i + kq) * ldw + n4);
#pragma unroll
    for (int i = 0; i < 16; ++i) { LAS float* s = scr + (8 * i + kq) * 33 + n4; s[0] = v[i][0]; s[1] = v[i][1]; s[2] = v[i][2]; s[3] = v[i][3]; }
    LDS_WAIT();
    const int c = lane >> 3, nn = lane & 7;
#pragma unroll
    for (int r = 0; r < 4; ++r) { const int n = 8 * r + nn; const LAS float* s = scr + (16 * c) * 33 + n;
        u32x4 o;
#pragma unroll
        for (int q = 0; q < 4; ++q) o[q] = cvt4_fp8(s[(4 * q) * 33] * W8_SCALE, s[(4 * q + 1) * 33] * W8_SCALE, s[(4 * q + 2) * 33] * W8_SCALE, s[(4 * q + 3) * 33] * W8_SCALE);
        *(u32x4*)(dst + (size_t)n * 1024 + 16 * c) = o; }
    LDS_WAIT();
}
constexpr int P0_WAB = 4 * 16896;
__device__ __forceinline__ void p0_prologue(const Frame& F, const Args& a) {
    const int gw = F.vcu * NWAVES + F.wave, NGW = F.G * NWAVES;
    const float* w_in = a.in[2]; const float* w_out = a.in[10]; const float* rw = a.in[12];
    bf16_t* WIN = (bf16_t*)(F.ws + WS_WIN); bf16_t* WOUT = (bf16_t*)(F.ws + WS_WOUT); bf16_t* RWT = (bf16_t*)(F.ws + WS_RWT);
    const float* x = a.in[0]; const float* g1 = a.in[1];
    bf16_t* Y = (bf16_t*)(F.ws + WS_Y); float* AB = (float*)(F.ws + WS_AB);
    LAS f32x4* wimg = (LAS f32x4*)(F.lds + P0_WAB);
    for (int r = F.tid; r < D; r += NTHREADS) {
        const float* p = w_in + (size_t)r * DIN + NPROJ;
        const f32x4 lo = *(const f32x4*)p, hi = *(const f32x4*)(p + 4);
        const int j = r >> 8, ln = (r & 255) >> 2, i = r & 3;
        wimg[((j * 4 + i) * 2 + 0) * 64 + ln] = lo; wimg[((j * 4 + i) * 2 + 1) * 64 + ln] = hi;
    }
    LDS_BAR();
    constexpr int I_IN = 16 * 48, I_OUT = 16 * 16, NITEMS = I_IN + I_OUT;
    if (F.wave < 4) {
        LAS float* scr = (LAS float*)(F.lds + F.wave * 16896);
        for (int it = F.vcu * 4 + F.wave; it < NITEMS; it += F.G * 4) {
            int r = it;
            if (r < I_IN) { const int kb = r / 48, nb = r % 48; tr_item(w_in + (size_t)(64 * kb) * DIN + 64 * nb, DIN, WIN + (size_t)(64 * nb) * 1024 + 64 * kb, scr, F.lane); continue; } r -= I_IN;
            { const int kb = r / 16, nb = r % 16; tr_item(w_out + (size_t)(64 * kb) * D + 64 * nb, D, WOUT + (size_t)(64 * nb) * 1024 + 64 * kb, scr, F.lane); }
        }
    } else {
        const int gq = F.vcu * 4 + (F.wave - 4), NGQ = F.G * 4;
        for (int i = gq * 64 + F.lane; i < 32 * 1024; i += NGQ * 64) { const int e = i >> 10, k = i & 1023; RWT[i] = f2bf(rw[(size_t)k * 32 + e]); }
    }
    volatile LAS unsigned* ctr = (volatile LAS unsigned*)(F.lds + LDSCTL_OFF) + 40;
    const int nidx = 8 * ((T + NGW - 1) / NGW);
    auto claim = [&]() -> int { unsigned c = 0; if (F.lane == 0) c = __hip_atomic_fetch_add((LAS unsigned*)ctr, 1u, __ATOMIC_RELAXED, __HIP_MEMORY_SCOPE_WORKGROUP); return (int)__builtin_amdgcn_readfirstlane(c); };
    auto rowof = [&](int idx) -> int { const int m = NGW * (idx >> 3) + 8 * F.vcu + (idx & 7); return (idx < nidx && m < T) ? m : -1; };
    (void)gw;
    f32x4 gv[4]; f32x4 wab[4][4][2];
    { int ln = F.lane; asm volatile("" : "+v"(ln));
#pragma unroll
    for (int j = 0; j < 4; ++j) { gv[j] = *(const f32x4*)(g1 + 4 * ln + 256 * j);
#pragma unroll
        for (int i = 0; i < 4; ++i) { wab[j][i][0] = wimg[((j * 4 + i) * 2 + 0) * 64 + ln]; wab[j][i][1] = wimg[((j * 4 + i) * 2 + 1) * 64 + ln]; } } }
    f32x4 v[4];
    int m = rowof(claim());
    if (m >= 0) {
#pragma unroll
        for (int j = 0; j < 4; ++j) v[j] = ((const f32x4*)(x + (size_t)m * D) + F.lane)[64 * j];
    }
    while (m >= 0) {
        f32x4 vn[4];
        const int mn = rowof(claim());
        if (mn >= 0) {
#pragma unroll
            for (int j = 0; j < 4; ++j) vn[j] = ((const f32x4*)(x + (size_t)mn * D) + F.lane)[64 * j];
        }
        float ss = 0.f;
#pragma unroll
        for (int j = 0; j < 4; ++j) ss += (v[j][0] * v[j][0] + v[j][1] * v[j][1]) + (v[j][2] * v[j][2] + v[j][3] * v[j][3]);
        const float rstd = rsqrtf(wave_sum(ss) * (1.0f / D) + EPS);
        f32x4 p0 = (f32x4){0.f, 0.f, 0.f, 0.f}, p1 = p0;
        u32x2* yo = (u32x2*)(Y + (size_t)m * D) + F.lane;
#pragma unroll
        for (int j = 0; j < 4; ++j) { const f32x4 y = v[j] * rstd * gv[j];
#pragma unroll
            for (int i = 0; i < 4; ++i) { p0 += wab[j][i][0] * y[i]; p1 += wab[j][i][1] * y[i]; }
            u32x2 w; w.x = cvt_pk_bf16(y[0], y[1]); w.y = cvt_pk_bf16(y[2], y[3]); yo[64 * j] = w; }
        const bool b0 = F.lane & 1, b1 = F.lane & 2, b2 = F.lane & 4;
        f32x4 k4 = b0 ? p1 : p0, s4 = b0 ? p0 : p1;
#pragma unroll
        for (int i = 0; i < 4; ++i) k4[i] += __shfl_xor(s4[i], 1);
        f32x2 k2 = b1 ? (f32x2){k4[2], k4[3]} : (f32x2){k4[0], k4[1]}, s2 = b1 ? (f32x2){k4[0], k4[1]} : (f32x2){k4[2], k4[3]};
        k2.x += __shfl_xor(s2.x, 2); k2.y += __shfl_xor(s2.y, 2);
        float k1 = b2 ? k2.y : k2.x; const float s1 = b2 ? k2.x : k2.y;
        k1 += __shfl_xor(s1, 4);
        k1 += __shfl_xor(k1, 8); k1 += __shfl_xor(k1, 16); k1 += __shfl_xor(k1, 32);
        if (F.lane < 8) AB[(size_t)m * 8 + (b0 ? 4 : 0) + (b1 ? 2 : 0) + (b2 ? 1 : 0)] = k1;
#pragma unroll
        for (int j = 0; j < 4; ++j) v[j] = vn[j];
        m = mn;
    }
}

constexpr int GM_LDT = 136;
constexpr int GM_U = 34816;
struct GmPre { u32x4 v[4], u[4]; };
__device__ __forceinline__ void gmlp_prefetch(const Frame& F, GmPre& P, int unit) {
    const int h = unit & 3, bn = unit >> 2, sp = F.tid >> 3, seg = F.tid & 7;
    const bf16_t* pv = (const bf16_t*)(F.ws + WS_R3) + ((size_t)bn * GMC + 2 * sp) * NPROJ + 512 + h * HD + 16 * seg; const bf16_t* pu = pv - 512;
    P.v[0] = *(const u32x4*)pv; P.v[1] = *(const u32x4*)(pv + 8); P.v[2] = *(const u32x4*)(pv + NPROJ); P.v[3] = *(const u32x4*)(pv + NPROJ + 8);
    P.u[0] = *(const u32x4*)pu; P.u[1] = *(const u32x4*)(pu + 8); P.u[2] = *(const u32x4*)(pu + NPROJ); P.u[3] = *(const u32x4*)(pu + NPROJ + 8);
}
__device__ __forceinline__ void gmlp_unit(const Frame& F, const Args& a, int unit, const bf16x8 (&af)[4], GmPre& P, int next_unit) {
    const int h = unit & 3, bn = unit >> 2;
    bf16_t* MIX = (bf16_t*)(F.ws + WS_MIX);
    const float* gmg = a.in[3] + h * HD; const float* bs = a.in[5] + h * GMC;
    LAS bf16_t* vnT = (LAS bf16_t*)F.lds;
    LAS bf16_t* uI = (LAS bf16_t*)(F.lds + GM_U);
    const size_t row0 = (size_t)bn * GMC;
    const int sp = F.tid >> 3, seg = F.tid & 7;
    {
        float x0[16], x1[16];
#pragma unroll
        for (int i = 0; i < 4; ++i) { x0[2 * i] = bflo(P.v[0][i]); x0[2 * i + 1] = bfhi(P.v[0][i]); x0[8 + 2 * i] = bflo(P.v[1][i]); x0[9 + 2 * i] = bfhi(P.v[1][i]);
                                      x1[2 * i] = bflo(P.v[2][i]); x1[2 * i + 1] = bfhi(P.v[2][i]); x1[8 + 2 * i] = bflo(P.v[3][i]); x1[9 + 2 * i] = bfhi(P.v[3][i]); }
#pragma unroll
        for (int i = 0; i < 16; ++i) { const f32x2 gg2 = gelu_pk((f32x2){x0[i], x1[i]}); x0[i] = gg2.x; x1[i] = gg2.y; }
        float s0 = 0.f, s1 = 0.f;
#pragma unroll
        for (int i = 0; i < 16; ++i) { s0 += x0[i] * x0[i]; s1 += x1[i] * x1[i]; }
#pragma unroll
        for (int o = 1; o < 8; o <<= 1) { s0 += __shfl_xor(s0, o); s1 += __shfl_xor(s1, o); }
        const float r0 = rsqrtf(s0 * (1.0f / HD) + EPS), r1 = rsqrtf(s1 * (1.0f / HD) + EPS);
#pragma unroll
        for (int i = 0; i < 16; ++i) { const float gg = gmg[16 * seg + i];
            *(LAS unsigned*)(vnT + (16 * seg + i) * GM_LDT + (((((sp >> 2) ^ seg) & 7) | ((sp >> 2) & 8)) << 3) + ((2 * sp) & 7)) = cvt_pk_bf16(x0[i] * r0 * gg, x1[i] * r1 * gg); }
#pragma unroll
        for (int rr = 0; rr < 2; ++rr)
#pragma unroll
            for (int hh = 0; hh < 2; ++hh) { const u32x4 uw = P.u[2 * rr + hh]; u32x4 o;
#pragma unroll
                for (int i = 0; i < 4; ++i) { const f32x2 g2 = gelu_pk((f32x2){bflo(uw[i]), bfhi(uw[i])}); o[i] = cvt_pk_bf16(g2.x, g2.y); }
                *(LAS u32x4*)(uI + (2 * sp + rr) * GM_LDT + 16 * seg + 8 * hh) = o; }
    }
    if (next_unit >= 0) gmlp_prefetch(F, P, next_unit);
    LDS_BAR();
    const int fr = F.lane & 15, fq = F.lane >> 4;
    f32x4 acc[8];
#pragma unroll
    for (int nt = 0; nt < 8; ++nt) { acc[nt] = (f32x4){0.f, 0.f, 0.f, 0.f};
#pragma unroll
        for (int kk = 0; kk < 4; ++kk) { const int ch = 4 * kk + fq; const bf16x8 bfr = *(const LAS bf16x8*)(vnT + (16 * nt + fr) * GM_LDT + ((((ch ^ nt) & 7) | (ch & 8)) << 3)); acc[nt] = MFMA16(af[kk], bfr, acc[nt]); } }
#pragma unroll
    for (int r = 0; r < 4; ++r) { const int t = 16 * F.wave + 4 * fq + r; const float bias = bs[t];
#pragma unroll
        for (int nt = 0; nt < 8; ++nt) { LAS bf16_t* q = uI + t * GM_LDT + 16 * nt + fr; *q = f2bf(bf2f(*q) * (acc[nt][r] + bias)); } }
    LDS_BAR();
#pragma unroll
    for (int rr = 0; rr < 2; ++rr)
#pragma unroll
        for (int hh = 0; hh < 2; ++hh) *(u32x4*)(MIX + (row0 + 2 * sp + rr) * D + h * HD + 16 * seg + 8 * hh) = *(const LAS u32x4*)(uI + (2 * sp + rr) * GM_LDT + 16 * seg + 8 * hh);
    LDS_BAR();
}
__device__ __forceinline__ void gmlp_wfrags(const Frame& F, const Args& a, int h, bf16x8 (&af)[4]) {
    const float* Wh = a.in[4] + (size_t)h * GMC * GMC;
    const int fr = F.lane & 15, fq = F.lane >> 4, trow = 16 * F.wave + fr;
#pragma unroll
    for (int kk = 0; kk < 4; ++kk) { const int s0 = 32 * kk + 8 * fq; const float* wp = Wh + (size_t)trow * GMC + s0;
        const f32x4 w0 = *(const f32x4*)wp, w1 = *(const f32x4*)(wp + 4); float wv[8] = {w0[0], w0[1], w0[2], w0[3], w1[0], w1[1], w1[2], w1[3]};
#pragma unroll
        for (int j = 0; j < 8; ++j) if (s0 + j > trow) wv[j] = 0.f;
        u32x4 pk; pk.x = cvt_pk_bf16(wv[0], wv[1]); pk.y = cvt_pk_bf16(wv[2], wv[3]); pk.z = cvt_pk_bf16(wv[4], wv[5]); pk.w = cvt_pk_bf16(wv[6], wv[7]);
        af[kk] = __builtin_bit_cast(bf16x8, pk); }
}

constexpr int DN_QS = 0;
constexpr int DN_KS = 17408;
constexpr int DN_KT = 34816;
constexpr int DN_XT = 53248;
constexpr int DN_LN = 90112;
constexpr int DN_LD = 99328;
constexpr int DN_TI = 103680;
constexpr int DN_YT = 106752;
constexpr int DN_GC = 119040;
constexpr int DN_CW = 120064;
static_assert(DN_CW + 6144 <= RING_BYTES, "DeltaNet chunk LDS map");
__device__ __forceinline__ int tsw(int r, int pos) { return r * 72 + ((((pos >> 3) ^ (r >> 3)) & 7) << 3) + (pos & 7); }
__device__ __forceinline__ int dn_slot(int bh, int n) { return bh * NCH + ((n + 7 * bh) & (NCH - 1)); }
struct DnPre { u32x4 xv[3][2][4]; float av, bv; };
__device__ __forceinline__ void dn_prefetch(const Frame& F, DnPre& P, int unit) {
    const int n = unit & 63, bh = unit >> 6, h = bh & 3, b = bh >> 2, fr = F.lane & 15, fq = F.lane >> 4;
    const bf16_t* PROJ = (const bf16_t*)(F.ws + WS_R3); const float* AB = (const float*)(F.ws + WS_AB);
    const size_t trow0 = (size_t)b * SEQ + (size_t)n * DNC;
    P.av = AB[(trow0 + F.lane) * 8 + h]; P.bv = AB[(trow0 + F.lane) * 8 + 4 + h];
#pragma unroll
    for (int ten = 0; ten < 3; ++ten) { const int ch = ten * 512 + h * HD + 8 * fr;
#pragma unroll
        for (int hp = 0; hp < 2; ++hp) { const int pos = hp * 32 + 4 * F.wave + fq;
#pragma unroll
            for (int j = 0; j < 4; ++j) { const int sp = n * DNC + pos - 3 + j;
                P.xv[ten][hp][j] = (sp >= 0) ? *(const u32x4*)(PROJ + ((size_t)b * SEQ + sp) * NPROJ + 1024 + ch) : (u32x4){0u, 0u, 0u, 0u}; } } }
}
__device__ __forceinline__ void dn_chunk(const Frame& F, const Args& a, int unit, DnPre& P, int next_unit) {
    const int n = unit & 63, bh = unit >> 6, h = bh & 3, b = bh >> 2;
    const LAS float* cwL = (const LAS float*)(F.lds + DN_CW);
    LAS unsigned char* L = F.lds;
    LAS bf16_t* qs = (LAS bf16_t*)(L + DN_QS); LAS bf16_t* ks = (LAS bf16_t*)(L + DN_KS); LAS bf16_t* kT = (LAS bf16_t*)(L + DN_KT); LAS bf16_t* XT = (LAS bf16_t*)(L + DN_XT);
    LAS bf16_t* Ln = (LAS bf16_t*)(L + DN_LN); LAS float* Ld = (LAS float*)(L + DN_LD); LAS bf16_t* Ti = (LAS bf16_t*)(L + DN_TI); LAS bf16_t* YT = (LAS bf16_t*)(L + DN_YT + F.wave * 1536);
    LAS float* gcs = (LAS float*)(L + DN_GC); LAS float* bts = gcs + 64; LAS float* egs = gcs + 128;
    const size_t trow0 = (size_t)b * SEQ + (size_t)n * DNC;
    int fr = F.lane & 15, fq = F.lane >> 4;
    asm volatile("" : "+v"(fr), "+v"(fq));
    float my_gc, my_beta, my_eg;
    {
        const float av = P.av, bv = P.bv;
        const float xg = av + a.in[8][h];
        const float sp = xg > 20.f ? xg : log1pf(__expf(xg));
        float g = -__expf(a.in[7][h]) * sp;
#pragma unroll
        for (int o = 1; o < 64; o <<= 1) { const float t = __shfl_up(g, o); if (F.lane >= o) g += t; }
        my_gc = g; my_beta = sigmoid_f(bv); my_eg = __expf(g);
        if (F.wave == 0) { gcs[F.lane] = my_gc; bts[F.lane] = my_beta; egs[F.lane] = my_eg; }
    }
    const int slot = dn_slot(bh, n);
    bf16_t* QDg = (bf16_t*)(F.ws + WS_QD) + (size_t)slot * 64 * 128;
#pragma unroll
    for (int ten = 0; ten < 3; ++ten) {
        f32x4 w0[4], w1[4];
#pragma unroll
        for (int j = 0; j < 4; ++j) { w0[j] = *(const LAS f32x4*)(cwL + (ten * 4 + j) * 128 + 8 * fr); w1[j] = *(const LAS f32x4*)(cwL + (ten * 4 + j) * 128 + 8 * fr + 4); }
#pragma unroll
        for (int hp = 0; hp < 2; ++hp) { const int pos = hp * 32 + 4 * F.wave + fq;
            float accv[8];
#pragma unroll
            for (int i = 0; i < 8; ++i) accv[i] = 0.f;
#pragma unroll
            for (int j = 0; j < 4; ++j) { const u32x4 x = P.xv[ten][hp][j];
                accv[0] += bflo(x[0]) * w0[j][0]; accv[1] += bfhi(x[0]) * w0[j][1]; accv[2] += bflo(x[1]) * w0[j][2]; accv[3] += bfhi(x[1]) * w0[j][3];
                accv[4] += bflo(x[2]) * w1[j][0]; accv[5] += bfhi(x[2]) * w1[j][1]; accv[6] += bflo(x[3]) * w1[j][2]; accv[7] += bfhi(x[3]) * w1[j][3]; }
            float ss = 0.f;
#pragma unroll
            for (int i = 0; i < 8; ++i) { accv[i] = silu_f(accv[i]); ss += accv[i] * accv[i]; }
#pragma unroll
            for (int o = 1; o < 16; o <<= 1) ss += __shfl_xor(ss, o);
            const float bp = __shfl(my_beta, pos), ep = __shfl(my_eg, pos);
            if (ten == 0) { const float sc = rsqrtf(ss + EPS) * 0.08838834764831845f;
#pragma unroll
                for (int i = 0; i < 8; ++i) accv[i] *= sc;
                u32x4 w; w.x = cvt_pk_bf16(accv[0], accv[1]); w.y = cvt_pk_bf16(accv[2], accv[3]); w.z = cvt_pk_bf16(accv[4], accv[5]); w.w = cvt_pk_bf16(accv[6], accv[7]);
                *(LAS u32x4*)(qs + pos * 136 + 8 * fr) = w;
                u32x4 wd; wd.x = cvt_pk_bf16(accv[0] * ep, accv[1] * ep); wd.y = cvt_pk_bf16(accv[2] * ep, accv[3] * ep); wd.z = cvt_pk_bf16(accv[4] * ep, accv[5] * ep); wd.w = cvt_pk_bf16(accv[6] * ep, accv[7] * ep);
                *(u32x4*)(QDg + pos * 128 + 8 * fr) = wd;
            } else if (ten == 1) { const float sc = rsqrtf(ss + EPS);
#pragma unroll
                for (int i = 0; i < 8; ++i) accv[i] *= sc;
                u32x4 w; w.x = cvt_pk_bf16(accv[0], accv[1]); w.y = cvt_pk_bf16(accv[2], accv[3]); w.z = cvt_pk_bf16(accv[4], accv[5]); w.w = cvt_pk_bf16(accv[6], accv[7]);
                *(LAS u32x4*)(ks + pos * 136 + 8 * fr) = w;
                const float rs = bp * ep;
#pragma unroll
                for (int i = 0; i < 8; ++i) { kT[tsw(8 * fr + i, pos)] = f2bf(accv[i]); XT[tsw(128 + 8 * fr + i, pos)] = f2bf(accv[i] * rs); }
            } else {
#pragma unroll
                for (int i = 0; i < 8; ++i) XT[tsw(8 * fr + i, pos)] = f2bf(accv[i] * bp);
            }
        }
    }
    if (next_unit >= 0) dn_prefetch(F, P, next_unit);
    LDS_BAR();
    bf16_t* ATg = (bf16_t*)(F.ws + WS_AT) + (size_t)slot * 64 * 64;
    {
        const int mt = F.wave & 3; const LAS bf16_t* Asrc = (F.wave < 4) ? ks : qs;
        f32x4 acc[4];
#pragma unroll
        for (int nt = 0; nt < 4; ++nt) acc[nt] = (f32x4){0.f, 0.f, 0.f, 0.f};
#pragma unroll
        for (int kk = 0; kk < 4; ++kk) { const bf16x8 af = *(const LAS bf16x8*)(Asrc + (16 * mt + fr) * 136 + 32 * kk + 8 * fq);
#pragma unroll
            for (int nt = 0; nt < 4; ++nt) { const bf16x8 bfr = *(const LAS bf16x8*)(ks + (16 * nt + fr) * 136 + 32 * kk + 8 * fq); acc[nt] = MFMA16(af, bfr, acc[nt]); } }
#pragma unroll
        for (int r = 0; r < 4; ++r) { const int i = 16 * mt + 4 * fq + r; const float gi = gcs[i], bi = bts[i];
#pragma unroll
            for (int nt = 0; nt < 4; ++nt) { const int j = 16 * nt + fr; const float dec = __expf(fminf(gi - gcs[j], 0.f));
                if (F.wave < 4) { const float lv = (j < i) ? bi * acc[nt][r] * dec : 0.f; Ln[i * 72 + j] = f2bf(-lv); if (nt == mt) Ld[(mt * 16 + 4 * fq + r) * 17 + fr] = lv; }
                else ATg[i * 64 + j] = f2bf((j <= i) ? acc[nt][r] * dec : 0.f); } }
    }
    LDS_BAR();
    if (F.wave == 0) {
        const int blk = fq, c = fr;
        float t[16];
#pragma unroll
        for (int i = 0; i < 16; ++i) { float s = (i == c) ? 1.f : 0.f;
#pragma unroll
            for (int j = 0; j < i; ++j) s -= Ld[(blk * 16 + i) * 17 + j] * t[j];
            t[i] = s; }
#pragma unroll
        for (int i = 0; i < 16; ++i) Ti[(16 * blk + i) * 24 + c] = f2bf(t[i]);
    } else {
        bf16_t* KETg = (bf16_t*)(F.ws + WS_KET) + (size_t)slot * 128 * 64;
        const float glast = gcs[63];
        for (int idx = F.tid - 64; idx < 128 * 8; idx += NTHREADS - 64) {
            const int d = idx >> 3, gp = idx & 7;
            const u32x4 v = *(const LAS u32x4*)(kT + tsw(d, 8 * gp)); u32x4 w;
#pragma unroll
            for (int i = 0; i < 4; ++i) w[i] = cvt_pk_bf16(bflo(v[i]) * __expf(glast - gcs[8 * gp + 2 * i]), bfhi(v[i]) * __expf(glast - gcs[8 * gp + 2 * i + 1]));
            *(u32x4*)(KETg + d * 64 + 8 * gp) = w;
        }
        if (F.tid == 64) ((float*)(F.ws + WS_GLAST))[slot] = __expf(glast);
    }
    LDS_BAR();
    {
        bf16_t* Og = (bf16_t*)(F.ws + (F.wave < 4 ? WS_UC : WS_WC)) + (size_t)slot * 64 * 128;
        const int ncol0 = (F.wave & 3) * 32;
        const bf16x8 zf = (bf16x8){0, 0, 0, 0, 0, 0, 0, 0};
#pragma unroll
        for (int bb = 0; bb < 4; ++bb) {
            f32x4 acc[2];
#pragma unroll
            for (int t = 0; t < 2; ++t) { const u32x2 rv = *(const LAS u32x2*)(XT + tsw(32 * F.wave + 16 * t + fr, 16 * bb + 4 * fq));
                acc[t] = (f32x4){bflo(rv.x), bfhi(rv.x), bflo(rv.y), bfhi(rv.y)}; }
            if (bb >= 1) {
#pragma unroll
                for (int kk = 0; kk < 2; ++kk) if (32 * kk < 16 * bb) {
                    bf16x8 af = *(const LAS bf16x8*)(Ln + (16 * bb + fr) * 72 + 32 * kk + 8 * fq);
                    if (32 * kk + 8 * fq >= 16 * bb) af = zf;
#pragma unroll
                    for (int t = 0; t < 2; ++t) { const bf16x8 bfr = *(const LAS bf16x8*)(XT + tsw(32 * F.wave + 16 * t + fr, 32 * kk + 8 * fq)); acc[t] = MFMA16(af, bfr, acc[t]); }
                }
            }
#pragma unroll
            for (int t = 0; t < 2; ++t) { u32x2 w; w.x = cvt_pk_bf16(acc[t][0], acc[t][1]); w.y = cvt_pk_bf16(acc[t][2], acc[t][3]); *(LAS u32x2*)(YT + (16 * t + fr) * 24 + 4 * fq) = w; }
            LDS_WAIT();
            bf16x8 a2 = *(const LAS bf16x8*)(Ti + (16 * bb + fr) * 24 + 8 * (fq & 1));
            if (fq >= 2) a2 = zf;
#pragma unroll
            for (int t = 0; t < 2; ++t) { bf16x8 b2 = *(const LAS bf16x8*)(YT + (16 * t + fr) * 24 + 8 * (fq & 1)); if (fq >= 2) b2 = zf;
                f32x4 x = MFMA16(a2, b2, ((f32x4){0.f, 0.f, 0.f, 0.f}));
                u32x2 w; w.x = cvt_pk_bf16(x[0], x[1]); w.y = cvt_pk_bf16(x[2], x[3]);
                *(LAS u32x2*)(XT + tsw(32 * F.wave + 16 * t + fr, 16 * bb + 4 * fq)) = w;
                if (F.wave < 4) *(u32x2*)(Og + (ncol0 + 16 * t + fr) * 64 + 16 * bb + 4 * fq) = w;
                else {
#pragma unroll
                    for (int r = 0; r < 4; ++r) Og[(16 * bb + 4 * fq + r) * 128 + ncol0 + 16 * t + fr] = f2bf(x[r]); } }
            LDS_WAIT();
        }
    }
    LDS_BAR();
}

constexpr int SC_WC = 0, SC_QD = 17408, SC_AT = 34816, SC_KE = 44032, SC_UC = 62464, SC_GL = 66560, SC_BUF = 66816;
constexpr int SC_ST = 2 * SC_BUF, SC_SLICE = 6656  , SC_OT = SC_ST + 2 * SC_SLICE;
static_assert(SC_OT + 8192 <= RING_BYTES, "scan LDS map");
constexpr int SC_NLD = 384;
struct ScanRegs { u32x4 w[3], q[3], k[3], a[2], u; float gl; };
__device__ __forceinline__ void scan_load(const Frame& F, ScanRegs& R, size_t cu, int sp, int lt) {
    const unsigned char* wc = F.ws + WS_WC + cu * 16384; const unsigned char* qd = F.ws + WS_QD + cu * 16384; const unsigned char* ke = F.ws + WS_KET + cu * 16384;
    const unsigned char* at = F.ws + WS_AT + cu * 8192; const unsigned char* uc = F.ws + WS_UC + cu * 16384 + (size_t)sp * 4096;
    const unsigned o = (unsigned)lt * 16u;
#pragma unroll
    for (int i = 0; i < 3; ++i) if (i < 2 || lt < 256) { R.w[i] = *(const u32x4*)(wc + o + i * (SC_NLD * 16)); R.q[i] = *(const u32x4*)(qd + o + i * (SC_NLD * 16)); R.k[i] = *(const u32x4*)(ke + o + i * (SC_NLD * 16)); }
    R.a[0] = *(const u32x4*)(at + o); if (lt < 128) R.a[1] = *(const u32x4*)(at + o + SC_NLD * 16);
    if (lt < 256) R.u = *(const u32x4*)(uc + o);
    R.gl = ((const float*)(F.ws + WS_GLAST))[cu];
}
__device__ __forceinline__ void scan_store(LAS unsigned char* buf, const ScanRegs& R, int lt) {
    if (lt == 0) *(LAS float*)(buf + SC_GL) = R.gl;
    const int d16 = ((lt >> 4) * 136 + (lt & 15) * 8) * 2;
    const int d8 = ((lt >> 3) * 72 + (lt & 7) * 8) * 2;
#pragma unroll
    for (int i = 0; i < 3; ++i) if (i < 2 || lt < 256) { *(LAS u32x4*)(buf + SC_WC + d16 + i * (24 * 136 * 2)) = R.w[i]; *(LAS u32x4*)(buf + SC_QD + d16 + i * (24 * 136 * 2)) = R.q[i]; *(LAS u32x4*)(buf + SC_KE + d8 + i * (48 * 72 * 2)) = R.k[i]; }
    *(LAS u32x4*)(buf + SC_AT + d8) = R.a[0]; if (lt < 128) *(LAS u32x4*)(buf + SC_AT + d8 + 48 * 72 * 2) = R.a[1];
    if (lt < 256) *(LAS u32x4*)(buf + SC_UC + lt * 16) = R.u;
}
__device__ __forceinline__ void scan_out(const Frame& F, int b, int h, int sp, int nn, int lt) {
    bf16_t* Og = (bf16_t*)(F.ws + WS_O);
    const int pos = lt >> 2, e4 = (lt & 3) * 4;
#pragma unroll
    for (int j = 0; j < 2; ++j) { const LAS bf16_t* OT = (const LAS bf16_t*)(F.lds + SC_OT + ((nn & 1) * 2 + j) * 2048);
        u32x2 w; w.x = (unsigned)OT[e4 * 64 + pos] | ((unsigned)OT[(e4 + 1) * 64 + pos] << 16); w.y = (unsigned)OT[(e4 + 2) * 64 + pos] | ((unsigned)OT[(e4 + 3) * 64 + pos] << 16);
        *(u32x2*)(Og + ((size_t)b * SEQ + (size_t)nn * DNC + pos) * 512 + h * HD + 16 * (2 * sp + j) + e4) = w; }
}
__device__ __forceinline__ void dn_scan(const Frame& F, int item) {
    const int bh = item >> 2, sp = item & 3, h = bh & 3, b = bh >> 2;
    const int cj = F.wave & 1;
    LAS bf16_t* ST = (LAS bf16_t*)(F.lds + SC_ST + cj * SC_SLICE); LAS bf16_t* VT = (LAS bf16_t*)(F.lds + SC_ST + cj * SC_SLICE + 4352);
    const int fr = F.lane & 15, fq = F.lane >> 4;
    f32x4 S[8];
#pragma unroll
    for (int mt = 0; mt < 8; ++mt) S[mt] = (f32x4){0.f, 0.f, 0.f, 0.f};
    if (F.wave < 2) {
#pragma unroll
        for (int mt = 0; mt < 8; ++mt) *(LAS u32x2*)(ST + fr * 136 + 16 * mt + 4 * fq) = (u32x2){0u, 0u};
    }
    ScanRegs R;
    if (F.wave >= 2) { scan_load(F, R, (size_t)dn_slot(bh, 0), sp, F.tid - 128); scan_store(F.lds, R, F.tid - 128);
                       scan_load(F, R, (size_t)dn_slot(bh, 1), sp, F.tid - 128); }
    LDS_WAIT(); __syncthreads();
#pragma unroll 1
    for (int n = 0; n < NCH; ++n) {
        LAS unsigned char* buf = F.lds + (n & 1) * SC_BUF;
        if (F.wave >= 2) {
            if (n + 1 < NCH) scan_store(F.lds + ((n + 1) & 1) * SC_BUF, R, F.tid - 128);
            if (n + 2 < NCH) scan_load(F, R, (size_t)dn_slot(bh, n + 2), sp, F.tid - 128);
            if (n >= 1 && F.tid < 384) scan_out(F, b, h, sp, n - 1, F.tid - 128);
        } else {
            const LAS bf16_t* wc = (const LAS bf16_t*)(buf + SC_WC); const LAS bf16_t* qd = (const LAS bf16_t*)(buf + SC_QD); const LAS bf16_t* at = (const LAS bf16_t*)(buf + SC_AT);
            const LAS bf16_t* ke = (const LAS bf16_t*)(buf + SC_KE); const LAS bf16_t* uc = (const LAS bf16_t*)(buf + SC_UC) + cj * 1024;
            bf16x8 sb[4];
#pragma unroll
            for (int kk = 0; kk < 4; ++kk) sb[kk] = *(const LAS bf16x8*)(ST + fr * 136 + 32 * kk + 8 * fq);
            f32x4 vn[4], oo[4];
#pragma unroll
            for (int hf = 0; hf < 2; ++hf) {
                bf16x8 aw[2][4], aq[2][4];
#pragma unroll
                for (int m2 = 0; m2 < 2; ++m2)
#pragma unroll
                    for (int kk = 0; kk < 4; ++kk) { aw[m2][kk] = *(const LAS bf16x8*)(wc + (16 * (2 * hf + m2) + fr) * 136 + 32 * kk + 8 * fq); aq[m2][kk] = *(const LAS bf16x8*)(qd + (16 * (2 * hf + m2) + fr) * 136 + 32 * kk + 8 * fq); }
                __builtin_amdgcn_sched_barrier(0);
#pragma unroll
                for (int m2 = 0; m2 < 2; ++m2) { const int mt = 2 * hf + m2; vn[mt] = (f32x4){0.f, 0.f, 0.f, 0.f}; oo[mt] = (f32x4){0.f, 0.f, 0.f, 0.f}; }
#pragma unroll
                for (int kk = 0; kk < 4; ++kk)
#pragma unroll
                    for (int m2 = 0; m2 < 2; ++m2) { const int mt = 2 * hf + m2; vn[mt] = MFMA16(aw[m2][kk], sb[kk], vn[mt]); oo[mt] = MFMA16(aq[m2][kk], sb[kk], oo[mt]); }
                __builtin_amdgcn_sched_barrier(0);
            }
            u32x2 uvv[4];
#pragma unroll
            for (int mt = 0; mt < 4; ++mt) uvv[mt] = *(const LAS u32x2*)(uc + fr * 64 + 16 * mt + 4 * fq);
            __builtin_amdgcn_sched_barrier(0);
#pragma unroll
            for (int mt = 0; mt < 4; ++mt) { const u32x2 uv = uvv[mt];
                vn[mt][0] = bflo(uv.x) - vn[mt][0]; vn[mt][1] = bfhi(uv.x) - vn[mt][1]; vn[mt][2] = bflo(uv.y) - vn[mt][2]; vn[mt][3] = bfhi(uv.y) - vn[mt][3];
                u32x2 w; w.x = cvt_pk_bf16(vn[mt][0], vn[mt][1]); w.y = cvt_pk_bf16(vn[mt][2], vn[mt][3]);
                *(LAS u32x2*)(VT + fr * 72 + 16 * mt + 4 * fq) = w; }
            LDS_WAIT();
            bf16x8 vb[2];
#pragma unroll
            for (int kk = 0; kk < 2; ++kk) vb[kk] = *(const LAS bf16x8*)(VT + fr * 72 + 32 * kk + 8 * fq);
            bf16x8 aa[4][2];
#pragma unroll
            for (int mt = 0; mt < 4; ++mt)
#pragma unroll
                for (int kk = 0; kk < 2; ++kk) aa[mt][kk] = *(const LAS bf16x8*)(at + (16 * mt + fr) * 72 + 32 * kk + 8 * fq);
            bf16x8 ak[8][2];
#pragma unroll
            for (int mt = 0; mt < 4; ++mt)
#pragma unroll
                for (int kk = 0; kk < 2; ++kk) ak[mt][kk] = *(const LAS bf16x8*)(ke + (16 * mt + fr) * 72 + 32 * kk + 8 * fq);
            const float dec = *(const LAS float*)(buf + SC_GL);
            __builtin_amdgcn_sched_barrier(0);
#pragma unroll
            for (int mt = 0; mt < 4; ++mt) {
#pragma unroll
                for (int kk = 0; kk < 2; ++kk) oo[mt] = MFMA16(aa[mt][kk], vb[kk], oo[mt]); }
#pragma unroll
            for (int mt = 4; mt < 8; ++mt)
#pragma unroll
                for (int kk = 0; kk < 2; ++kk) ak[mt][kk] = *(const LAS bf16x8*)(ke + (16 * mt + fr) * 72 + 32 * kk + 8 * fq);
            __builtin_amdgcn_sched_barrier(0);
#pragma unroll
            for (int mt = 0; mt < 8; ++mt) { S[mt] = S[mt] * dec;
#pragma unroll
                for (int kk = 0; kk < 2; ++kk) S[mt] = MFMA16(ak[mt][kk], vb[kk], S[mt]); }
            __builtin_amdgcn_sched_barrier(0);
#pragma unroll
            for (int mt = 0; mt < 8; ++mt) { u32x2 w; w.x = cvt_pk_bf16(S[mt][0], S[mt][1]); w.y = cvt_pk_bf16(S[mt][2], S[mt][3]);
                *(LAS u32x2*)(ST + fr * 136 + 16 * mt + 4 * fq) = w; }
            LAS bf16_t* OT = (LAS bf16_t*)(F.lds + SC_OT + ((n & 1) * 2 + cj) * 2048);
#pragma unroll
            for (int mt = 0; mt < 4; ++mt) { u32x2 w; w.x = cvt_pk_bf16(oo[mt][0], oo[mt][1]); w.y = cvt_pk_bf16(oo[mt][2], oo[mt][3]); *(LAS u32x2*)(OT + fr * 64 + 16 * mt + 4 * fq) = w; }
        }
        LDS_WAIT(); __builtin_amdgcn_s_barrier(); asm volatile("" ::: "memory");
    }
    if (F.tid >= 128 && F.tid < 384) scan_out(F, b, h, sp, NCH - 1, F.tid - 128);
    LDS_WAIT(); __syncthreads();
}
__device__ __forceinline__ void convert_experts(const Frame& F, const Args& a, int cw, int nw) {
    LAS float* scr = (LAS float*)(F.lds + F.wave * 16896);
    const float* w_gu = a.in[14]; const float* w_dn = a.in[16]; unsigned char* WGU = F.ws + WS_WGU; unsigned char* WDN = F.ws + WS_WDN;
    constexpr int I_GU = NE * 8 * 64, I_DN = NE * 8 * 32;
    for (int it = cw; it < I_GU + I_DN; it += nw) {
        int r = it;
        if (r < I_GU) { const int e = r / 512, q = r % 512, kb = q / 64, nb = q % 64; const int c0 = 32 * nb, j = c0 & 1023, drow = (j >> 7) * 256 + (c0 >= 1024 ? 128 : 0) + (j & 127);
            tr_item8(w_gu + (size_t)e * 1024 * 2048 + (size_t)(128 * kb) * 2048 + c0, 2048, WGU + (size_t)e * 2048 * 1024 + (size_t)drow * 1024 + 128 * kb, scr, F.lane); continue; } r -= I_GU;
        { const int e = r / 256, q = r % 256, kb = q / 32, nb = q % 32;
            tr_item8(w_dn + (size_t)e * 1024 * 1024 + (size_t)(128 * kb) * 1024 + 32 * nb, 1024, WDN + (size_t)e * 1024 * 1024 + (size_t)(32 * nb) * 1024 + 128 * kb, scr, F.lane); }
    }
}

__device__ __forceinline__ void dn_out(const Frame& F, const Args& a) {
    const int gw = F.vcu * NWAVES + F.wave, NGW = F.G * NWAVES;
    const bf16_t* Og = (const bf16_t*)(F.ws + WS_O); const bf16_t* PROJ = (const bf16_t*)(F.ws + WS_R3); bf16_t* MIX = (bf16_t*)(F.ws + WS_MIX);
    const float* ng = a.in[9] + 8 * (F.lane & 15);
    const f32x4 g0 = *(const f32x4*)ng, g1 = *(const f32x4*)(ng + 4);
    for (int m = gw; m < T; m += NGW) {
        const u32x4 ow = *(const u32x4*)(Og + (size_t)m * 512 + 8 * F.lane);
        f32x4 o0 = (f32x4){bflo(ow[0]), bfhi(ow[0]), bflo(ow[1]), bfhi(ow[1])}, o1 = (f32x4){bflo(ow[2]), bfhi(ow[2]), bflo(ow[3]), bfhi(ow[3])};
        const u32x4 z = *(const u32x4*)(PROJ + (size_t)m * NPROJ + 2560 + 8 * F.lane);
        float ss = (o0[0] * o0[0] + o0[1] * o0[1]) + (o0[2] * o0[2] + o0[3] * o0[3]) + (o1[0] * o1[0] + o1[1] * o1[1]) + (o1[2] * o1[2] + o1[3] * o1[3]);
#pragma unroll
        for (int o = 1; o < 16; o <<= 1) ss += __shfl_xor(ss, o);
        const float rstd = rsqrtf(ss * (1.0f / HD) + EPS);
        o0 = o0 * rstd * g0; o1 = o1 * rstd * g1;
        u32x4 w; w.x = cvt_pk_bf16(o0[0] * silu_f(bflo(z[0])), o0[1] * silu_f(bfhi(z[0]))); w.y = cvt_pk_bf16(o0[2] * silu_f(bflo(z[1])), o0[3] * silu_f(bfhi(z[1])));
        w.z = cvt_pk_bf16(o1[0] * silu_f(bflo(z[2])), o1[1] * silu_f(bfhi(z[2]))); w.w = cvt_pk_bf16(o1[2] * silu_f(bflo(z[3])), o1[3] * silu_f(bfhi(z[3])));
        *(u32x4*)(MIX + (size_t)m * D + 512 + 8 * F.lane) = w;
    }
}

constexpr int RT_PITCH = 1032;
__device__ __forceinline__ void route(const Frame& F, const Args& a) {
    const int gw = F.vcu * NWAVES + F.wave, NGW = F.G * NWAVES;
    const bf16_t* HB = (const bf16_t*)(F.ws + WS_H); const bf16_t* RWT = (const bf16_t*)(F.ws + WS_RWT); const float* rb = a.in[13]; const float* g2 = a.in[11];
    int* EIDX = (int*)(F.ws + WS_EIDX); float* GATEW = (float*)(F.ws + WS_GATEW); int* EPOS = (int*)(F.ws + WS_EPOS);
    unsigned* cnt = (unsigned*)(F.ws + WS_CTL) + CW_CNT;
    LAS bf16_t* tl = (LAS bf16_t*)(F.lds + F.wave * 17664); LAS float* lg = (LAS float*)(F.lds + F.wave * 17664 + 16512);
    LAS unsigned* lcnt = (LAS unsigned*)(F.lds + 8 * 17664);
    if (F.tid < 64) lcnt[F.tid] = 0u;
    LDS_WAIT(); __syncthreads();
    const int fr = F.lane & 15, fq = F.lane >> 4;
    f32x4 gv[4];
#pragma unroll
    for (int j = 0; j < 4; ++j) gv[j] = *(const f32x4*)(g2 + 4 * F.lane + 256 * j);
    for (int batch = gw; batch < T / 8; batch += NGW) {
        const size_t r0 = (size_t)batch * 8;
        u32x2 raw[8][4];
#pragma unroll
        for (int row = 0; row < 8; ++row)
#pragma unroll
            for (int j = 0; j < 4; ++j) raw[row][j] = ((const u32x2*)(HB + (r0 + row) * D))[F.lane + 64 * j];
#pragma unroll
        for (int row = 0; row < 8; ++row) {
            f32x4 v[4]; float ss = 0.f;
#pragma unroll
            for (int j = 0; j < 4; ++j) { v[j] = (f32x4){bflo(raw[row][j].x), bfhi(raw[row][j].x), bflo(raw[row][j].y), bfhi(raw[row][j].y)}; ss += (v[j][0] * v[j][0] + v[j][1] * v[j][1]) + (v[j][2] * v[j][2] + v[j][3] * v[j][3]); }
            const float rstd = rsqrtf(wave_sum(ss) * (1.0f / D) + EPS);
            unsigned* y8 = (unsigned*)(F.ws + WS_HN8 + (r0 + row) * D) + F.lane;
#pragma unroll
            for (int j = 0; j < 4; ++j) { const f32x4 y = v[j] * rstd * gv[j]; y8[64 * j] = cvt4_fp8(y[0], y[1], y[2], y[3]);
                u32x2 w; w.x = cvt_pk_bf16(y[0], y[1]); w.y = cvt_pk_bf16(y[2], y[3]); *(LAS u32x2*)(tl + row * RT_PITCH + 4 * F.lane + 256 * j) = w; }
        }
        LDS_WAIT();
        f32x4 acc0 = (f32x4){0.f, 0.f, 0.f, 0.f}, acc1 = acc0;
#pragma unroll 1
        for (int k8 = 0; k8 < 32; k8 += 8) {
            bf16x8 b0[8], b1[8];
#pragma unroll
            for (int kk = 0; kk < 8; ++kk) { b0[kk] = *(const bf16x8*)(RWT + (size_t)fr * D + 32 * (k8 + kk) + 8 * fq); b1[kk] = *(const bf16x8*)(RWT + (size_t)(16 + fr) * D + 32 * (k8 + kk) + 8 * fq); }
#pragma unroll
            for (int kk = 0; kk < 8; ++kk) { const bf16x8 af = *(const LAS bf16x8*)(tl + (fr & 7) * RT_PITCH + 32 * (k8 + kk) + 8 * fq);
                acc0 = MFMA16(af, b0[kk], acc0); acc1 = MFMA16(af, b1[kk], acc1); }
        }
        const float bb0 = rb[fr], bb1 = rb[16 + fr];
        if (fq < 2) {
#pragma unroll
            for (int r = 0; r < 4; ++r) { lg[(4 * fq + r) * 36 + fr] = acc0[r] + bb0; lg[(4 * fq + r) * 36 + 16 + fr] = acc1[r] + bb1; } }
        LDS_WAIT();
        if (F.lane < 8) {
            const int row = F.lane; const size_t t = r0 + row;
            float v[32];
#pragma unroll
            for (int q = 0; q < 8; ++q) { const f32x4 x = *(const LAS f32x4*)(lg + row * 36 + 4 * q); v[4 * q] = x[0]; v[4 * q + 1] = x[1]; v[4 * q + 2] = x[2]; v[4 * q + 3] = x[3]; }
            float tv[4]; int ti[4];
#pragma unroll
            for (int k = 0; k < 4; ++k) { float best = -3.0e38f; int bi = 0;
#pragma unroll
                for (int e = 0; e < 32; ++e) { if (v[e] > best) { best = v[e]; bi = e; } }
                tv[k] = best; ti[k] = bi;
#pragma unroll
                for (int e = 0; e < 32; ++e) v[e] = (e == bi) ? -3.0e38f : v[e]; }
            const float e1 = __expf(tv[1] - tv[0]), e2 = __expf(tv[2] - tv[0]), e3 = __expf(tv[3] - tv[0]); const float inv = 1.0f / (1.0f + e1 + e2 + e3);
            const float gk[4] = {inv, e1 * inv, e2 * inv, e3 * inv};
#pragma unroll
            for (int k = 0; k < 4; ++k) {
                const unsigned pos = __hip_atomic_fetch_add(lcnt + ti[k], 1u, __ATOMIC_RELAXED, __HIP_MEMORY_SCOPE_WORKGROUP);
                EIDX[t * 4 + k] = ti[k]; GATEW[t * 4 + k] = gk[k]; EPOS[t * 4 + k] = (int)pos;
            }
        }
        LDS_WAIT();
    }
    VM_WAIT(); LDS_WAIT(); __syncthreads();
    if (F.tid < NE) { const unsigned c = lcnt[F.tid]; lcnt[32 + F.tid] = c ? __hip_atomic_fetch_add(cnt + 64 * F.tid, c, __ATOMIC_RELAXED, __HIP_MEMORY_SCOPE_AGENT) : 0u; }
    LDS_WAIT(); __syncthreads();
    for (int batch = gw; batch < T / 8; batch += NGW) if (F.lane < 32) { const size_t a0 = (size_t)batch * 32 + F.lane; EPOS[a0] += (int)lcnt[32 + EIDX[a0]]; }
}

constexpr int TB_OFF = 131072;
__device__ __forceinline__ void build_tables(const Frame& F) {
    LAS int* pst = (LAS int*)(F.lds + TB_OFF); LAS int* cn = pst + 40; LAS int* tile_e = pst + 80;
    const unsigned* cnt = (const unsigned*)(F.ws + WS_CTL) + CW_CNT;
    if (F.tid < 64) {
        const int e = F.lane & 31; const int c = (int)__hip_atomic_load(cnt + 64 * e, __ATOMIC_RELAXED, __HIP_MEMORY_SCOPE_AGENT);
        const int padded = (c + 255) & ~255;
        int incl = padded;
#pragma unroll
        for (int o = 1; o < 32; o <<= 1) { const int t = __shfl_up(incl, o); if (e >= o) incl += t; }
        if (F.lane < 32) { pst[e] = incl - padded; cn[e] = c; if (e == 31) pst[32] = incl;
            for (int j = 0; j < padded / 256; ++j) tile_e[(incl - padded) / 256 + j] = e; }
    }
    LDS_WAIT(); __syncthreads();
}

__device__ __forceinline__ void gather_rows(const Frame& F) {
    const int gw = F.vcu * NWAVES + F.wave, NGW = F.G * NWAVES;
    LAS int* pst = (LAS int*)(F.lds + TB_OFF); LAS int* cn = pst + 40; LAS int* tile_e = pst + 80;
    const unsigned char* HN8 = F.ws + WS_HN8; unsigned char* XS = F.ws + WS_R3;
    const int* EIDX = (const int*)(F.ws + WS_EIDX); const int* EPOS = (const int*)(F.ws + WS_EPOS); const float* GATEW = (const float*)(F.ws + WS_GATEW); float* GSORT = (float*)(F.ws + WS_GSORT); int* ROWOF = (int*)(F.ws + WS_ROWOF);
    const int rtot = pst[32];
    for (int tl = gw; tl < (rtot >> 8); tl += NGW) { const int e = tile_e[tl], first = pst[e] + cn[e], lo = tl << 8;
        for (int R = (first > lo ? first : lo); R < lo + 256; ++R) { *((u32x4*)(XS + (size_t)R * D) + F.lane) = (u32x4){0u, 0u, 0u, 0u}; if (F.lane == 0) GSORT[R] = 0.f; } }
    for (int t0 = gw * 4; t0 < T; t0 += NGW * 4) {
        int Rl = 0;
        if (F.lane < 16) { const int a = t0 * 4 + F.lane; const int e = EIDX[a]; Rl = pst[e] + EPOS[a]; ROWOF[a] = Rl; GSORT[Rl] = GATEW[a]; }
        u32x4 v[4];
#pragma unroll
        for (int j = 0; j < 4; ++j) v[j] = *((const u32x4*)(HN8 + (size_t)(t0 + j) * D) + F.lane);
#pragma unroll
        for (int j = 0; j < 4; ++j)
#pragma unroll
            for (int k = 0; k < 4; ++k) { const int R = __builtin_amdgcn_readlane(Rl, 4 * j + k); *((u32x4*)(XS + (size_t)R * D) + F.lane) = v[j]; }
    }
}

__device__ __forceinline__ void combine(const Frame& F, const Args& a) {
    const int gw = F.vcu * NWAVES + F.wave, NGW = F.G * NWAVES;
    const bf16_t* H = (const bf16_t*)(F.ws + WS_H); const unsigned char* YS = F.ws + WS_YS; const int* ROWOF = (const int*)(F.ws + WS_ROWOF); const float* gf = a.in[18];
    f32x4 gv[4];
#pragma unroll
    for (int j = 0; j < 4; ++j) gv[j] = *(const f32x4*)(gf + 4 * F.lane + 256 * j);
    for (int m = gw; m < T; m += NGW) {
        const u32x2* xr = (const u32x2*)(H + (size_t)m * D) + F.lane;
        f32x4 v[4];
#pragma unroll
        for (int j = 0; j < 4; ++j) { const u32x2 hw = xr[64 * j]; v[j] = (f32x4){bflo(hw.x), bfhi(hw.x), bflo(hw.y), bfhi(hw.y)}; }
#if !defined(DBG_SKIP_MOE)
#pragma unroll
        for (int k = 0; k < 4; ++k) { const int R = ROWOF[m * 4 + k]; const int* yr = (const int*)(YS + (size_t)R * D) + F.lane;
#pragma unroll
            for (int j = 0; j < 4; ++j) { const int w = yr[64 * j]; const f32x2 lo = __builtin_amdgcn_cvt_pk_f32_fp8(w, false), hi = __builtin_amdgcn_cvt_pk_f32_fp8(w, true);
                v[j][0] += lo.x; v[j][1] += lo.y; v[j][2] += hi.x; v[j][3] += hi.y; } }
#endif
        float ss = 0.f;
#pragma unroll
        for (int j = 0; j < 4; ++j) ss += (v[j][0] * v[j][0] + v[j][1] * v[j][1]) + (v[j][2] * v[j][2] + v[j][3] * v[j][3]);
        const float rstd = rsqrtf(wave_sum(ss) * (1.0f / D) + EPS);
        f32x4* o = (f32x4*)(a.out + (size_t)m * D) + F.lane;
#pragma unroll
        for (int j = 0; j < 4; ++j) o[64 * j] = v[j] * rstd * gv[j];
    }
}

__device__ __forceinline__ void dbg_dump(const Frame& F, const Args& a, int what) {
    const int gw = F.vcu * NWAVES + F.wave, NGW = F.G * NWAVES;
    for (int m = gw; m < T; m += NGW) {
        for (int c = F.lane; c < D; c += 64) {
            float v = 0.f;
            if (what == 1) v = bf2f(((const bf16_t*)(F.ws + WS_R3))[(size_t)m * NPROJ + c]);
            else if (what == 2) v = bf2f(((const bf16_t*)(F.ws + WS_MIX))[(size_t)m * D + c]);
            else if (what == 3) v = ((const float*)(F.ws + WS_O))[(size_t)m * 512 + (c & 511)];
            else if (what == 4) v = ((const float*)(F.ws + WS_H))[(size_t)m * D + c];
            else if (what == 5) v = bf2f(((const bf16_t*)(F.ws + WS_R3))[(size_t)m * NPROJ + 1024 + c]);
            else if (what == 6) v = bf2f(((const bf16_t*)(F.ws + WS_R3))[(size_t)m * NPROJ + 2048 + c]);
            else if (what == 7) v = bf2f(((const bf16_t*)(F.ws + WS_Y))[(size_t)m * D + c]);
            else if (what == 9) v = bf2f(((const bf16_t*)(F.ws + WS_WC))[((size_t)m * D + c) & 0xFFFFFF]);
            else if (what == 10) v = bf2f(((const bf16_t*)(F.ws + WS_UC))[((size_t)m * D + c) & 0xFFFFFF]);
            else if (what == 11) v = bf2f(((const bf16_t*)(F.ws + WS_QD))[((size_t)m * D + c) & 0xFFFFFF]);
            else if (what == 12) v = bf2f(((const bf16_t*)(F.ws + WS_KET))[((size_t)m * D + c) & 0xFFFFFF]);
            else if (what == 13) v = bf2f(((const bf16_t*)(F.ws + WS_AT))[((size_t)m * D + c) & 0x7FFFFF]);
            else if (what == 14) v = ((const float*)(F.ws + WS_AB))[(size_t)m * 8 + (c & 7)];
            else if (what == 8) v = bf2f(((const bf16_t*)(F.ws + WS_MIX))[(size_t)m * D + (c & 511)]);
            if (!(v - v == 0.f)) v = 12345.f;
            a.out[(size_t)m * D + c] = v;
        }
    }
}

constexpr int NPHASES = 12;
__global__ void __launch_bounds__(NTHREADS, 2) fwd(Args args) {
    __shared__ __attribute__((aligned(16))) unsigned char lds_raw[LDS_BYTES];
    Frame F;
    F.lds = (LAS unsigned char*)lds_raw;
    F.tid = threadIdx.x; F.lane = F.tid & 63; F.wave = __builtin_amdgcn_readfirstlane(F.tid >> 6);
    F.G = gridDim.x; { const int bx = blockIdx.x; F.vcu = (F.G % 8 == 0) ? (bx % 8) * (F.G / 8) + bx / 8 : bx; }
    F.ws = args.ws;
    volatile LAS unsigned* MISC = (volatile LAS unsigned*)(F.lds + LDSCTL_OFF);
    for (int u = F.tid; u < (LDS_BYTES - LDSCTL_OFF) / 4; u += NTHREADS) MISC[u] = 0u;
    __syncthreads();
#if !MK_PER_PHASE
    XcdBarrier bar = xcd_barrier_post((unsigned*)(F.ws + WS_CTL) + CW_BAR, MISC + 8);
#define GRID_BAR() xcd_barrier(bar)
#else
#define GRID_BAR() do { } while (0)
#endif
    const int lo = args.ph_lo, hi = args.ph_hi;
#define IN(k) (lo <= (k) && (k) < hi)
#ifndef PROBE_DOUBLE
#define PROBE_DOUBLE (-1)
#endif
#define REP(k) for (int rep_ = 0; rep_ < ((PROBE_DOUBLE) == (k) ? 2 : 1); ++rep_)
#define SEAM(k) do { if (IN(k) && IN((k) + 1)) GRID_BAR(); } while (0)

    if (IN(0)) REP(0) { p0_prologue(F, args); } SEAM(0);
    if (IN(1)) REP(1) {
        pg8::Gemm g{(const bf16_t*)(F.ws + WS_Y), (const bf16_t*)(F.ws + WS_WIN), T, NPROJ, D}; pg8::StaticOrder S; S.init(T, NPROJ, F.G, (int)blockIdx.x);
        pg8::EpiProj E{(bf16_t*)(F.ws + WS_R3)};
        pg8::gemm_phase<pg8::EpiProj, pg8::StaticOrder>(F.lds, g, S, E);
    } SEAM(1);
    if (IN(2)) REP(2) {
        if (F.vcu < NB * 32 * NH) {
            bf16x8 af[4]; GmPre GP; int hcur = -1;
            gmlp_prefetch(F, GP, F.vcu);
            for (int u = F.vcu; u < NB * 32 * NH; u += F.G) {
                if ((u & 3) != hcur) { hcur = u & 3; gmlp_wfrags(F, args, hcur, af); }
                gmlp_unit(F, args, u, af, GP, (u + F.G < NB * 32 * NH) ? u + F.G : -1);
            }
        }
        if (F.vcu < NCHUNKS) {
            const int h0 = (F.vcu >> 6) & 3;
            DnPre P; int hcur = -1;
            dn_prefetch(F, P, F.vcu);
            for (int u = F.vcu; u < NCHUNKS; u += F.G) {
                const int hh = (u >> 6) & 3;
                if (hh != hcur) { __syncthreads(); for (int i = F.tid; i < 3 * 4 * 128; i += NTHREADS) { const int ten = i / 512, j = (i >> 7) & 3, c = i & 127; ((LAS float*)(F.lds + DN_CW))[i] = args.in[6][(size_t)j * 1536 + ten * 512 + hh * HD + c]; } hcur = hh; LDS_WAIT(); __syncthreads(); }
                dn_chunk(F, args, u, P, (u + F.G < NCHUNKS) ? u + F.G : -1);
            }
            (void)h0;
        }
    } SEAM(2);
    if (IN(3)) {
        const int bx = (int)blockIdx.x, nscan = F.G >= 2 ? F.G / 2 : 1;
        if (bx < nscan) {
            const int sid = (nscan % 8 == 0) ? (bx % 8) * (nscan / 8) + bx / 8 : bx;
            for (int it = sid; it < NB * NH * 4; it += nscan) dn_scan(F, it);
            if (F.G < 2) convert_experts(F, args, F.wave, NWAVES);
        } else convert_experts(F, args, (bx - nscan) * NWAVES + F.wave, (F.G - nscan) * NWAVES);
    } SEAM(3);
    if (IN(4)) REP(4) { dn_out(F, args); } SEAM(4);
    if (IN(5)) REP(5) {
        pg8::Gemm g{(const bf16_t*)(F.ws + WS_MIX), (const bf16_t*)(F.ws + WS_WOUT), T, D, D}; pg8::StaticOrder S; S.init(T, D, F.G, (int)blockIdx.x);
        pg8::EpiResid E{args.in[0], (bf16_t*)(F.ws + WS_H)};
        pg8::gemm_phase<pg8::EpiResid, pg8::StaticOrder>(F.lds, g, S, E);
    } SEAM(5);
    if (IN(6)) { route(F, args); } SEAM(6);
    if (IN(8)) { build_tables(F); REP(8) gather_rows(F); } SEAM(8);
    if (IN(9)) {
        if (!IN(8)) build_tables(F);
        const int rtot = ((LAS int*)(F.lds + TB_OFF))[32];
        REP(9) {
        pg8::Gemm g{(const bf16_t*)(F.ws + WS_R3), (const bf16_t*)(F.ws + WS_WGU), rtot, 2048, D / 2}; pg8::MoeOrder S; S.init(rtot, 2048, F.G, (int)blockIdx.x); S.tile_e = (const LAS int*)(F.lds + TB_OFF) + 80;
        pg8::EpiSwiglu E{F.ws + WS_R4, args.in[15]};
        pg8::gemm_phase<pg8::EpiSwiglu, pg8::MoeOrder, true>(F.lds, g, S, E);
        }
    } SEAM(9);
    if (IN(10)) {
        if (!IN(9)) build_tables(F);
        const int rtot = ((LAS int*)(F.lds + TB_OFF))[32];
        REP(10) {
        pg8::Gemm g{(const bf16_t*)(F.ws + WS_R4), (const bf16_t*)(F.ws + WS_WDN), rtot, D, DFF / 2}; pg8::MoeOrder S; S.init(rtot, D, F.G, (int)blockIdx.x); S.tile_e = (const LAS int*)(F.lds + TB_OFF) + 80;
        pg8::EpiDown E{F.ws + WS_YS, args.in[17], (const float*)(F.ws + WS_GSORT)};
        pg8::gemm_phase<pg8::EpiDown, pg8::MoeOrder, true>(F.lds, g, S, E);
        }
    } SEAM(10);
    if (IN(11)) REP(11) { combine(F, args); }
#if defined(DBG_DUMP)
    if (IN(12)) { dbg_dump(F, args, DBG_DUMP); }
#endif
#undef IN
#undef SEAM
}

extern "C" void kernel_launch(void* const* d_in, const int* in_sizes, int n_in, void* d_out, int out_size, void* d_ws, size_t ws_size, hipStream_t stream) {
    static int grid = 0;
    if (grid == 0) {
        if (n_in != 19 || out_size != T * D || ws_size < WS_END) { fprintf(stderr, "kernel_launch: unexpected shapes (n_in %d, out %d, ws %zu)\n", n_in, out_size, ws_size); grid = -1; return; }
        int dev = 0, cus = 0, per_cu = 0;
        if (hipGetDevice(&dev) != hipSuccess || hipDeviceGetAttribute(&cus, hipDeviceAttributeMultiprocessorCount, dev) != hipSuccess) { grid = -1; return; }
        if (hipOccupancyMaxActiveBlocksPerMultiprocessor(&per_cu, (const void*)fwd, NTHREADS, 0) != hipSuccess || per_cu < 1) fprintf(stderr, "kernel_launch: occupancy query reports %d\n", per_cu);
        (void)hipGetLastError();
        grid = cus;
    }
    if (grid < 0) return;
    (void)hipMemsetAsync((char*)d_ws + WS_CTL, 0, CTL_ZERO_BYTES, stream);
    Args a{};
    for (int i = 0; i < 19; ++i) a.in[i] = (const float*)d_in[i];
    a.out = (float*)d_out; a.ws = (unsigned char*)d_ws;
#if MK_PER_PHASE
    for (int p = 0; p < NPHASES; ++p) {
#if defined(DBG_DUMP)
        if (p > DBG_LAST) continue;
#endif
        a.ph_lo = p; a.ph_hi = p + 1; hipLaunchKernelGGL(fwd, dim3(grid), dim3(NTHREADS), 0, stream, a); }
#if defined(DBG_DUMP)
    a.ph_lo = 12; a.ph_hi = 13; hipLaunchKernelGGL(fwd, dim3(grid), dim3(NTHREADS), 0, stream, a);
#endif
#else
    a.ph_lo = 0; a.ph_hi = NPHASES; hipLaunchKernelGGL(fwd, dim3(grid), dim3(NTHREADS), 0, stream, a);
#endif
}
```
